# Optimizing an MI355X kernel written in HIP

```python
import jax
import jax.numpy as jnp
from jax import lax
import numpy as np

D_MODEL = 2048
BATCH = 8
SEQ = 4096
DEPTH = 4

GRID_W = 64
CTX_LEN = 256
EPS = 1e-6
ROPE_THETA = 10000.0

MLA_HEADS = 6
MLA_Q_RANK = 512
MLA_KV_RANK = 512
MLA_NOPE = 128
MLA_ROPE = 64
MLA_V = 128
MLA_Q_BLOCK = 128

SWA_HEADS = 6
SWA_KV_HEADS = 2
SWA_GROUP = SWA_HEADS // SWA_KV_HEADS
SWA_HEAD_DIM = 128
SWA_WINDOW = 128
SWA_BLOCK = SWA_WINDOW

GLA_HEADS = 4
GLA_DK = 64
GLA_DV = 128
GLA_GATE_RANK = 16
GLA_TAU = 16.0
GLA_CHUNK = 64

MIX_WIDTH = MLA_HEADS * MLA_V + SWA_HEADS * SWA_HEAD_DIM + GLA_HEADS * GLA_DV
FFN_HIDDEN = -(-8 * D_MODEL // (3 * 256)) * 256
N_MOD = 6

IN_SIZES = (MLA_Q_RANK, MLA_KV_RANK, MLA_ROPE,
            SWA_HEADS * SWA_HEAD_DIM, SWA_KV_HEADS * SWA_HEAD_DIM, SWA_KV_HEADS * SWA_HEAD_DIM,
            GLA_HEADS * GLA_DK, GLA_HEADS * GLA_DK, GLA_HEADS * GLA_DV,
            2 * GLA_GATE_RANK, GLA_HEADS * GLA_DV)
IN_WIDTH = sum(IN_SIZES)

kernel_name = 'hybrid_mla_swa_gla_dit'


def rmsnorm(x, g):
    x32 = x.astype(jnp.float32)
    y = x32 * lax.rsqrt(jnp.mean(x32 * x32, axis=-1, keepdims=True) + EPS)
    return (y * g.astype(jnp.float32)).astype(x.dtype)


def modulate(x, g, shift, scale):
    return rmsnorm(x, g) * (1 + scale) + shift


def rope_1d(x, pos):
    half = x.shape[-1] // 2
    freqs = ROPE_THETA ** (-jnp.arange(half, dtype=jnp.float32) / half)
    ang = pos.astype(jnp.float32)[:, None] * freqs
    cos = jnp.cos(ang)[:, None, :].astype(x.dtype)
    sin = jnp.sin(ang)[:, None, :].astype(x.dtype)
    x1, x2 = x[..., :half], x[..., half:]
    return jnp.concatenate([x1 * cos - x2 * sin, x2 * cos + x1 * sin], axis=-1)


def rope_2d(x, rows, cols):
    d = x.shape[-1] // 2
    return jnp.concatenate([rope_1d(x[..., :d], rows), rope_1d(x[..., d:], cols)], axis=-1)


def mla_q(cq, g_q, w_uq, pos):
    B, N, _ = cq.shape
    q = (rmsnorm(cq, g_q) @ w_uq).reshape(B, N, MLA_HEADS, MLA_NOPE + MLA_ROPE)
    q_nope, q_rope = q[..., :MLA_NOPE], q[..., MLA_NOPE:]
    if pos is not None:
        q_rope = rope_2d(q_rope, *pos)
    return q_nope, q_rope


def mla_kv(ckv, kr, g_kv, w_ukv, pos):
    B, N, _ = ckv.shape
    kv = (rmsnorm(ckv, g_kv) @ w_ukv).reshape(B, N, MLA_HEADS, MLA_NOPE + MLA_V)
    k_rope = kr[:, :, None, :]
    if pos is not None:
        k_rope = rope_2d(k_rope, *pos)
    return kv[..., :MLA_NOPE], k_rope[:, :, 0], kv[..., MLA_NOPE:]


def mla_attend(qn, qr, kn, kr, v):
    scale = (MLA_NOPE + MLA_ROPE) ** -0.5
    s = (jnp.einsum('bqhd,bkhd->bhqk', qn, kn)
         + jnp.einsum('bqhr,bkr->bhqk', qr, kr)).astype(jnp.float32) * scale
    p = jax.nn.softmax(s, axis=-1).astype(v.dtype)
    return jnp.einsum('bhqk,bkhd->bqhd', p, v)


def mla_latent(qn, qr, kn, kr, v):
    B, N, H, _ = qn.shape
    nb = N // MLA_Q_BLOCK
    to_blocks = lambda t: jnp.moveaxis(t.reshape(B, nb, MLA_Q_BLOCK, *t.shape[2:]), 1, 0)
    out = lax.map(lambda qs: mla_attend(qs[0], qs[1], kn, kr, v), (to_blocks(qn), to_blocks(qr)))
    return jnp.moveaxis(out, 0, 1).reshape(B, N, H * MLA_V)


def sink_softmax(scores, sink):
    sink = jnp.broadcast_to(sink.astype(jnp.float32), scores.shape[:-1] + (1,))
    p = jax.nn.softmax(jnp.concatenate([scores, sink], axis=-1), axis=-1)
    return p[..., :-1]


def swa_latent(q, k, v, kc, vc, sink):
    B, N = q.shape[:2]
    nb = N // SWA_BLOCK
    band_len = 3 * SWA_BLOCK
    scale = SWA_HEAD_DIM ** -0.5
    qb = q.reshape(B, nb, SWA_BLOCK, SWA_KV_HEADS, SWA_GROUP, SWA_HEAD_DIM)

    def band(t):
        tp = jnp.pad(t, ((0, 0), (SWA_BLOCK, SWA_BLOCK), (0, 0), (0, 0)))
        tp = tp.reshape(B, nb + 2, SWA_BLOCK, SWA_KV_HEADS, SWA_HEAD_DIM)
        return jnp.concatenate([tp[:, :-2], tp[:, 1:-1], tp[:, 2:]], axis=2)

    kb, vb = band(k), band(v)
    blk = jnp.arange(nb)[:, None, None] * SWA_BLOCK
    qpos = blk + jnp.arange(SWA_BLOCK)[None, :, None]
    kpos = blk - SWA_BLOCK + jnp.arange(band_len)[None, None, :]
    valid = (jnp.abs(qpos - kpos) <= SWA_WINDOW) & (kpos >= 0) & (kpos < N)
    s_loc = jnp.einsum('bnqhgd,bnkhd->bnhgqk', qb, kb).astype(jnp.float32) * scale
    s_loc = jnp.where(valid[None, :, None, None], s_loc, -jnp.inf)
    s_ctx = jnp.einsum('bnqhgd,bkhd->bnhgqk', qb, kc).astype(jnp.float32) * scale
    sink_b = sink.reshape(SWA_KV_HEADS, SWA_GROUP)[None, None, :, :, None, None]
    p = sink_softmax(jnp.concatenate([s_loc, s_ctx], axis=-1), sink_b).astype(v.dtype)
    o = (jnp.einsum('bnhgqk,bnkhd->bnqhgd', p[..., :band_len], vb)
         + jnp.einsum('bnhgqk,bkhd->bnqhgd', p[..., band_len:], vc))
    return o.reshape(B, N, SWA_HEADS * SWA_HEAD_DIM)


def swa_context(qc, kc, vc, sink):
    B, C = qc.shape[:2]
    qg = qc.reshape(B, C, SWA_KV_HEADS, SWA_GROUP, SWA_HEAD_DIM)
    s = jnp.einsum('bqhgd,bkhd->bhgqk', qg, kc).astype(jnp.float32) * SWA_HEAD_DIM ** -0.5
    p = sink_softmax(s, sink.reshape(SWA_KV_HEADS, SWA_GROUP)[None, :, :, None, None])
    o = jnp.einsum('bhgqk,bkhd->bqhgd', p.astype(vc.dtype), vc)
    return o.reshape(B, C, SWA_HEADS * SWA_HEAD_DIM)


def gla_prepare(parts, w_f, b_f, w_b, b_b):
    q, k, v, glr, r = parts
    B, N, _ = q.shape
    shp = (B, N, GLA_HEADS, GLA_DK)
    la_f = jax.nn.log_sigmoid((glr[..., :GLA_GATE_RANK] @ w_f + b_f).astype(jnp.float32)) / GLA_TAU
    la_b = jax.nn.log_sigmoid((glr[..., GLA_GATE_RANK:] @ w_b + b_b).astype(jnp.float32)) / GLA_TAU
    return (q.reshape(shp), k.reshape(shp), v.reshape(B, N, GLA_HEADS, GLA_DV),
            la_f.reshape(shp), la_b.reshape(shp), r)


def gla_chunked(q, k, v, log_a, s0, strict, want_out):
    B, N, H, DK = q.shape
    DV = v.shape[-1]
    L = GLA_CHUNK
    nc = N // L
    f32 = jnp.float32
    qc = q.astype(f32).reshape(B, nc, L, H, DK) * DK ** -0.5
    kc = k.astype(f32).reshape(B, nc, L, H, DK)
    vc = v.astype(f32).reshape(B, nc, L, H, DV)
    b = jnp.cumsum(log_a.astype(f32).reshape(B, nc, L, H, DK), axis=2)
    b_last = b[:, :, -1]
    dS = jnp.einsum('bclhd,bclhe->bchde', kc * jnp.exp(b_last[:, :, None] - b), vc)
    decay = jnp.exp(b_last)[..., None]

    def step(S, inp):
        dec, ds = inp
        return dec * S + ds, S

    s_fin, s_in = lax.scan(step, s0, (jnp.moveaxis(decay, 1, 0), jnp.moveaxis(dS, 1, 0)))
    if not want_out:
        return None, s_fin
    s_in = jnp.moveaxis(s_in, 0, 1)
    q_in = qc * jnp.exp(b)
    k_in = kc * jnp.exp(-b)
    mask = jnp.tril(jnp.ones((L, L), dtype=bool), -1 if strict else 0)
    A = jnp.where(mask, jnp.einsum('bclhd,bcmhd->bchlm', q_in, k_in), 0.0)
    o = (jnp.einsum('bchlm,bcmhe->bclhe', A, vc)
         + jnp.einsum('bclhd,bchde->bclhe', q_in, s_in))
    return o.reshape(B, N, H, DV).astype(v.dtype), s_fin


def gla_bidir(q, k, v, la_f, la_b, s0_f, s0_b, want_out):
    flip = lambda t: jnp.flip(t, axis=1)
    o_f, s_f = gla_chunked(q, k, v, la_f, s0_f, False, want_out)
    o_b, s_b = gla_chunked(flip(q), flip(k), flip(v), flip(la_b), s0_b, True, want_out)
    o = o_f + flip(o_b) if want_out else None
    return o, s_f, s_b


def gla_output(o, r, g_out):
    B, N = o.shape[:2]
    o = rmsnorm(o, g_out.reshape(GLA_HEADS, GLA_DV)) * jax.nn.silu(r).reshape(B, N, GLA_HEADS, GLA_DV)
    return o.reshape(B, N, GLA_HEADS * GLA_DV)


def swiglu(h, w_gu, w_down):
    gu = h @ w_gu
    return (jax.nn.silu(gu[..., :FFN_HIDDEN]) * gu[..., FFN_HIDDEN:]) @ w_down


def setup_inputs(seed: int = 0) -> dict:
    key = jax.random.key(seed)
    ks = jax.random.split(key, 24)
    f32 = jnp.float32
    nrm = lambda k, shape, s: jax.random.normal(k, shape, f32) * s
    gain = lambda k, shape: 1.0 + 0.02 * jax.random.normal(k, shape, f32)
    D, L = D_MODEL, DEPTH
    return {
        'x': nrm(ks[0], (BATCH, SEQ, D), 1.0),
        'c': nrm(ks[1], (BATCH, D), 1.0),
        'ctx': nrm(ks[2], (BATCH, CTX_LEN, D), 1.0),
        'c_ctx': nrm(ks[3], (D,), 1.0),
        'w_mod': nrm(ks[4], (L, D, N_MOD * D), 0.5 * D ** -0.5),
        'b_mod': nrm(ks[5], (L, N_MOD * D), 0.02),
        'g_mix': gain(ks[6], (L, D)),
        'g_ffn': gain(ks[7], (L, D)),
        'w_in': nrm(ks[8], (L, D, IN_WIDTH), D ** -0.5),
        'g_mla_q': gain(ks[9], (L, MLA_Q_RANK)),
        'g_mla_kv': gain(ks[10], (L, MLA_KV_RANK)),
        'w_mla_uq': nrm(ks[11], (L, MLA_Q_RANK, MLA_HEADS * (MLA_NOPE + MLA_ROPE)), MLA_Q_RANK ** -0.5),
        'w_mla_ukv': nrm(ks[12], (L, MLA_KV_RANK, MLA_HEADS * (MLA_NOPE + MLA_V)), MLA_KV_RANK ** -0.5),
        'swa_sink': nrm(ks[13], (L, SWA_HEADS), 0.5),
        'w_gla_gate_f': nrm(ks[14], (L, GLA_GATE_RANK, GLA_HEADS * GLA_DK), GLA_GATE_RANK ** -0.5),
        'b_gla_gate_f': nrm(ks[15], (L, GLA_HEADS * GLA_DK), 0.1),
        'w_gla_gate_b': nrm(ks[16], (L, GLA_GATE_RANK, GLA_HEADS * GLA_DK), GLA_GATE_RANK ** -0.5),
        'b_gla_gate_b': nrm(ks[17], (L, GLA_HEADS * GLA_DK), 0.1),
        'g_gla_out': gain(ks[18], (L, GLA_HEADS * GLA_DV)),
        'w_out': nrm(ks[19], (L, MIX_WIDTH, D), MIX_WIDTH ** -0.5),
        'w_ffn_gu': nrm(ks[20], (L, D, 2 * FFN_HIDDEN), D ** -0.5),
        'w_ffn_down': nrm(ks[21], (L, FFN_HIDDEN, D), FFN_HIDDEN ** -0.5),
        'g_final': gain(ks[22], (D,)),
    }


def reference(x, c, ctx, c_ctx, w_mod, b_mod, g_mix, g_ffn, w_in, g_mla_q, g_mla_kv,
              w_mla_uq, w_mla_ukv, swa_sink, w_gla_gate_f, b_gla_gate_f, w_gla_gate_b,
              b_gla_gate_b, g_gla_out, w_out, w_ffn_gu, w_ffn_down, g_final):
    B, N, D = x.shape
    C = ctx.shape[1]
    rows = N // GRID_W
    row_ids = jnp.repeat(jnp.arange(rows, dtype=jnp.int32), GRID_W)
    col_ids = jnp.tile(jnp.arange(GRID_W, dtype=jnp.int32), rows)
    pos = (row_ids, col_ids)
    split_pts = np.cumsum(IN_SIZES)[:-1].tolist()
    state0 = jnp.zeros((B, GLA_HEADS, GLA_DK, GLA_DV), jnp.float32)
    xc = ctx
    for l in range(DEPTH):
        last = l == DEPTH - 1
        mod_l = (jax.nn.silu(c) @ w_mod[l] + b_mod[l]).reshape(B, 1, N_MOD, D)
        mod_c = (jax.nn.silu(c_ctx) @ w_mod[l] + b_mod[l]).reshape(1, 1, N_MOD, D)

        pl = jnp.split(modulate(x, g_mix[l], mod_l[:, :, 0], mod_l[:, :, 1]) @ w_in[l], split_pts, axis=-1)
        pc = jnp.split(modulate(xc, g_mix[l], mod_c[:, :, 0], mod_c[:, :, 1]) @ w_in[l], split_pts, axis=-1)

        kn_l, kr_l, v_l = mla_kv(pl[1], pl[2], g_mla_kv[l], w_mla_ukv[l], pos)
        kn_c, kr_c, v_c = mla_kv(pc[1], pc[2], g_mla_kv[l], w_mla_ukv[l], None)
        qn_l, qr_l = mla_q(pl[0], g_mla_q[l], w_mla_uq[l], pos)
        mla_l = mla_latent(qn_l, qr_l,
                           jnp.concatenate([kn_l, kn_c], axis=1),
                           jnp.concatenate([kr_l, kr_c], axis=1),
                           jnp.concatenate([v_l, v_c], axis=1))

        q_sl = rope_2d(pl[3].reshape(B, N, SWA_HEADS, SWA_HEAD_DIM), *pos)
        k_sl = rope_2d(pl[4].reshape(B, N, SWA_KV_HEADS, SWA_HEAD_DIM), *pos)
        v_sl = pl[5].reshape(B, N, SWA_KV_HEADS, SWA_HEAD_DIM)
        k_sc = pc[4].reshape(B, C, SWA_KV_HEADS, SWA_HEAD_DIM)
        v_sc = pc[5].reshape(B, C, SWA_KV_HEADS, SWA_HEAD_DIM)
        swa_l = swa_latent(q_sl, k_sl, v_sl, k_sc, v_sc, swa_sink[l])

        gw = (w_gla_gate_f[l], b_gla_gate_f[l], w_gla_gate_b[l], b_gla_gate_b[l])
        q_gc, k_gc, v_gc, af_c, ab_c, r_gc = gla_prepare(pc[6:], *gw)
        o_gc, s_f, s_b = gla_bidir(q_gc, k_gc, v_gc, af_c, ab_c, state0, state0, not last)
        q_gl, k_gl, v_gl, af_l, ab_l, r_gl = gla_prepare(pl[6:], *gw)
        o_gl, _, _ = gla_bidir(q_gl, k_gl, v_gl, af_l, ab_l, s_f, s_b, True)
        gla_l = gla_output(o_gl, r_gl, g_gla_out[l])

        mix_l = jnp.concatenate([mla_l, swa_l, gla_l], axis=-1) @ w_out[l]
        x = x + mod_l[:, :, 2] * mix_l
        h = modulate(x, g_ffn[l], mod_l[:, :, 3], mod_l[:, :, 4])
        x = x + mod_l[:, :, 5] * swiglu(h, w_ffn_gu[l], w_ffn_down[l])

        if not last:
            qn_c, qr_c = mla_q(pc[0], g_mla_q[l], w_mla_uq[l], None)
            mla_c = mla_attend(qn_c, qr_c, kn_c, kr_c, v_c).reshape(B, C, MLA_HEADS * MLA_V)
            swa_c = swa_context(pc[3], k_sc, v_sc, swa_sink[l])
            gla_c = gla_output(o_gc, r_gc, g_gla_out[l])
            mix_c = jnp.concatenate([mla_c, swa_c, gla_c], axis=-1) @ w_out[l]
            xc = xc + mod_c[:, :, 2] * mix_c
            hc = modulate(xc, g_ffn[l], mod_c[:, :, 3], mod_c[:, :, 4])
            xc = xc + mod_c[:, :, 5] * swiglu(hc, w_ffn_gu[l], w_ffn_down[l])
    return rmsnorm(x, g_final)
```

```cpp
#include <hip/hip_runtime.h>
#include <cstdio>
#include <cstdint>
#include <cmath>

constexpr int D_MODEL = 2048, BATCH = 8, SEQ = 4096, DEPTH = 4, CTX = 256;
constexpr int NLAT = BATCH * SEQ;
constexpr int NCTX = BATCH * CTX;
constexpr int NTOK = NLAT + NCTX;
constexpr int IN_W = 3936, IN_WP = 4096;
constexpr int FFN = 5632, NMOD = 6;
constexpr int UQ_W = 1152, UQ_WP = 1280, UKV_W = 1536;
constexpr float EPS = 1e-6f;
constexpr int C_CQ = 0, C_CKV = 512, C_KR = 1024, C_QS = 1088, C_KS = 1856, C_VS = 2112, C_GQ = 2368, C_GK = 2624, C_GV = 2880, C_GLR = 3392, C_GR = 3424;
constexpr int MX_MLA = 0, MX_SWA = 768, MX_GLA = 1536;

namespace pg8 {
#define PG8_LAS __attribute__((address_space(3)))
typedef unsigned short bf16_t;
typedef short bf16x8 __attribute__((ext_vector_type(8)));
typedef float f32x4 __attribute__((ext_vector_type(4)));
typedef unsigned u32x4 __attribute__((ext_vector_type(4)));
constexpr int BM = 256, BK = 64, HALF = 128, HTB = HALF * BK * 2  , STAGE_BYTES = 8 * HTB, NXCD = 8, WGM = 8;

__host__ __device__ __forceinline__ int lds_byte(int r, int c) { const int st = (r >> 4) * 2 + (c >> 5), rr = r & 15, cc = c & 31, ob = rr * 64 + cc * 2; return st * 1024 + (ob ^ (((ob >> 9) & 1) << 5)); }
__host__ __device__ __forceinline__ void stage_rc(int b, int& R, int& C) { const int st = b / 1024, sb = b % 1024, swz = sb ^ (((sb >> 9) & 1) << 5); R = (st >> 1) * 16 + swz / 64; C = (st & 1) * 32 + (swz % 64) / 2; }
__host__ __device__ __forceinline__ int perm32(int rho) { const int n = rho >> 4, i = rho & 15; return 8 * (i >> 2) + 4 * n + (i & 3); }

struct Unit { int pm, pn; };
struct Gemm { const bf16_t* A; const bf16_t* Bt; int M, N, K, lda, a_split_pn, a_split_off; };

struct StaticOrder {
    int nM, nN, nwg, G, c;
    __host__ __device__ void init(int M, int N, int G_, int c_) { nM = M / BM; nN = N / BM; nwg = nM * nN; G = G_; c = c_; }
    __host__ __device__ bool next(int i, Unit& u) const {
        const long L = (long)i * G + c; if (L >= nwg) return false;
        int wgid = (int)L; { const int q = nwg / NXCD, r = nwg % NXCD, xcd = wgid % NXCD, off = wgid / NXCD; wgid = (xcd < r ? xcd * (q + 1) : r * (q + 1) + (xcd - r) * q) + off; }
        const int nig = WGM * nN, gid = wgid / nig, fm = gid * WGM, gsz = (nM - fm) < WGM ? (nM - fm) : WGM;
        u.pm = fm + ((wgid % nig) % gsz); u.pn = (wgid % nig) / gsz; return true;
    }
    __device__ __forceinline__ void a_ready(const Unit&) const {}
    __device__ __forceinline__ void done(const Unit&) const {}
};

typedef float f32x2_t __attribute__((ext_vector_type(2))); typedef __bf16 bf16x2_t __attribute__((ext_vector_type(2)));
__device__ __forceinline__ unsigned cvt_pk_bf16(float lo, float hi) { f32x2_t v = {lo, hi}; bf16x2_t b = __builtin_convertvector(v, bf16x2_t); return __builtin_bit_cast(unsigned, b); }
typedef float f32x2 __attribute__((ext_vector_type(2)));
__device__ __forceinline__ float fast_sigmoid(float x) { return __builtin_amdgcn_rcpf(1.0f + __builtin_amdgcn_exp2f(-1.4426950408889634f * x)); }
struct EpiStoreBf16 {
    static constexpr bool PERM = true, AFTER_DRAIN = false;
    bf16_t* O; int ldc;
    __device__ __forceinline__ void operator()(const f32x4 (&acc)[2][2][4][2], const Unit& u, int wr, int wc, int fr, int fq) const {
        const int row0 = u.pm * BM + wr * 64 + fr, col0 = u.pn * BM + wc * 32 + 8 * fq;
#pragma unroll
        for (int ai = 0; ai < 2; ++ai)
#pragma unroll
            for (int m = 0; m < 4; ++m) { bf16_t* rowp = O + (size_t)(row0 + ai * HALF + m * 16) * ldc + col0;
#pragma unroll
                for (int bj = 0; bj < 2; ++bj) { const f32x4 v0 = acc[ai][bj][m][0], v1 = acc[ai][bj][m][1];
                    u32x4 w; w.x = cvt_pk_bf16(v0[0], v0[1]); w.y = cvt_pk_bf16(v0[2], v0[3]); w.z = cvt_pk_bf16(v1[0], v1[1]); w.w = cvt_pk_bf16(v1[2], v1[3]);
                    *(u32x4*)(rowp + bj * HALF) = w; } }
    }
};
struct EpiQKV {
    static constexpr bool PERM = true, AFTER_DRAIN = false;
    bf16_t* Oq; int ldq; bf16_t* Okv; int ldkv; const float* rq; const float* rkv; int split;
    __device__ __forceinline__ void operator()(const f32x4 (&acc)[2][2][4][2], const Unit& u, int wr, int wc, int fr, int fq) const {
        const bool first = u.pn < split;
        bf16_t* base = first ? Oq : Okv; const int ld = first ? ldq : ldkv; const float* rs = first ? rq : rkv;
        const int row0 = u.pm * BM + wr * 64 + fr, col0 = (first ? u.pn : u.pn - split) * BM + wc * 32 + 8 * fq;
#pragma unroll
        for (int ai = 0; ai < 2; ++ai)
#pragma unroll
            for (int m = 0; m < 4; ++m) { const int row = row0 + ai * HALF + m * 16; const float s = rs[row]; bf16_t* rowp = base + (size_t)row * ld + col0;
#pragma unroll
                for (int bj = 0; bj < 2; ++bj) { const f32x4 v0 = acc[ai][bj][m][0] * s, v1 = acc[ai][bj][m][1] * s;
                    u32x4 w; w.x = cvt_pk_bf16(v0[0], v0[1]); w.y = cvt_pk_bf16(v0[2], v0[3]); w.z = cvt_pk_bf16(v1[0], v1[1]); w.w = cvt_pk_bf16(v1[2], v1[3]);
                    *(u32x4*)(rowp + bj * HALF) = w; } }
    }
};
struct EpiRes {
    static constexpr bool PERM = false, AFTER_DRAIN = false;
    const float* base_l; const float* base_c; float* out_l; float* out_c; const float* gate; int gpitch; int ncols;
    __device__ __forceinline__ void operator()(const f32x4 (&acc)[2][2][4][2], const Unit& u, int wr, int wc, int fr, int fq) const {
        const bool lat = u.pm < (NLAT / BM);
        const int gi = lat ? (u.pm >> 4) : BATCH;
        const float* bs = lat ? base_l : base_c; float* os = lat ? out_l : out_c;
        const int row0 = (lat ? u.pm : u.pm - NLAT / BM) * BM + wr * 64 + fr, col0 = u.pn * BM + wc * 32 + 4 * fq;
        f32x4 gv[2][2];
#pragma unroll
        for (int bj = 0; bj < 2; ++bj)
#pragma unroll
            for (int n = 0; n < 2; ++n) gv[bj][n] = *(const f32x4*)(gate + (size_t)gi * gpitch + col0 + bj * HALF + n * 16);
#pragma unroll
        for (int ai = 0; ai < 2; ++ai)
#pragma unroll
            for (int m = 0; m < 4; ++m) { const size_t off = (size_t)(row0 + ai * HALF + m * 16) * ncols + col0;
#pragma unroll
                for (int bj = 0; bj < 2; ++bj)
#pragma unroll
                    for (int n = 0; n < 2; ++n) { const f32x4 b = *(const f32x4*)(bs + off + bj * HALF + n * 16); *(f32x4*)(os + off + bj * HALF + n * 16) = b + gv[bj][n] * acc[ai][bj][m][n]; }
                asm volatile("" ::: "memory"); }
    }
};
struct EpiSwiglu {
    static constexpr bool PERM = true, AFTER_DRAIN = false;
    bf16_t* O; int ldc;
    __device__ __forceinline__ void operator()(const f32x4 (&acc)[2][2][4][2], const Unit& u, int wr, int wc, int fr, int fq) const {
        const int row0 = u.pm * BM + wr * 64 + fr, col0 = u.pn * HALF + wc * 32 + 8 * fq;
#pragma unroll
        for (int ai = 0; ai < 2; ++ai)
#pragma unroll
            for (int m = 0; m < 4; ++m) { bf16_t* rowp = O + (size_t)(row0 + ai * HALF + m * 16) * ldc + col0;
                float r[8];
#pragma unroll
                for (int n = 0; n < 2; ++n)
#pragma unroll
                    for (int i = 0; i < 4; ++i) { const float g = acc[ai][0][m][n][i], up = acc[ai][1][m][n][i]; r[n * 4 + i] = g * fast_sigmoid(g) * up; }
                u32x4 w; w.x = cvt_pk_bf16(r[0], r[1]); w.y = cvt_pk_bf16(r[2], r[3]); w.z = cvt_pk_bf16(r[4], r[5]); w.w = cvt_pk_bf16(r[6], r[7]);
                *(u32x4*)rowp = w; }
    }
};

template <class Epi, class Sched, bool ALIGN_EPI = true>
__device__ __forceinline__ void gemm_phase(PG8_LAS unsigned char* lds, const Gemm g, const Sched& S, const Epi& E, const int tid) {
    const int wid = __builtin_amdgcn_readfirstlane(tid >> 6), lane = tid & 63, wr = wid >> 2, wc = wid & 3, fr = lane & 15, fq = lane >> 4;
    const int K = g.K, nt = K / BK;
    unsigned voffA[2], voffB[2];
#pragma unroll
    for (int i = 0; i < 2; ++i) { int R, C; stage_rc(tid * 16 + i * 8192, R, C); const int Rb = Epi::PERM ? ((R & ~31) + perm32(R & 31)) : R;
        voffA[i] = (unsigned)(R * g.lda + C) * 2u; voffB[i] = (unsigned)(Rb * K + C) * 2u; }
    const size_t kstep = (size_t)(BK * 2);
    const size_t hstepA = (size_t)HALF * g.lda * 2, hstepB = (size_t)HALF * K * 2;
    const size_t tstepA = 2 * hstepA, tstepB = 2 * hstepB;
#define PG8_AOFF(u) ((size_t)(u).pm * tstepA + ((u).pn >= g.a_split_pn ? (size_t)g.a_split_off * 2 : (size_t)0))
    const unsigned ldsw = (unsigned)wid * 1024u;
    const int aoff = lds_byte(wr * 64 + fr, fq * 8), boff = lds_byte(wc * 32 + fr, fq * 8);
#define PG8_SA(b, h) (((b) * 2 + (h)) * HTB)
#define PG8_SB(b, h) ((4 + (b) * 2 + (h)) * HTB)
#define PG8_STAGE(bufoff, gbase, voff) do { _Pragma("unroll") for (int _i = 0; _i < 2; ++_i) \
        __builtin_amdgcn_global_load_lds((const unsigned*)((const char*)(gbase) + (voff)[_i]), (PG8_LAS unsigned*)(lds + (bufoff) + ldsw + _i * 8192), 16, 0, 0); } while (0)
#define PG8_LDA(dst, b, h) do { _Pragma("unroll") for (int m = 0; m < 4; ++m) _Pragma("unroll") for (int k = 0; k < 2; ++k) dst[m][k] = *(const PG8_LAS bf16x8*)(lds + PG8_SA(b, h) + aoff + m * 2048 + k * 1024); } while (0)
#define PG8_LDB(dst, b, h) do { _Pragma("unroll") for (int n = 0; n < 2; ++n) _Pragma("unroll") for (int k = 0; k < 2; ++k) dst[n][k] = *(const PG8_LAS bf16x8*)(lds + PG8_SB(b, h) + boff + n * 2048 + k * 1024); } while (0)
#define PG8_MMA(ai, bj, At, Bt) do { __builtin_amdgcn_s_setprio(1); _Pragma("unroll") for (int m = 0; m < 4; ++m) _Pragma("unroll") for (int n = 0; n < 2; ++n) _Pragma("unroll") for (int k = 0; k < 2; ++k) \
        acc[ai][bj][m][n] = __builtin_amdgcn_mfma_f32_16x16x32_bf16(Bt[n][k], At[m][k], acc[ai][bj][m][n], 0, 0, 0); __builtin_amdgcn_s_setprio(0); } while (0)
#define PG8_WAIT_V(n) asm volatile("s_waitcnt vmcnt(" #n ")" ::: "memory")
#define PG8_WAIT_L(n) asm volatile("s_waitcnt lgkmcnt(" #n ")" ::: "memory")
#define PG8_BAR __builtin_amdgcn_s_barrier()
#define PG8_SCHED __builtin_amdgcn_sched_barrier(0)
    Unit cur, nxt; int ui = 0;
    if (!S.next(0, cur)) return;
    f32x4 acc[2][2][4][2];
#pragma unroll
    for (int a = 0; a < 2; ++a)
#pragma unroll
        for (int b = 0; b < 2; ++b)
#pragma unroll
            for (int m = 0; m < 4; ++m)
#pragma unroll
                for (int n = 0; n < 2; ++n) acc[a][b][m][n] = (f32x4){0.f, 0.f, 0.f, 0.f};
    bf16x8 At[4][2], B0[2][2], B1[2][2];
    const char* cA = (const char*)g.A + PG8_AOFF(cur); const char* cB = (const char*)g.Bt + (size_t)cur.pn * tstepB;
    S.a_ready(cur);
    {
        PG8_STAGE(PG8_SB(0, 0), cB, voffB); PG8_STAGE(PG8_SB(0, 1), cB + hstepB, voffB); PG8_STAGE(PG8_SA(0, 0), cA, voffA); PG8_STAGE(PG8_SA(0, 1), cA + hstepA, voffA);
        if (wr == 1) PG8_BAR;
        PG8_WAIT_V(2); PG8_BAR;
        PG8_STAGE(PG8_SB(1, 0), cB + kstep, voffB); PG8_STAGE(PG8_SA(1, 0), cA + kstep, voffA); PG8_STAGE(PG8_SB(1, 1), cB + hstepB + kstep, voffB);
        PG8_WAIT_V(6); PG8_BAR;
    }
    for (;;) {
        const bool has_next = S.next(ui + 1, nxt);
        const char* nA = has_next ? (const char*)g.A + PG8_AOFF(nxt) : cA; const char* nB = has_next ? (const char*)g.Bt + (size_t)nxt.pn * tstepB : cB;
        for (int t = 0; t < nt; t += 2) {
            const bool last = (t == nt - 2);
            const char* a1 = cA + (size_t)(t + 1) * kstep;
            const char* a2 = last ? nA : cA + (size_t)(t + 2) * kstep; const char* b2 = last ? nB : cB + (size_t)(t + 2) * kstep;
            const char* a3 = a2 + kstep; const char* b3 = b2 + kstep;
            if (last && has_next) S.a_ready(nxt);
            {
            PG8_LDB(B0, 0, 0); PG8_LDB(B1, 0, 1); PG8_SCHED; PG8_LDA(At, 0, 0); PG8_STAGE(PG8_SA(1, 1), a1 + hstepA, voffA);
            PG8_WAIT_V(8); PG8_WAIT_L(0); PG8_BAR; PG8_MMA(0, 0, At, B0); PG8_MMA(0, 1, At, B1); PG8_BAR; PG8_SCHED;
            PG8_LDA(At, 0, 1); PG8_STAGE(PG8_SB(0, 0), b2, voffB); PG8_STAGE(PG8_SB(0, 1), b2 + hstepB, voffB); PG8_STAGE(PG8_SA(0, 0), a2, voffA);
            PG8_WAIT_V(8); PG8_WAIT_L(0); PG8_BAR; PG8_MMA(1, 0, At, B0); PG8_MMA(1, 1, At, B1); PG8_BAR; PG8_SCHED;
            PG8_LDB(B0, 1, 0); PG8_LDB(B1, 1, 1); PG8_SCHED; PG8_LDA(At, 1, 0); PG8_STAGE(PG8_SA(0, 1), a2 + hstepA, voffA);
            PG8_WAIT_V(8); PG8_WAIT_L(0); PG8_BAR; PG8_MMA(0, 0, At, B0); PG8_MMA(0, 1, At, B1); PG8_BAR; PG8_SCHED;
            PG8_LDA(At, 1, 1); PG8_STAGE(PG8_SB(1, 0), b3, voffB); PG8_STAGE(PG8_SB(1, 1), b3 + hstepB, voffB); PG8_STAGE(PG8_SA(1, 0), a3, voffA);
            PG8_WAIT_V(8); PG8_WAIT_L(0); PG8_BAR; PG8_MMA(1, 0, At, B0); PG8_MMA(1, 1, At, B1); PG8_BAR; PG8_SCHED;
            }
        }
        if constexpr (ALIGN_EPI) { if (wr == 0) PG8_BAR; }
        if constexpr (!Epi::AFTER_DRAIN) { E(acc, cur, wr, wc, fr, fq); S.done(cur); }
        if (!has_next) break;
#pragma unroll
        for (int a = 0; a < 2; ++a)
#pragma unroll
            for (int b = 0; b < 2; ++b)
#pragma unroll
                for (int m = 0; m < 4; ++m)
#pragma unroll
                    for (int n = 0; n < 2; ++n) acc[a][b][m][n] = (f32x4){0.f, 0.f, 0.f, 0.f};
        cur = nxt; cA = nA; cB = nB; ++ui;
        if constexpr (ALIGN_EPI) { if (wr == 1) PG8_BAR; }
    }
    PG8_WAIT_V(0);
    if constexpr (!ALIGN_EPI) { if (wr == 0) PG8_BAR; }
    PG8_BAR;
    if constexpr (Epi::AFTER_DRAIN) { E.fused(acc, cur, wr, wc, fr, fq, lds, wid, lane); S.done(cur); }
#undef PG8_AOFF
#undef PG8_SA
#undef PG8_SB
#undef PG8_STAGE
#undef PG8_LDA
#undef PG8_LDB
#undef PG8_MMA
#undef PG8_WAIT_V
#undef PG8_WAIT_L
#undef PG8_BAR
#undef PG8_SCHED
}
}
namespace att {
typedef unsigned short bf16;
using bf16x8 = __attribute__((ext_vector_type(8))) short;
using s16x4  = __attribute__((ext_vector_type(4))) short;
using f32x16 = __attribute__((ext_vector_type(16))) float;
using f32x4  = __attribute__((ext_vector_type(4))) float;
using u32x4  = __attribute__((ext_vector_type(4))) unsigned;
constexpr int NW = 8, QBLK = 32, KVBLK = 64, DV = 128;
constexpr float THR = 8.f;
#define ATT_SBAR() __builtin_amdgcn_sched_barrier(0)
__device__ __forceinline__ int crow(int r, int hi) { return (r & 3) + 8 * (r >> 2) + 4 * hi; }
typedef float f32x2_t __attribute__((ext_vector_type(2))); typedef __bf16 bf16x2_t __attribute__((ext_vector_type(2)));
__device__ __forceinline__ unsigned cvtpk(float lo, float hi) { f32x2_t v = {lo, hi}; bf16x2_t b = __builtin_convertvector(v, bf16x2_t); return __builtin_bit_cast(unsigned, b); }
__device__ __forceinline__ float bf2f(short s) { return __uint_as_float(((unsigned)(unsigned short)s) << 16); }
__device__ __forceinline__ short f2bf(float f) { unsigned u = __float_as_uint(f); u += 0x7fffu + ((u >> 16) & 1u); return (short)(u >> 16); }

template <int DQK> struct Cfg {
    static constexpr int KROW = DQK * 2 + 16;
    static constexpr int SHM_V = KVBLK * DV * 2, SHM_K = KVBLK * KROW;
    static constexpr int OFF_V = 0, OFF_K = 2 * SHM_V, OFF_WS = 2 * SHM_V + 2 * SHM_K, BYTES = OFF_WS + NW * 64 * 4;
};

__device__ __forceinline__ void partialSM(f32x16& p0, f32x16& p1, float& m_reg, float& mn, float& alpha, const float C, const float TS) {
    float pmax = p0[0];
#pragma unroll
    for (int r = 1; r < 16; ++r) pmax = fmaxf(pmax, p0[r]);
#pragma unroll
    for (int r = 0; r < 16; ++r) pmax = fmaxf(pmax, p1[r]);
    { auto rr = __builtin_amdgcn_permlane32_swap(__float_as_uint(pmax), __float_as_uint(pmax), false, false);
      pmax = fmaxf(__uint_as_float(rr[0]), __uint_as_float(rr[1])); }
    if (__builtin_expect(__all(pmax - m_reg <= TS), 1)) { mn = m_reg; alpha = 1.f; }
    else { mn = fmaxf(m_reg, pmax); alpha = __builtin_amdgcn_exp2f((m_reg - mn) * C); m_reg = mn; }
    const float mnC = -mn * C;
#pragma unroll
    for (int r = 0; r < 16; ++r) p0[r] = fmaf(p0[r], C, mnC);
#pragma unroll
    for (int r = 0; r < 16; ++r) p1[r] = fmaf(p1[r], C, mnC);
#pragma unroll
    for (int r = 0; r < 16; ++r) p0[r] = __builtin_amdgcn_exp2f(p0[r]);
}
__device__ __forceinline__ void finishSM(f32x16& p0, f32x16& p1, float alpha, float& l_reg, bf16x8& pa0, bf16x8& pa1, bf16x8& pa2, bf16x8& pa3) {
#pragma unroll
    for (int r = 0; r < 16; ++r) p1[r] = __builtin_amdgcn_exp2f(p1[r]);
    float ps = 0;
#pragma unroll
    for (int r = 0; r < 16; ++r) ps += p0[r];
#pragma unroll
    for (int r = 0; r < 16; ++r) ps += p1[r];
    { auto rr = __builtin_amdgcn_permlane32_swap(__float_as_uint(ps), __float_as_uint(ps), false, false);
      ps = __uint_as_float(rr[0]) + __uint_as_float(rr[1]); }
    l_reg = l_reg * alpha + ps;
#define ATT_PK4(P, BASE, OUT) do { unsigned a0 = cvtpk(P[BASE + 0], P[BASE + 1]), a1 = cvtpk(P[BASE + 2], P[BASE + 3]);   \
    unsigned b0 = cvtpk(P[BASE + 4], P[BASE + 5]), b1 = cvtpk(P[BASE + 6], P[BASE + 7]);                              \
    auto r0 = __builtin_amdgcn_permlane32_swap(a0, b0, false, false); auto r1 = __builtin_amdgcn_permlane32_swap(a1, b1, false, false); \
    u32x4 w = {r0[0], r1[0], r0[1], r1[1]}; OUT = *reinterpret_cast<bf16x8*>(&w); } while (0)
    ATT_PK4(p0, 0, pa0); ATT_PK4(p0, 8, pa1); ATT_PK4(p1, 0, pa2); ATT_PK4(p1, 8, pa3);
}
template <int DQK> __device__ __forceinline__ void qkt(f32x16& p0, f32x16& p1, const char* Ks, const bf16x8* qr, int r32, int hi) {
    constexpr int KROW = Cfg<DQK>::KROW;
    p0 = f32x16{}; p1 = f32x16{};
#pragma unroll
    for (int d0 = 0; d0 < DQK / 16; ++d0) { const int cb = (d0 * 16 + hi * 8) * 2;
        const bf16x8 b0 = *reinterpret_cast<const bf16x8*>(Ks + r32 * KROW + cb);
        const bf16x8 b1 = *reinterpret_cast<const bf16x8*>(Ks + (32 + r32) * KROW + cb);
        p0 = __builtin_amdgcn_mfma_f32_32x32x16_bf16(b0, qr[d0], p0, 0, 0, 0);
        p1 = __builtin_amdgcn_mfma_f32_32x32x16_bf16(b1, qr[d0], p1, 0, 0, 0); }
}
__device__ __forceinline__ int v_st(int k, int c) { const int kk = (k & ~0xC) | ((k & 4) << 1) | ((k & 8) >> 1); return ((kk >> 3) * 4 + (c >> 5)) * 512 + ((kk & 7) * 32 + (c & 31)) * 2; }
__device__ __forceinline__ int v_rd_base(int lane) { return ((lane & 3) << 3) | (((lane >> 2) & 3) << 6) | (((lane >> 4) & 1) << 5) | (((lane >> 5) & 1) << 8); }
constexpr int v_rd_off(int d0, int ks, int half) { return d0 * 512 + ks * 4096 + half * 2048; }
template <int OFF> __device__ __forceinline__ s16x4 tr_read(int vb) { s16x4 r; asm volatile("ds_read_b64_tr_b16 %0, %1 offset:%2" : "=&v"(r) : "v"(vb), "i"(OFF) : "memory"); return r; }
template <int D0> __device__ __forceinline__ void pv_one(f32x16& od, int vb, bf16x8 pa0, bf16x8 pa1, bf16x8 pa2, bf16x8 pa3) {
    const s16x4 l0 = tr_read<v_rd_off(D0, 0, 0)>(vb), h0 = tr_read<v_rd_off(D0, 0, 1)>(vb), l1 = tr_read<v_rd_off(D0, 1, 0)>(vb), h1 = tr_read<v_rd_off(D0, 1, 1)>(vb);
    const s16x4 l2 = tr_read<v_rd_off(D0, 2, 0)>(vb), h2 = tr_read<v_rd_off(D0, 2, 1)>(vb), l3 = tr_read<v_rd_off(D0, 3, 0)>(vb), h3 = tr_read<v_rd_off(D0, 3, 1)>(vb);
    asm volatile("s_waitcnt lgkmcnt(0)" ::: "memory"); ATT_SBAR();
#define ATT_PK(L, H) (bf16x8){L[0], L[1], L[2], L[3], H[0], H[1], H[2], H[3]}
    od = __builtin_amdgcn_mfma_f32_32x32x16_bf16(pa0, ATT_PK(l0, h0), od, 0, 0, 0);
    od = __builtin_amdgcn_mfma_f32_32x32x16_bf16(pa1, ATT_PK(l1, h1), od, 0, 0, 0);
    od = __builtin_amdgcn_mfma_f32_32x32x16_bf16(pa2, ATT_PK(l2, h2), od, 0, 0, 0);
    od = __builtin_amdgcn_mfma_f32_32x32x16_bf16(pa3, ATT_PK(l3, h3), od, 0, 0, 0);
}
__device__ __forceinline__ void pv_d0(f32x16* o, int vb, bf16x8 pa0, bf16x8 pa1, bf16x8 pa2, bf16x8 pa3) {
    pv_one<0>(o[0], vb, pa0, pa1, pa2, pa3); pv_one<1>(o[1], vb, pa0, pa1, pa2, pa3); pv_one<2>(o[2], vb, pa0, pa1, pa2, pa3); pv_one<3>(o[3], vb, pa0, pa1, pa2, pa3);
}
__device__ __forceinline__ void rope_pair(bf16x8& a, bf16x8& b, const float* cs, const float* sn) {
    const f32x4 c0 = *(const f32x4*)cs, c1 = *(const f32x4*)(cs + 4), s0 = *(const f32x4*)sn, s1 = *(const f32x4*)(sn + 4);
#pragma unroll
    for (int e = 0; e < 8; ++e) { const float c = e < 4 ? c0[e & 3] : c1[e & 3], s = e < 4 ? s0[e & 3] : s1[e & 3]; const float x1 = bf2f(a[e]), x2 = bf2f(b[e]);
        a[e] = f2bf(x1 * c - x2 * s); b[e] = f2bf(x2 * c + x1 * s); }
}

struct Unit {
    const bf16* Q; long ldq;
    const bf16* Kn; long ldkn;
    const bf16* Kr; long ldkr;
    const bf16* V; long ldv;
    int t0a, nta, t0b, ntb;
    int mask;
    int qpos0, kpos0;
    int has_sink; float sink;
    int rope;
    const float* tab;
    bf16* O; long ldo;
};

template <int DQK, int SDEPTH>
__device__ __forceinline__ void attn_unit(const Unit& U, char* lds, const float scale, const int tid) {
    using C_ = Cfg<DQK>;
    constexpr int KROW = C_::KROW, SHM_V = C_::SHM_V, SHM_K = C_::SHM_K, ND = DQK / 16;
    const float C = scale * 1.4426950408889634f, TS = THR / scale;
    const int wid = tid >> 6, lane = tid & 63, r32 = lane & 31, hi = lane >> 5;
    char* V_lds = lds + C_::OFF_V; char* K_lds = lds + C_::OFF_K;
    float* ws = (float*)(lds + C_::OFF_WS) + wid * 64; float* li_l = ws; float* al_l = ws + 32;
    float m_reg = -1e30f, l_reg = 0; f32x16 o[4] = {}; bf16x8 qr[ND];
    const bf16* Qw = U.Q + (long)(wid * QBLK + r32) * U.ldq + hi * 8;
#pragma unroll
    for (int d0 = 0; d0 < ND; ++d0) qr[d0] = *reinterpret_cast<const bf16x8*>(Qw + d0 * 16);
    if (U.rope) {
        const int n = U.qpos0 + wid * QBLK + r32, prow = n >> 6, pcol = n & 63;
        if constexpr (DQK == 128) {
            const float* cr = U.tab + prow * 32 + hi * 8; const float* cc = U.tab + pcol * 32 + hi * 8;
            rope_pair(qr[0], qr[2], cr, cr + 2048); rope_pair(qr[1], qr[3], cr + 16, cr + 16 + 2048);
            rope_pair(qr[4], qr[6], cc, cc + 2048); rope_pair(qr[5], qr[7], cc + 16, cc + 16 + 2048);
        } else {
            const float* cr = U.tab + prow * 16 + hi * 8; const float* cc = U.tab + pcol * 16 + hi * 8;
            rope_pair(qr[8], qr[9], cr, cr + 1024); rope_pair(qr[10], qr[11], cc, cc + 1024);
        }
    }
    const int sr = tid >> 4, sc = (tid & 15) * 8, vst0 = v_st(sr, sc), vst1 = v_st(32 + sr, sc);
    const int kr_r = tid >> 3, kr_c = (tid & 7) * 8;
    const int vb0 = (int)(uintptr_t)V_lds + v_rd_base(lane);
    struct { bf16x8 vs0, vs1, ks0, ks1, kx; } sr_[SDEPTH];
    const int NT = U.nta + U.ntb;
#define ATT_TOK(j) ((j) < U.nta ? U.t0a + (j) * KVBLK : U.t0b + ((j) - U.nta) * KVBLK)
#define ATT_SLOAD(i, j) do { const long tk = ATT_TOK(j); \
    sr_[i].vs0 = *reinterpret_cast<const bf16x8*>(U.V + (tk + sr) * U.ldv + sc); sr_[i].vs1 = *reinterpret_cast<const bf16x8*>(U.V + (tk + 32 + sr) * U.ldv + sc); \
    sr_[i].ks0 = *reinterpret_cast<const bf16x8*>(U.Kn + (tk + sr) * U.ldkn + sc); sr_[i].ks1 = *reinterpret_cast<const bf16x8*>(U.Kn + (tk + 32 + sr) * U.ldkn + sc); \
    if constexpr (DQK == 192) sr_[i].kx = *reinterpret_cast<const bf16x8*>(U.Kr + (tk + kr_r) * U.ldkr + kr_c); } while (0)
#define ATT_SWRITE(b, i) do { *(bf16x8*)(V_lds + (b) * SHM_V + vst0) = sr_[i].vs0; *(bf16x8*)(V_lds + (b) * SHM_V + vst1) = sr_[i].vs1; \
    *(bf16x8*)(K_lds + (b) * SHM_K + sr * KROW + sc * 2) = sr_[i].ks0; *(bf16x8*)(K_lds + (b) * SHM_K + (32 + sr) * KROW + sc * 2) = sr_[i].ks1; \
    if constexpr (DQK == 192) *(bf16x8*)(K_lds + (b) * SHM_K + kr_r * KROW + (128 + kr_c) * 2) = sr_[i].kx; } while (0)
#define ATT_SWAIT() do { if constexpr (SDEPTH == 2) { if constexpr (DQK == 192) asm volatile("s_waitcnt vmcnt(5)" ::: "memory"); else asm volatile("s_waitcnt vmcnt(4)" ::: "memory"); } else asm volatile("s_waitcnt vmcnt(0)" ::: "memory"); } while (0)
#define ATT_RESC(a) do { if (__any((a) < 1.f)) { if (hi == 0) al_l[r32] = (a); asm volatile("s_waitcnt lgkmcnt(0)" ::: "memory"); \
    _Pragma("unroll") for (int d = 0; d < 4; ++d) _Pragma("unroll") for (int r = 0; r < 16; ++r) o[d][r] *= al_l[crow(r, hi)]; } } while (0)
    const int qpos = U.qpos0 + wid * QBLK + r32;
#define ATT_MASK(P0, P1, j) do { if (U.mask && (j) < U.nta) { const int kb = U.kpos0 + (j) * KVBLK + 4 * hi - qpos; \
    _Pragma("unroll") for (int r = 0; r < 16; ++r) { const int dk = kb + (r & 3) + 8 * (r >> 2); \
        if (dk > 128 || dk < -128) P0[r] = -INFINITY; if (dk + 32 > 128 || dk + 32 < -128) P1[r] = -INFINITY; } } } while (0)
    f32x16 pA0, pA1, pB0, pB1; float mnA, mnB, alA, alB; bf16x8 pa0, pa1, pa2, pa3;
    constexpr int SE = 0, SO = SDEPTH - 1;
    ATT_SLOAD(SE, 0); asm volatile("s_waitcnt vmcnt(0)" ::: "memory"); ATT_SWRITE(0, SE); __syncthreads();
    qkt<DQK>(pA0, pA1, K_lds, qr, r32, hi); ATT_MASK(pA0, pA1, 0); partialSM(pA0, pA1, m_reg, mnA, alA, C, TS);
    ATT_SLOAD(SO, 1); if constexpr (SDEPTH == 2) { if (2 < NT) ATT_SLOAD(SE, 2); }
    ATT_SWAIT(); ATT_SWRITE(1, SO); __syncthreads();
    for (int j = 1; j + 1 < NT; j += 2) {
        ATT_SBAR(); qkt<DQK>(pB0, pB1, K_lds + SHM_K, qr, r32, hi);
        finishSM(pA0, pA1, alA, l_reg, pa0, pa1, pa2, pa3); ATT_SBAR();
        ATT_SLOAD(SO, j + SDEPTH); ATT_SBAR();
        pv_d0(o, vb0, pa0, pa1, pa2, pa3); ATT_MASK(pB0, pB1, j); partialSM(pB0, pB1, m_reg, mnB, alB, C, TS);
        __syncthreads(); ATT_SWAIT(); ATT_SWRITE(0, SE);
        ATT_RESC(alB); __syncthreads();
        ATT_SBAR(); qkt<DQK>(pA0, pA1, K_lds, qr, r32, hi);
        finishSM(pB0, pB1, alB, l_reg, pa0, pa1, pa2, pa3); ATT_SBAR();
        if (SDEPTH == 1 || j + 3 < NT) ATT_SLOAD(SE, j + 1 + SDEPTH); ATT_SBAR();
        pv_d0(o, vb0 + SHM_V, pa0, pa1, pa2, pa3); ATT_MASK(pA0, pA1, j + 1); partialSM(pA0, pA1, m_reg, mnA, alA, C, TS);
        __syncthreads(); ATT_SWAIT(); ATT_SWRITE(1, SO);
        ATT_RESC(alA); __syncthreads();
    }
    ATT_SBAR(); qkt<DQK>(pB0, pB1, K_lds + SHM_K, qr, r32, hi);
    finishSM(pA0, pA1, alA, l_reg, pa0, pa1, pa2, pa3); ATT_SBAR();
    pv_d0(o, vb0, pa0, pa1, pa2, pa3); ATT_MASK(pB0, pB1, NT - 1); partialSM(pB0, pB1, m_reg, mnB, alB, C, TS);
    __syncthreads(); ATT_RESC(alB);
    finishSM(pB0, pB1, alB, l_reg, pa0, pa1, pa2, pa3); ATT_SBAR();
    pv_d0(o, vb0 + SHM_V, pa0, pa1, pa2, pa3);
    if (U.has_sink) l_reg += __builtin_amdgcn_exp2f(U.sink * 1.4426950408889634f - m_reg * C);
    if (hi == 0) li_l[r32] = l_reg; asm volatile("s_waitcnt lgkmcnt(0)" ::: "memory");
    float rli[16];
#pragma unroll
    for (int r = 0; r < 16; ++r) rli[r] = __builtin_amdgcn_rcpf(li_l[crow(r, hi)]);
    bf16* Ow = U.O + (long)(wid * QBLK) * U.ldo;
#pragma unroll
    for (int r = 0; r < 16; ++r) { const int orow = crow(r, hi);
#pragma unroll
        for (int d0 = 0; d0 < 4; ++d0) Ow[(long)orow * U.ldo + d0 * 32 + r32] = (bf16)f2bf(o[d0][r] * rli[r]); }
    __syncthreads();
#undef ATT_TOK
#undef ATT_SLOAD
#undef ATT_SWRITE
#undef ATT_SWAIT
#undef ATT_RESC
#undef ATT_MASK
}
}

namespace gla {
using att::bf16; using att::bf16x8; using att::s16x4; using att::f32x16; using att::f32x4; using att::u32x4; using att::crow; using att::cvtpk; using att::bf2f; using att::f2bf;
constexpr int ROWB = 144;
constexpr int OFF_QI = 0, OFF_KI = OFF_QI + 64 * ROWB, OFF_KDT = OFF_KI + 64 * ROWB, OFF_V = OFF_KDT + 64 * ROWB  , OFF_ST = OFF_V + 16384, OFF_SEG = OFF_ST + 128 * ROWB,
              OFF_DEC = OFF_SEG + 8 * 64 * 4, OFF_GLR = OFF_DEC + 256, BYTES = OFF_GLR + 8 * 128 * 4;
static_assert(OFF_V % 16 == 0 && OFF_ST % 16 == 0 && OFF_SEG % 16 == 0 && OFF_GLR % 16 == 0, "gla LDS map alignment");
struct Unit {
    const bf16* P; int ldp;
    const float* wg; const float* bg;
    float* og;
    int b, h, dir;
};
__device__ __forceinline__ float log_sigmoid(float z) { return fminf(z, 0.f) - __logf(1.f + __expf(-fabsf(z))); }

__device__ __forceinline__ void gla_unit(const Unit& U, char* lds, const int tid) {
    const int wid = __builtin_amdgcn_readfirstlane(tid >> 6), lane = tid & 63, r32 = lane & 31, hi = lane >> 5;
    const int d = lane, seg = wid;
    const int rh = wid & 1, eb = wid >> 1;
    const int h = U.h, dir = U.dir;
    float w[16];
#pragma unroll
    for (int j = 0; j < 16; ++j) w[j] = U.wg[j * 256 + h * 64 + d];
    const float bias = U.bg[h * 64 + d];
    float* SEG = (float*)(lds + OFF_SEG); float* DEC = (float*)(lds + OFF_DEC); float* GLR = (float*)(lds + OFF_GLR) + seg * 128;
    for (int i = tid; i < 128 * ROWB / 4; i += 512) ((unsigned*)(lds + OFF_ST))[i] = 0u;
    f32x16 S = {};
    const int sr = tid >> 4, sc = (tid & 15) * 8, vst0 = att::v_st(sr, sc), vst1 = att::v_st(32 + sr, sc);
    const int vb = (int)(uintptr_t)(lds + OFF_V) + att::v_rd_base(lane) + eb * 512;
    unsigned short qraw[8], kraw[8]; bf16x8 v0, v1; unsigned graw;
#define GLA_TB(s) ((s) < 4 ? NLAT + U.b * CTX + 64 * (dir ? 3 - (s) : (s)) : U.b * SEQ + 64 * (dir ? 67 - (s) : (s) - 4))
#define GLA_TOK(tb, i) ((long)((tb) + (dir ? 63 - (i) : (i))))
#define GLA_LOAD(s) do { const int tb_ = GLA_TB(s); \
    _Pragma("unroll") for (int i = 0; i < 8; ++i) { const bf16* row = U.P + GLA_TOK(tb_, seg * 8 + i) * U.ldp; qraw[i] = row[C_GQ + h * 64 + d]; kraw[i] = row[C_GK + h * 64 + d]; } \
    v0 = *reinterpret_cast<const bf16x8*>(U.P + GLA_TOK(tb_, sr) * U.ldp + C_GV + h * 128 + sc); v1 = *reinterpret_cast<const bf16x8*>(U.P + GLA_TOK(tb_, 32 + sr) * U.ldp + C_GV + h * 128 + sc); \
    graw = *reinterpret_cast<const unsigned*>(U.P + GLA_TOK(tb_, seg * 8 + (lane >> 3)) * U.ldp + C_GLR + dir * 16 + 2 * (lane & 7)); } while (0)
    GLA_LOAD(0);
    __syncthreads();
    for (int s = 0; s < 68; ++s) {
        const int tb = GLA_TB(s);
        GLR[lane * 2] = __uint_as_float(graw << 16); GLR[lane * 2 + 1] = __uint_as_float(graw & 0xffff0000u);
        asm volatile("s_waitcnt lgkmcnt(0)" ::: "memory");
        float bl[8]; float run = 0.f;
#pragma unroll
        for (int i = 0; i < 8; ++i) { float z = bias;
#pragma unroll
            for (int j4 = 0; j4 < 4; ++j4) { const f32x4 g = *(const f32x4*)(GLR + i * 16 + j4 * 4); z += g[0] * w[j4 * 4] + g[1] * w[j4 * 4 + 1] + g[2] * w[j4 * 4 + 2] + g[3] * w[j4 * 4 + 3]; }
            run += log_sigmoid(z) * (1.f / 16.f); bl[i] = run; }
        SEG[seg * 64 + d] = run;
        __syncthreads();
        float pre = 0.f, tot = 0.f;
#pragma unroll
        for (int s2 = 0; s2 < 8; ++s2) { const float t = SEG[s2 * 64 + d]; tot += t; if (s2 < seg) pre += t; }
        bf16x8 kd;
#pragma unroll
        for (int i = 0; i < 8; ++i) { const float bb = pre + bl[i]; const float q = __uint_as_float((unsigned)qraw[i] << 16), k = __uint_as_float((unsigned)kraw[i] << 16);
            const int row = seg * 8 + i;
            *(short*)(lds + OFF_QI + row * ROWB + d * 2) = f2bf(q * 0.125f * __expf(bb));
            *(short*)(lds + OFF_KI + row * ROWB + d * 2) = f2bf(k * __expf(-bb));
            kd[i] = f2bf(k * __expf(tot - bb)); }
        *(bf16x8*)(lds + OFF_KDT + d * ROWB + seg * 16) = kd;
        if (seg == 0) DEC[d] = __expf(tot);
        *(bf16x8*)(lds + OFF_V + vst0) = v0; *(bf16x8*)(lds + OFF_V + vst1) = v1;
        __syncthreads();
        if (s + 1 < 68) GLA_LOAD(s + 1);
        bf16x8 qf[4];
#pragma unroll
        for (int d0 = 0; d0 < 4; ++d0) qf[d0] = *reinterpret_cast<const bf16x8*>(lds + OFF_QI + (rh * 32 + r32) * ROWB + (d0 * 16 + hi * 8) * 2);
        f32x16 p0 = {}, p1 = {};
#pragma unroll
        for (int d0 = 0; d0 < 4; ++d0) { const int cb = (d0 * 16 + hi * 8) * 2;
            const bf16x8 k0 = *reinterpret_cast<const bf16x8*>(lds + OFF_KI + r32 * ROWB + cb), k1 = *reinterpret_cast<const bf16x8*>(lds + OFF_KI + (32 + r32) * ROWB + cb);
            p0 = __builtin_amdgcn_mfma_f32_32x32x16_bf16(k0, qf[d0], p0, 0, 0, 0); p1 = __builtin_amdgcn_mfma_f32_32x32x16_bf16(k1, qf[d0], p1, 0, 0, 0); }
        { const int irow = rh * 32 + r32 - dir;
#pragma unroll
          for (int r = 0; r < 16; ++r) { const int m = crow(r, hi); if (m > irow) p0[r] = 0.f; if (m + 32 > irow) p1[r] = 0.f; } }
        bf16x8 pa0, pa1, pa2, pa3;
        ATT_PK4(p0, 0, pa0); ATT_PK4(p0, 8, pa1); ATT_PK4(p1, 0, pa2); ATT_PK4(p1, 8, pa3);
        f32x16 o = {};
        att::pv_one<0>(o, vb, pa0, pa1, pa2, pa3);
#pragma unroll
        for (int d0 = 0; d0 < 4; ++d0) { const bf16x8 sf = *reinterpret_cast<const bf16x8*>(lds + OFF_ST + (eb * 32 + r32) * ROWB + (d0 * 16 + hi * 8) * 2);
            o = __builtin_amdgcn_mfma_f32_32x32x16_bf16(qf[d0], sf, o, 0, 0, 0); }
#pragma unroll
        for (int r = 0; r < 16; ++r) U.og[GLA_TOK(tb, rh * 32 + crow(r, hi)) * 512 + h * 128 + eb * 32 + r32] = o[r];
#pragma unroll
        for (int r = 0; r < 16; ++r) S[r] *= DEC[rh * 32 + crow(r, hi)];
        { bf16x8 kf[4];
#pragma unroll
          for (int ks = 0; ks < 4; ++ks) kf[ks] = *reinterpret_cast<const bf16x8*>(lds + OFF_KDT + (rh * 32 + r32) * ROWB + (ks * 16 + hi * 8) * 2);
          att::pv_one<0>(S, vb, kf[0], kf[1], kf[2], kf[3]); }
        __syncthreads();
#pragma unroll
        for (int g = 0; g < 4; ++g) { uint2 wv; wv.x = cvtpk(S[4 * g], S[4 * g + 1]); wv.y = cvtpk(S[4 * g + 2], S[4 * g + 3]);
            *(uint2*)(lds + OFF_ST + (eb * 32 + r32) * ROWB + (rh * 32 + 8 * g + 4 * hi) * 2) = wv; }
    }
    __syncthreads();
#undef GLA_TB
#undef GLA_TOK
#undef GLA_LOAD
}
}

constexpr size_t MiB = 1u << 20;
constexpr size_t WS_CTL = 0, CTL_BYTES = 1 * MiB;
constexpr size_t WS_MOD = 1 * MiB, MOD_BYTES = (size_t)DEPTH * 9 * NMOD * D_MODEL * 4;
constexpr size_t ZERO_BYTES = 3 * MiB;
static_assert(WS_MOD + MOD_BYTES <= ZERO_BYTES, "zero region");
constexpr size_t WS_TAB = 3 * MiB;
constexpr size_t WS_RSTD = WS_TAB + 64 * 1024;
constexpr size_t WS_W = 4 * MiB;
constexpr size_t W_IN = 0, W_UQKV = W_IN + (size_t)IN_WP * D_MODEL * 2, W_OUT = W_UQKV + (size_t)(UQ_WP + UKV_W) * 512 * 2, W_GU = W_OUT + (size_t)D_MODEL * D_MODEL * 2,
                 W_DOWN = W_GU + (size_t)2 * FFN * D_MODEL * 2, W_LAYER = W_DOWN + (size_t)D_MODEL * FFN * 2;
constexpr size_t WS_H = WS_W + DEPTH * W_LAYER;
constexpr size_t WS_MIX = WS_H + (size_t)NTOK * D_MODEL * 2;
constexpr size_t WS_XC = WS_MIX + (size_t)NTOK * D_MODEL * 2;
constexpr size_t WS_R1 = WS_XC + (size_t)NCTX * D_MODEL * 4;
constexpr size_t WS_P = WS_R1, WS_Q = WS_P + (size_t)NTOK * IN_WP * 2, WS_KV = WS_Q + (size_t)NTOK * UQ_WP * 2, WS_GOF = WS_KV + (size_t)NTOK * UKV_W * 2,
                 WS_GOB = WS_GOF + (size_t)NTOK * 512 * 4, WS_R1_END = WS_GOB + (size_t)NTOK * 512 * 4;
constexpr size_t WS_ACT = WS_R1;
static_assert(WS_ACT + (size_t)NTOK * FFN * 2 <= WS_R1_END, "ACT overlay fits");
constexpr size_t WS_END = WS_R1_END;
static_assert(W_LAYER % 256 == 0 && WS_H % 256 == 0 && WS_R1 % 256 == 0 && WS_Q % 256 == 0 && WS_KV % 256 == 0 && WS_GOF % 256 == 0, "alignment");
constexpr int CW_BAR = 4096;
constexpr int CW_QUEUE = 16384;
constexpr int RING_BYTES = 131072, LDSCTL_OFF = RING_BYTES, LDS_BYTES = 147456;

#define GAS __attribute__((address_space(1)))
#define LAS __attribute__((address_space(3)))
typedef unsigned short bf16;
typedef unsigned v4u __attribute__((ext_vector_type(4)));
typedef unsigned v2u __attribute__((ext_vector_type(2)));
typedef float f32x4 __attribute__((ext_vector_type(4)));
#define LDS_WAIT() asm volatile("s_waitcnt lgkmcnt(0)" ::: "memory")
__device__ __forceinline__ unsigned f2bf(float f) { unsigned u = __builtin_bit_cast(unsigned, f); return (u + 0x7fffu + ((u >> 16) & 1u)) >> 16; }
__device__ __forceinline__ unsigned pk2(float lo, float hi) { return f2bf(lo) | (f2bf(hi) << 16); }
__device__ __forceinline__ float bflo(unsigned w) { return __uint_as_float(w << 16); }
__device__ __forceinline__ float bfhi(unsigned w) { return __uint_as_float(w & 0xffff0000u); }
template <int O> __device__ __forceinline__ float swz_xor(float v) { return __int_as_float(__builtin_amdgcn_ds_swizzle(__float_as_int(v), (O << 10) | 0x1f)); }
__device__ __forceinline__ float sum16(float v) { v += swz_xor<1>(v); v += swz_xor<2>(v); v += swz_xor<4>(v); v += swz_xor<8>(v); return v; }
__device__ __forceinline__ float sum32(float v) { v = sum16(v); v += swz_xor<16>(v); return v; }
__device__ __forceinline__ float wave_sum(float v) { v = sum32(v); auto rr = __builtin_amdgcn_permlane32_swap(__float_as_uint(v), __float_as_uint(v), false, false); return __uint_as_float(rr[0]) + __uint_as_float(rr[1]); }

#define XB_TMO      128
#define XB_XCNT(j)  (256  + 64 * (j))
#define XB_XSUB(j)  (1280 + 64 * (j))
#define XB_XGEN(j)  (2304 + 64 * (j))
#define XB_TOP      3328
#define XB_TOPGEN   3392
#define XCD_BAR_WORDS 3456
#define XB_SPIN_CAP (1u << 21)
__device__ __forceinline__ unsigned xb_ld(unsigned* p)              { return __hip_atomic_load(p, __ATOMIC_RELAXED, __HIP_MEMORY_SCOPE_AGENT); }
__device__ __forceinline__ unsigned xb_add(unsigned* p, unsigned v) { return __hip_atomic_fetch_add(p, v, __ATOMIC_RELAXED, __HIP_MEMORY_SCOPE_AGENT); }
__device__ __forceinline__ unsigned xb_xcc_id() { return (unsigned)__builtin_amdgcn_s_getreg((3 << 11) | 20) & 0xFu; }
#define XB_SPIN(cond, bar) do { unsigned _sp = 0; while (cond) { __builtin_amdgcn_s_sleep(1); \
    if ((++_sp & 255u) == 0u) { if (xb_ld(&(bar)[XB_TMO])) break; if (_sp > XB_SPIN_CAP) { atomicAdd(&(bar)[XB_TMO], 1u); break; } } } } while (0)
struct XcdBarrier { unsigned* bar; unsigned x; volatile LAS unsigned* st; };
__device__ __forceinline__ XcdBarrier xcd_barrier_post(unsigned* bar, volatile LAS unsigned* st) {
    XcdBarrier b; b.bar = bar; b.x = xb_xcc_id(); b.st = st;
    if (threadIdx.x == 0) (void)xb_add(&bar[XB_XCNT(b.x)], 1u);
    return b;
}
__device__ __forceinline__ void xcd_barrier_complete(unsigned* bar, unsigned x, unsigned& nloc, unsigned& nx) {
    const unsigned G = gridDim.x * gridDim.y * gridDim.z;
    unsigned sum, cnt, mine, sp = 0u;
    for (;;) {
        sum = 0u; cnt = 0u; mine = 0u;
#pragma unroll
        for (unsigned j = 0; j < 16; ++j) { const unsigned c = xb_ld(&bar[XB_XCNT(j)]); sum += c; cnt += (c > 0u) ? 1u : 0u; mine = (j == x) ? c : mine; }
        if (sum == G) break;
        __builtin_amdgcn_s_sleep(1);
        if ((++sp & 255u) == 0u) { if (xb_ld(&bar[XB_TMO])) break; if (sp > XB_SPIN_CAP) { atomicAdd(&bar[XB_TMO], 1u); break; } }
    }
    nloc = mine > 0u ? mine : 1u; nx = cnt > 0u ? cnt : 1u;
}
__device__ __forceinline__ void xcd_barrier(const XcdBarrier& b) {
    asm volatile("s_waitcnt vmcnt(0)" ::: "memory");
    __syncthreads();
    if (threadIdx.x == 0) {
        unsigned* bar = b.bar;
        const unsigned bx_ = (unsigned)__builtin_amdgcn_readfirstlane((int)xb_xcc_id());
        __builtin_amdgcn_s_waitcnt(0);
        unsigned nloc = b.st[0], nx = b.st[1];
        if (nloc == 0u) { xcd_barrier_complete(bar, bx_, nloc, nx); b.st[0] = nloc; b.st[1] = nx; }
        const unsigned old = xb_add(&bar[XB_XSUB(bx_)], 1u);
        const unsigned gen = old / nloc;
        if (old + 1u == (gen + 1u) * nloc) {
            __builtin_amdgcn_fence(__ATOMIC_RELEASE, "agent");
            asm volatile("s_waitcnt vmcnt(0)" ::: "memory");
            const unsigned og = xb_add(&bar[XB_TOP], 1u);
            const unsigned tg = og / nx;
            if (og + 1u == (tg + 1u) * nx) xb_add(&bar[XB_TOPGEN], 1u);
            else XB_SPIN(xb_ld(&bar[XB_TOPGEN]) == tg, bar);
            __builtin_amdgcn_fence(__ATOMIC_ACQUIRE, "agent");
            xb_add(&bar[XB_XGEN(bx_)], 1u);
            asm volatile("s_waitcnt vmcnt(0)" ::: "memory");
        } else {
            XB_SPIN(xb_ld(&bar[XB_XGEN(bx_)]) == gen, bar);
            __builtin_amdgcn_fence(__ATOMIC_ACQUIRE, "agent");
            asm volatile("s_waitcnt vmcnt(0)" ::: "memory");
        }
    }
    __syncthreads();
}

constexpr int NWAVES = 8;
struct Ptrs {
    const float *x, *c, *ctx, *c_ctx, *w_mod, *b_mod, *g_mix, *g_ffn, *w_in, *g_mla_q, *g_mla_kv, *w_mla_uq, *w_mla_ukv, *swa_sink, *w_gate_f, *b_gate_f, *w_gate_b, *b_gate_b, *g_gla_out,
                *w_out, *w_ffn_gu, *w_ffn_down, *g_final;
    float* out; unsigned char* ws;
};

__device__ __forceinline__ void transpose_item(const float* W, int K, int N, bf16* WT, int drow0, int k0, int n0, const float* kscale, LAS float* scr, int lane) {
#pragma unroll 8
    for (int i = 0; i < 32; ++i) { const int kk = 2 * i + (lane >> 5); float v = W[(size_t)(k0 + kk) * N + n0 + (lane & 31)]; if (kscale) v *= kscale[k0 + kk]; scr[kk * 33 + (lane & 31)] = v; }
    LDS_WAIT(); asm volatile("" ::: "memory");
    const int c = lane & 7;
#pragma unroll
    for (int j = 0; j < 4; ++j) { const int n = (lane >> 3) + 8 * j; const LAS float* s = scr + (8 * c) * 33 + n;
        v4u o; o.x = pk2(s[0 * 33], s[1 * 33]); o.y = pk2(s[2 * 33], s[3 * 33]); o.z = pk2(s[4 * 33], s[5 * 33]); o.w = pk2(s[6 * 33], s[7 * 33]);
        *(GAS v4u*)(WT + (size_t)(drow0 + n) * K + k0 + 8 * c) = o; }
    LDS_WAIT(); asm volatile("" ::: "memory");
}
constexpr int TI_IN = 32 * 123, TI_UQ = 8 * 36, TI_UKV = 8 * 48, TI_OUT = 32 * 64, TI_GU = 32 * 352, TI_DOWN = 88 * 64, TI_LAYER = TI_IN + TI_UQ + TI_UKV + TI_OUT + TI_GU + TI_DOWN;

__device__ __forceinline__ void sincos_d(double a, double& s, double& c) {
    const double TWO_PI = 6.283185307179586476925287, INV = 0.15915494309189533576888;
    const double k = __builtin_rint(a * INV); const double r = a - k * TWO_PI, r2 = r * r;
    double ts = 1.0, tc = 1.0;
#pragma unroll
    for (int n = 12; n >= 1; --n) { ts = 1.0 - ts * r2 / (double)((2 * n) * (2 * n + 1)); tc = 1.0 - tc * r2 / (double)((2 * n - 1) * (2 * n)); }
    s = r * ts; c = tc;
}

__device__ __forceinline__ void norm_rows(const float* xl, const float* xc, int M, bf16* H, const float* g, const float* modl, int ch_shift, int ch_scale, int gw, int NGW, int lane) {
    for (int row = gw; row < M; row += NGW) {
        const bool lat = row < NLAT; const int gi = lat ? (row >> 12) : BATCH;
        const float* xr = lat ? xl + (size_t)row * D_MODEL : xc + (size_t)(row - NLAT) * D_MODEL;
        const float* sh = modl + (size_t)gi * (NMOD * D_MODEL) + ch_shift * D_MODEL; const float* sc = modl + (size_t)gi * (NMOD * D_MODEL) + ch_scale * D_MODEL;
        f32x4 v[8]; float ss = 0.f;
#pragma unroll
        for (int j = 0; j < 8; ++j) { v[j] = *(const f32x4*)(xr + 4 * lane + 256 * j); ss += (v[j].x * v[j].x + v[j].y * v[j].y) + (v[j].z * v[j].z + v[j].w * v[j].w); }
        const float rstd = 1.f / sqrtf(wave_sum(ss) * (1.f / D_MODEL) + EPS);
        bf16* hr = H + (size_t)row * D_MODEL;
#pragma unroll
        for (int j = 0; j < 8; ++j) { const int col = 4 * lane + 256 * j; const f32x4 gv = *(const f32x4*)(g + col), sv = *(const f32x4*)(sc + col), hv = *(const f32x4*)(sh + col);
            const f32x4 y = (v[j] * rstd) * gv * (sv + 1.f) + hv;
            v2u o; o.x = pk2(y.x, y.y); o.y = pk2(y.z, y.w); *(v2u*)(hr + col) = o; }
    }
}
#ifndef EN_P0
#define EN_P0 1
#endif
#ifndef EN_N1
#define EN_N1 1
#endif
#ifndef EN_G1
#define EN_G1 1
#endif
#ifndef EN_GL1
#define EN_GL1 1
#endif
#ifndef EN_G2
#define EN_G2 1
#endif
#ifndef EN_MIX
#define EN_MIX 1
#endif
#ifndef EN_GL2
#define EN_GL2 1
#endif
#ifndef EN_G3
#define EN_G3 1
#endif
#ifndef EN_N2
#define EN_N2 1
#endif
#ifndef EN_G4
#define EN_G4 1
#endif
#ifndef EN_G5
#define EN_G5 1
#endif
#ifndef EN_GLA
#define EN_GLA 1
#endif
#ifndef EN_MLA
#define EN_MLA 1
#endif
#ifndef EN_SWA
#define EN_SWA 1
#endif
__global__ void __launch_bounds__(NWAVES * 64, 2) fwd_kernel(Ptrs A) {
    extern __shared__ __attribute__((aligned(16))) unsigned char lds_raw[];
    LAS unsigned char* lds = (LAS unsigned char*)lds_raw;
    const int G = gridDim.x, bx = blockIdx.x, NGW = G * NWAVES;
    const int vcu = (G % 8 == 0) ? (bx % 8) * (G / 8) + bx / 8 : bx;
typedef const __attribute__((address_space(4))) Ptrs* KArgP;
#define PHASE_IDS() int tid = threadIdx.x; asm volatile("" : "+v"(tid)); const int lane = tid & 63, wave = __builtin_amdgcn_readfirstlane(tid >> 6), gw = vcu * NWAVES + wave; (void)lane; (void)gw; \
    KArgP AP = (KArgP)__builtin_amdgcn_kernarg_segment_ptr(); asm volatile("" : "+s"(AP)); \
    unsigned char* const ws = AP->ws; unsigned* const ctl = (unsigned*)(ws + WS_CTL); float* const MOD = (float*)(ws + WS_MOD); float* const TAB32 = (float*)(ws + WS_TAB); float* const TAB16 = TAB32 + 4096; \
    float* const RSTDQ = (float*)(ws + WS_RSTD); float* const RSTDKV = RSTDQ + NTOK; bf16* const Hb = (bf16*)(ws + WS_H); bf16* const MIX = (bf16*)(ws + WS_MIX); float* const XC = (float*)(ws + WS_XC); \
    bf16* const Pb = (bf16*)(ws + WS_P); bf16* const Qb = (bf16*)(ws + WS_Q); bf16* const KVb = (bf16*)(ws + WS_KV); float* const GOF = (float*)(ws + WS_GOF); float* const GOB = (float*)(ws + WS_GOB); bf16* const ACT = (bf16*)(ws + WS_ACT); \
    const float* const modl = MOD + (size_t)l * 9 * (NMOD * D_MODEL); const float* const xl_in = (l == 0) ? AP->x : AP->out; const float* const xc_in = (l == 0) ? AP->ctx : XC; \
    const char* const wl = (const char*)(ws + WS_W + (size_t)l * W_LAYER); \
    (void)ctl; (void)MOD; (void)TAB32; (void)TAB16; (void)RSTDQ; (void)RSTDKV; (void)Hb; (void)MIX; (void)XC; (void)Pb; (void)Qb; (void)KVb; (void)GOF; (void)GOB; (void)ACT; (void)modl; (void)xl_in; (void)xc_in; (void)wl
    volatile LAS unsigned* LCTL = (volatile LAS unsigned*)(lds + LDSCTL_OFF);
    for (int u = threadIdx.x; u < (LDS_BYTES - LDSCTL_OFF) / 4; u += NWAVES * 64) LCTL[u] = 0u;
    __syncthreads();
    XcdBarrier bar = xcd_barrier_post((unsigned*)(A.ws + WS_CTL) + CW_BAR, LCTL);
#define GRID_BAR() xcd_barrier(bar)

#if EN_P0
        { const int l = 0; PHASE_IDS(); asm volatile("; PHASE_MARK EN_P0");
    {
        LAS float* sS = (LAS float*)lds;
        LAS float* sR = (LAS float*)(lds + 36864);
        for (int it = bx; it < DEPTH * 48 * 2; it += G) {
            const int l = it / 96, cchunk = (it % 96) >> 1, kh = it & 1;
            for (int u = tid; u < 9 * 1024; u += 512) { const int i = u >> 10, k = (u & 1023) + kh * 1024; const float cv = i < BATCH ? AP->c[i * D_MODEL + k] : AP->c_ctx[k]; sS[u] = cv * pg8::fast_sigmoid(cv); }
            __syncthreads();
            f32x4 acc[9];
#pragma unroll
            for (int i = 0; i < 9; ++i) acc[i] = (f32x4){0.f, 0.f, 0.f, 0.f};
            const float* wp = AP->w_mod + ((size_t)l * D_MODEL + kh * 1024 + wave * 128) * (NMOD * D_MODEL) + cchunk * 256 + 4 * lane;
#pragma unroll 4
            for (int k = 0; k < 128; ++k) { const f32x4 wv = *(const f32x4*)(wp + (size_t)k * (NMOD * D_MODEL));
#pragma unroll
                for (int i = 0; i < 9; ++i) acc[i] += wv * sS[i * 1024 + wave * 128 + k]; }
#pragma unroll
            for (int i = 0; i < 9; ++i) *(LAS f32x4*)(sR + (wave * 9 + i) * 256 + 4 * lane) = acc[i];
            __syncthreads();
            for (int u = tid; u < 9 * 256; u += 512) { float s = 0.f;
#pragma unroll
                for (int w8 = 0; w8 < 8; ++w8) s += sR[w8 * 2304 + u];
                const int i = u >> 8, col = cchunk * 256 + (u & 255);
                if (kh == 0) s += AP->b_mod[(size_t)l * (NMOD * D_MODEL) + col];
                atomicAdd(MOD + ((size_t)l * 9 + i) * (NMOD * D_MODEL) + col, s); }
            __syncthreads();
        }
        LAS float* scr = (LAS float*)(lds + wave * 16384);
        for (int it = gw; it < DEPTH * TI_LAYER; it += NGW) {
            const int l = it / TI_LAYER; int r = it % TI_LAYER;
            bf16* wl = (bf16*)(ws + WS_W + (size_t)l * W_LAYER);
            if (r < TI_IN) { const int kb = r / 123, nb = r % 123; transpose_item(AP->w_in + (size_t)l * D_MODEL * IN_W, D_MODEL, IN_W, (bf16*)((char*)wl + W_IN), 32 * nb, 64 * kb, 32 * nb, nullptr, scr, lane); continue; } r -= TI_IN;
            if (r < TI_UQ) { const int kb = r / 36, nb = r % 36; transpose_item(AP->w_mla_uq + (size_t)l * 512 * UQ_W, 512, UQ_W, (bf16*)((char*)wl + W_UQKV), 32 * nb, 64 * kb, 32 * nb, AP->g_mla_q + l * 512, scr, lane); continue; } r -= TI_UQ;
            if (r < TI_UKV) { const int kb = r / 48, nb = r % 48; transpose_item(AP->w_mla_ukv + (size_t)l * 512 * UKV_W, 512, UKV_W, (bf16*)((char*)wl + W_UQKV), UQ_WP + 32 * nb, 64 * kb, 32 * nb, AP->g_mla_kv + l * 512, scr, lane); continue; } r -= TI_UKV;
            if (r < TI_OUT) { const int kb = r / 64, nb = r % 64; transpose_item(AP->w_out + (size_t)l * D_MODEL * D_MODEL, D_MODEL, D_MODEL, (bf16*)((char*)wl + W_OUT), 32 * nb, 64 * kb, 32 * nb, nullptr, scr, lane); continue; } r -= TI_OUT;
            if (r < TI_GU) { const int kb = r / 352, nb = r % 352; const int n0 = 32 * nb; const int j = n0 < FFN ? n0 : n0 - FFN; const int drow = (j >> 7) * 256 + (n0 < FFN ? 0 : 128) + (j & 127);
                transpose_item(AP->w_ffn_gu + (size_t)l * D_MODEL * 2 * FFN, D_MODEL, 2 * FFN, (bf16*)((char*)wl + W_GU), drow, 64 * kb, n0, nullptr, scr, lane); continue; } r -= TI_GU;
            { const int kb = r / 64, nb = r % 64; transpose_item(AP->w_ffn_down + (size_t)l * FFN * D_MODEL, FFN, D_MODEL, (bf16*)((char*)wl + W_DOWN), 32 * nb, 64 * kb, 32 * nb, nullptr, scr, lane); }
        }
        for (int u = bx * 512 + tid; u < DEPTH * (160 * 2048 + 128 * 512) / 8; u += G * 512) {
            const int l = u / ((160 * 2048 + 128 * 512) / 8); const int r = u % ((160 * 2048 + 128 * 512) / 8);
            char* wl = (char*)(ws + WS_W + (size_t)l * W_LAYER);
            v4u z = {0u, 0u, 0u, 0u};
            if (r < 160 * 2048 / 8) *(v4u*)(wl + W_IN + (size_t)IN_W * D_MODEL * 2 + (size_t)r * 16) = z;
            else *(v4u*)(wl + W_UQKV + (size_t)UQ_W * 512 * 2 + (size_t)(r - 160 * 2048 / 8) * 16) = z;
        }
        for (int u = bx * 512 + tid; u < 64 * 32 + 64 * 16; u += G * 512) {
            const bool big = u < 2048; const int v = big ? u : u - 2048; const int half = big ? 32 : 16; const int pos = v / half, i = v % half;
            const double rr = big ? 0.74989420933245582730 : 0.56234132519034908039;
            double f = 1.0; for (int q = 0; q < i; ++q) f *= rr;
            double s, c; sincos_d((double)pos * f, s, c);
            float* T = big ? TAB32 : TAB16; T[v] = (float)c; T[64 * half + v] = (float)s;
        }
    }
        }
#endif
    GRID_BAR();

    for (int l = 0; l < DEPTH; ++l) {
        const bool last = (l == DEPTH - 1);
        const int Mres = last ? NLAT : NTOK;

#if EN_N1
        { PHASE_IDS(); asm volatile("; PHASE_MARK EN_N1");
        norm_rows(xl_in, xc_in, NTOK, Hb, AP->g_mix + l * D_MODEL, modl, 0, 1, gw, NGW, lane);
        }
#endif
        GRID_BAR();

#if EN_G1
        { PHASE_IDS(); asm volatile("; PHASE_MARK EN_G1");
        { pg8::Gemm g{Hb, (const bf16*)(wl + W_IN), NTOK, IN_WP, D_MODEL, D_MODEL, 1 << 30, 0}; pg8::StaticOrder S; S.init(NTOK, IN_WP, G, bx);
          pg8::EpiStoreBf16 E{Pb, IN_WP};
          pg8::gemm_phase<pg8::EpiStoreBf16, pg8::StaticOrder>(lds, g, S, E, tid); }
        }
#endif
        GRID_BAR();

#if EN_GL1
        { PHASE_IDS(); asm volatile("; PHASE_MARK EN_GL1");
        for (int row = gw; row < NTOK; row += NGW) {
            bf16* pr = Pb + (size_t)row * IN_WP;
            { const v4u a = *(const v4u*)(pr + lane * 16), b = *(const v4u*)(pr + lane * 16 + 8); float ss = 0.f;
#pragma unroll
              for (int e = 0; e < 4; ++e) { ss += bflo(a[e]) * bflo(a[e]) + bfhi(a[e]) * bfhi(a[e]) + bflo(b[e]) * bflo(b[e]) + bfhi(b[e]) * bfhi(b[e]); }
              ss = sum32(ss);
              const float rs = 1.f / sqrtf(ss * (1.f / 512.f) + EPS);
              if (lane == 0) RSTDQ[row] = rs; if (lane == 32) RSTDKV[row] = rs; }
            if (row < NLAT) {
                const int n = row & (SEQ - 1), prow = n >> 6, pcol = n & 63;
                {
                  const int kvh = lane >> 5, blk = (lane >> 4) & 1, i0 = (lane & 15) * 2, pos = blk ? pcol : prow;
                  bf16* kp = pr + C_KS + kvh * 128 + blk * 64 + i0;
                  const unsigned w1 = *(const unsigned*)kp, w2 = *(const unsigned*)(kp + 32);
                  const float c0 = TAB32[pos * 32 + i0], c1 = TAB32[pos * 32 + i0 + 1], s0 = TAB32[2048 + pos * 32 + i0], s1 = TAB32[2048 + pos * 32 + i0 + 1];
                  const float a0 = bflo(w1), a1 = bfhi(w1), b0 = bflo(w2), b1 = bfhi(w2);
                  *(unsigned*)kp = pk2(a0 * c0 - b0 * s0, a1 * c1 - b1 * s1); *(unsigned*)(kp + 32) = pk2(b0 * c0 + a0 * s0, b1 * c1 + a1 * s1); }
                if (lane < 32) {
                  const int blk = lane >> 4, i = lane & 15, pos = blk ? pcol : prow;
                  bf16* kp = pr + C_KR + blk * 32 + i;
                  const float x1 = __uint_as_float((unsigned)kp[0] << 16), x2 = __uint_as_float((unsigned)kp[16] << 16);
                  const float c = TAB16[pos * 16 + i], s = TAB16[1024 + pos * 16 + i];
                  kp[0] = (bf16)f2bf(x1 * c - x2 * s); kp[16] = (bf16)f2bf(x2 * c + x1 * s); }
            }
        }
        }
#endif
        GRID_BAR();

#if EN_G2
        { PHASE_IDS(); asm volatile("; PHASE_MARK EN_G2");
        { pg8::Gemm g{Pb, (const bf16*)(wl + W_UQKV), NTOK, UQ_WP + UKV_W, 512, IN_WP, UQ_WP / 256, C_CKV}; pg8::StaticOrder S; S.init(NTOK, UQ_WP + UKV_W, G, bx);
          pg8::EpiQKV E{Qb, UQ_WP, KVb, UKV_W, RSTDQ, RSTDKV, UQ_WP / 256};
          pg8::gemm_phase<pg8::EpiQKV, pg8::StaticOrder>(lds, g, S, E, tid); }
        }
#endif
        GRID_BAR();

#if EN_MIX
#if EN_GLA
        { PHASE_IDS(); asm volatile("; PHASE_MARK EN_GLA");
        if (bx < 64) {
            gla::Unit U; U.P = Pb; U.ldp = IN_WP; U.b = bx >> 3; U.h = (bx >> 1) & 3; U.dir = bx & 1;
            U.wg = (U.dir ? AP->w_gate_b : AP->w_gate_f) + (size_t)l * 16 * 256; U.bg = (U.dir ? AP->b_gate_b : AP->b_gate_f) + (size_t)l * 256; U.og = U.dir ? GOB : GOF;
            gla::gla_unit(U, (char*)lds_raw, tid);
        }
        }
#endif
#if EN_MLA
        { PHASE_IDS(); asm volatile("; PHASE_MARK EN_MLA");
        {
            const int nitem = last ? 768 : 816; unsigned* head = ctl + CW_QUEUE + (l * 2 + 0) * 64;
            for (;;) {
                if (tid == 0) LCTL[4] = xb_add(head, 1u);
                __syncthreads(); const int it = (int)LCTL[4]; __syncthreads();
                if (it >= nitem) break;
                att::Unit U; const bool lat = it < 768; const int bh = lat ? it >> 4 : it - 768, qb = lat ? it & 15 : 0, b = bh / 6, h = bh % 6;
                const long row0 = lat ? (long)b * SEQ + qb * 256 : (long)NLAT + b * CTX;
                U.Q = Qb + row0 * UQ_WP + h * 192; U.ldq = UQ_WP;
                U.Kn = KVb + h * 256; U.ldkn = UKV_W; U.V = KVb + h * 256 + 128; U.ldv = UKV_W; U.Kr = Pb + C_KR; U.ldkr = IN_WP;
                U.t0a = lat ? b * SEQ : NLAT + b * CTX; U.nta = lat ? 64 : 4; U.t0b = NLAT + b * CTX; U.ntb = lat ? 4 : 0;
                U.mask = 0; U.qpos0 = qb * 256; U.kpos0 = 0; U.has_sink = 0; U.sink = 0.f; U.rope = lat ? 1 : 0; U.tab = TAB16;
                U.O = MIX + row0 * D_MODEL + MX_MLA + h * 128; U.ldo = D_MODEL;
                att::attn_unit<192, 1>(U, (char*)lds_raw, 0.07216878364870322f, tid);
            }
        }
        }
#endif
#if EN_SWA
        { PHASE_IDS(); asm volatile("; PHASE_MARK EN_SWA");
        {
            const int nitem = last ? 768 : 816; unsigned* head = ctl + CW_QUEUE + (l * 2 + 1) * 64;
            for (;;) {
                if (tid == 0) LCTL[4] = xb_add(head, 1u);
                __syncthreads(); const int it = (int)LCTL[4]; __syncthreads();
                if (it >= nitem) break;
                att::Unit U; const bool lat = it < 768; const int bh = lat ? it >> 4 : it - 768, qb = lat ? it & 15 : 0, b = bh / 6, hq = bh % 6, kvh = hq / 3;
                const long row0 = lat ? (long)b * SEQ + qb * 256 : (long)NLAT + b * CTX;
                const int ks = lat ? (qb * 256 - 128 < 0 ? 0 : qb * 256 - 128) : 0, ke = lat ? (qb * 256 + 384 > SEQ ? SEQ : qb * 256 + 384) : 0;
                U.Q = Pb + row0 * IN_WP + C_QS + hq * 128; U.ldq = IN_WP;
                U.Kn = Pb + C_KS + kvh * 128; U.ldkn = IN_WP; U.V = Pb + C_VS + kvh * 128; U.ldv = IN_WP; U.Kr = nullptr; U.ldkr = 0;
                U.t0a = lat ? b * SEQ + ks : NLAT + b * CTX; U.nta = lat ? (ke - ks) / 64 : 4; U.t0b = NLAT + b * CTX; U.ntb = lat ? 4 : 0;
                U.mask = lat ? 1 : 0; U.qpos0 = qb * 256; U.kpos0 = ks; U.has_sink = 1; U.sink = AP->swa_sink[l * 6 + hq]; U.rope = lat ? 1 : 0; U.tab = TAB32;
                U.O = MIX + row0 * D_MODEL + MX_SWA + hq * 128; U.ldo = D_MODEL;
                att::attn_unit<128, 2>(U, (char*)lds_raw, 0.08838834764831845f, tid);
            }
        }
        }
#endif
#endif
        GRID_BAR();

#if EN_GL2
        { PHASE_IDS(); asm volatile("; PHASE_MARK EN_GL2");
        for (int row = gw; row < Mres; row += NGW) {
            const f32x4 a0 = *(const f32x4*)(GOF + (size_t)row * 512 + lane * 8), a1 = *(const f32x4*)(GOF + (size_t)row * 512 + lane * 8 + 4);
            const f32x4 b0 = *(const f32x4*)(GOB + (size_t)row * 512 + lane * 8), b1 = *(const f32x4*)(GOB + (size_t)row * 512 + lane * 8 + 4);
            const f32x4 o0 = a0 + b0, o1 = a1 + b1;
            float ss = (o0.x * o0.x + o0.y * o0.y) + (o0.z * o0.z + o0.w * o0.w) + (o1.x * o1.x + o1.y * o1.y) + (o1.z * o1.z + o1.w * o1.w);
            ss = sum16(ss);
            const float rs = 1.f / sqrtf(ss * (1.f / 128.f) + EPS);
            const float* gp = AP->g_gla_out + l * 512 + lane * 8; const f32x4 g0 = *(const f32x4*)gp, g1 = *(const f32x4*)(gp + 4);
            const v4u rw = *(const v4u*)(Pb + (size_t)row * IN_WP + C_GR + lane * 8);
            float r[8] = {bflo(rw.x), bfhi(rw.x), bflo(rw.y), bfhi(rw.y), bflo(rw.z), bfhi(rw.z), bflo(rw.w), bfhi(rw.w)};
            float y[8] = {o0.x * g0.x, o0.y * g0.y, o0.z * g0.z, o0.w * g0.w, o1.x * g1.x, o1.y * g1.y, o1.z * g1.z, o1.w * g1.w};
#pragma unroll
            for (int e = 0; e < 8; ++e) y[e] = y[e] * rs * (r[e] * pg8::fast_sigmoid(r[e]));
            v4u w; w.x = pk2(y[0], y[1]); w.y = pk2(y[2], y[3]); w.z = pk2(y[4], y[5]); w.w = pk2(y[6], y[7]);
            *(v4u*)(MIX + (size_t)row * D_MODEL + MX_GLA + lane * 8) = w;
        }
        }
#endif
        GRID_BAR();

#if EN_G3
        { PHASE_IDS(); asm volatile("; PHASE_MARK EN_G3");
        { pg8::Gemm g{MIX, (const bf16*)(wl + W_OUT), Mres, D_MODEL, D_MODEL, D_MODEL, 1 << 30, 0}; pg8::StaticOrder S; S.init(Mres, D_MODEL, G, bx);
          pg8::EpiRes E{xl_in, xc_in, AP->out, XC, modl + 2 * D_MODEL, NMOD * D_MODEL, D_MODEL};
          pg8::gemm_phase<pg8::EpiRes, pg8::StaticOrder>(lds, g, S, E, tid); }
        }
#endif
        GRID_BAR();

#if EN_N2
        { PHASE_IDS(); asm volatile("; PHASE_MARK EN_N2");
        norm_rows(AP->out, XC, Mres, Hb, AP->g_ffn + l * D_MODEL, modl, 3, 4, gw, NGW, lane);
        }
#endif
        GRID_BAR();

#if EN_G4
        { PHASE_IDS(); asm volatile("; PHASE_MARK EN_G4");
        { pg8::Gemm g{Hb, (const bf16*)(wl + W_GU), Mres, 2 * FFN, D_MODEL, D_MODEL, 1 << 30, 0}; pg8::StaticOrder S; S.init(Mres, 2 * FFN, G, bx);
          pg8::EpiSwiglu E{ACT, FFN};
          pg8::gemm_phase<pg8::EpiSwiglu, pg8::StaticOrder>(lds, g, S, E, tid); }
        }
#endif
        GRID_BAR();

#if EN_G5
        { PHASE_IDS(); asm volatile("; PHASE_MARK EN_G5");
        { pg8::Gemm g{ACT, (const bf16*)(wl + W_DOWN), Mres, D_MODEL, FFN, FFN, 1 << 30, 0}; pg8::StaticOrder S; S.init(Mres, D_MODEL, G, bx);
          pg8::EpiRes E{AP->out, XC, AP->out, XC, modl + 5 * D_MODEL, NMOD * D_MODEL, D_MODEL};
          pg8::gemm_phase<pg8::EpiRes, pg8::StaticOrder>(lds, g, S, E, tid); }
        }
#endif
        GRID_BAR();
    }

    const int l = 0; PHASE_IDS();
    for (int row = gw; row < NLAT; row += NGW) {
        float* xr = AP->out + (size_t)row * D_MODEL;
        f32x4 v[8]; float ss = 0.f;
#pragma unroll
        for (int j = 0; j < 8; ++j) { v[j] = *(const f32x4*)(xr + 4 * lane + 256 * j); ss += (v[j].x * v[j].x + v[j].y * v[j].y) + (v[j].z * v[j].z + v[j].w * v[j].w); }
        const float rstd = 1.f / sqrtf(wave_sum(ss) * (1.f / D_MODEL) + EPS);
#pragma unroll
        for (int j = 0; j < 8; ++j) { const int col = 4 * lane + 256 * j; const f32x4 gv = *(const f32x4*)(AP->g_final + col); *(f32x4*)(xr + col) = (v[j] * rstd) * gv; }
    }
}

extern "C" void kernel_launch(void* const* d_in, const int* in_sizes, int n_in, void* d_out, int out_size, void* d_ws, size_t ws_size, hipStream_t stream) {
    static int grid = 0;
    if (grid == 0) {
        if (n_in != 23 || in_sizes[0] != NLAT * D_MODEL || out_size != NLAT * D_MODEL || ws_size < WS_END) {
            fprintf(stderr, "kernel_launch: unexpected shapes: n_in %d in0 %d out %d ws %zu (need %zu)\n", n_in, n_in > 0 ? in_sizes[0] : -1, out_size, ws_size, (size_t)WS_END); grid = -1; return; }
        int dev = 0, cus = 0, per_cu = 0;
        if (hipGetDevice(&dev) != hipSuccess || hipDeviceGetAttribute(&cus, hipDeviceAttributeMultiprocessorCount, dev) != hipSuccess) { fprintf(stderr, "kernel_launch: device query failed\n"); grid = -1; return; }
        if (hipFuncSetAttribute((const void*)fwd_kernel, hipFuncAttributeMaxDynamicSharedMemorySize, LDS_BYTES) != hipSuccess) { fprintf(stderr, "kernel_launch: hipFuncSetAttribute failed\n"); grid = -1; return; }
        if (hipOccupancyMaxActiveBlocksPerMultiprocessor(&per_cu, (const void*)fwd_kernel, NWAVES * 64, LDS_BYTES) != hipSuccess || per_cu < 1) { fprintf(stderr, "kernel_launch: occupancy query reports %d workgroups per CU\n", per_cu); (void)hipGetLastError(); grid = -1; return; }
        grid = cus;
    }
    if (grid < 0) return;
    if (hipMemsetAsync((char*)d_ws, 0, ZERO_BYTES, stream) != hipSuccess) { fprintf(stderr, "kernel_launch: memset failed\n"); return; }
    Ptrs p{};
    const float** pf = (const float**)&p;
    for (int i = 0; i < 23; ++i) pf[i] = (const float*)d_in[i];
    p.out = (float*)d_out; p.ws = (unsigned char*)d_ws;
    hipLaunchKernelGGL(fwd_kernel, dim3(grid), dim3(NWAVES * 64), LDS_BYTES, stream, p);
    const hipError_t le = hipPeekAtLastError();
    if (le != hipSuccess) fprintf(stderr, "kernel_launch: launch failed: %s\n", hipGetErrorName(le));
}
```

```cpp
#include <hip/hip_runtime.h>
#include <cstdio>
#include <cstdint>
#include <cmath>

constexpr int D_MODEL = 2048, BATCH = 8, SEQ = 4096, DEPTH = 4, CTX = 256;
constexpr int NLAT = BATCH * SEQ;
constexpr int NCTX = BATCH * CTX;
constexpr int NTOK = NLAT + NCTX;
constexpr int IN_W = 3936, IN_WP = 4096;
constexpr int FFN = 5632, NMOD = 6;
constexpr int UQ_W = 1152, UQ_WP = 1280, UKV_W = 1536;
constexpr float EPS = 1e-6f;
constexpr int C_CQ = 0, C_CKV = 512, C_KR = 1024, C_QS = 1088, C_KS = 1856, C_VS = 2112, C_GQ = 2368, C_GK = 2624, C_GV = 2880, C_GLR = 3392, C_GR = 3424;
constexpr int MX_MLA = 0, MX_SWA = 768, MX_GLA = 1536;

namespace pg8 {
#define PG8_LAS __attribute__((address_space(3)))
typedef unsigned short bf16_t;
typedef short bf16x8 __attribute__((ext_vector_type(8)));
typedef float f32x4 __attribute__((ext_vector_type(4)));
typedef unsigned u32x4 __attribute__((ext_vector_type(4)));
constexpr int BM = 256, BK = 64, HALF = 128, HTB = HALF * BK * 2  , STAGE_BYTES = 8 * HTB, NXCD = 8, WGM = 8;

__host__ __device__ __forceinline__ int lds_byte(int r, int c) { const int st = (r >> 4) * 2 + (c >> 5), rr = r & 15, cc = c & 31, ob = rr * 64 + cc * 2; return st * 1024 + (ob ^ (((ob >> 9) & 1) << 5)); }
__host__ __device__ __forceinline__ void stage_rc(int b, int& R, int& C) { const int st = b / 1024, sb = b % 1024, swz = sb ^ (((sb >> 9) & 1) << 5); R = (st >> 1) * 16 + swz / 64; C = (st & 1) * 32 + (swz % 64) / 2; }
__host__ __device__ __forceinline__ int perm32(int rho) { const int n = rho >> 4, i = rho & 15; return 8 * (i >> 2) + 4 * n + (i & 3); }

struct Unit { int pm, pn, ks; int hm = 0; };
struct Gemm { const bf16_t* A; const bf16_t* Bt; int M, N, K, lda, a_split_pn, a_split_off, ldb, ksplit; long kstepA, ksplitA; };

struct StaticOrder {
    int nM, nN, nwg, G, c, wgm, rev, pm_mod = 0, mode = 0;
    __host__ __device__ void init(int M, int N, int G_, int c_, int wgm_ = WGM, int rev_ = 0) { nM = M / BM; nN = N / BM; nwg = nM * nN; G = G_; c = c_; wgm = wgm_; rev = rev_; }
    __host__ __device__ bool next(int i, Unit& u) const {
        long L = (long)i * G + c; u.hm = 0;
        if (mode) { const int full = nwg / G, R = nwg - full * G; const bool split = R > 0 && 2 * R <= G;
            if (mode == 1) { if (split && i >= full) return false; }
            else { if (!split || i > 0 || c >= 2 * R) return false; L = (long)full * G + (c >> 1); u.hm = 1 + (c & 1); } }
        if (L >= nwg) return false;
        int wgid = (int)L; { const int q = nwg / NXCD, r = nwg % NXCD, xcd = wgid % NXCD, off = wgid / NXCD; wgid = (xcd < r ? xcd * (q + 1) : r * (q + 1) + (xcd - r) * q) + off; }
        const int nig = wgm * nN, gid = wgid / nig, fm = gid * wgm, gsz = (nM - fm) < wgm ? (nM - fm) : wgm;
        u.pm = fm + ((wgid % nig) % gsz); u.pn = (wgid % nig) / gsz; u.ks = 0; if (rev) u.pm = nM - 1 - u.pm; if (pm_mod) u.pm %= pm_mod; return true;
    }
    __device__ __forceinline__ void a_ready(const Unit&) const {}
    __device__ __forceinline__ void done(const Unit&) const {}
};

struct SplitKOrder {
    int nM, nN, nS, G, c;
    __host__ __device__ void init(int nM_, int nN_, int nS_, int G_, int c_) { nM = nM_; nN = nN_; nS = nS_; G = G_; c = c_; }
    __host__ __device__ bool next(int i, Unit& u) const { const int L = i * G + c; if (L >= nM * nN * nS) return false; u.ks = L % nS; u.pm = (L / nS) % nM; u.pn = L / (nS * nM); return true; }
    __device__ __forceinline__ void a_ready(const Unit&) const {}
    __device__ __forceinline__ void done(const Unit&) const {}
};

typedef float f32x2_t __attribute__((ext_vector_type(2))); typedef __bf16 bf16x2_t __attribute__((ext_vector_type(2)));
__device__ __forceinline__ unsigned cvt_pk_bf16(float lo, float hi) { f32x2_t v = {lo, hi}; bf16x2_t b = __builtin_convertvector(v, bf16x2_t); return __builtin_bit_cast(unsigned, b); }
typedef float f32x2 __attribute__((ext_vector_type(2)));
#ifndef NT_ACT
#define NT_ACT 0
#endif
typedef unsigned u32x2 __attribute__((ext_vector_type(2)));
__device__ __forceinline__ float fast_sigmoid(float x) { return __builtin_amdgcn_rcpf(1.0f + __builtin_amdgcn_exp2f(-1.4426950408889634f * x)); }
struct EpiStoreBf16 {
    static constexpr bool PERM = true, AFTER_DRAIN = false;
    bf16_t* O; int ldc;
    __device__ __forceinline__ void operator()(const f32x4 (&acc)[2][2][4][2], const Unit& u, int wr, int wc, int fr, int fq) const {
        const int row0 = u.pm * BM + wr * 64 + fr, col0 = u.pn * BM + wc * 32 + 8 * fq;
#pragma unroll
        for (int ai = 0; ai < 2; ++ai)
#pragma unroll
            for (int m = 0; m < 4; ++m) { bf16_t* rowp = O + (size_t)(row0 + ai * HALF + m * 16) * ldc + col0;
#pragma unroll
                for (int bj = 0; bj < 2; ++bj) { const f32x4 v0 = acc[ai][bj][m][0], v1 = acc[ai][bj][m][1];
                    u32x4 w; w.x = cvt_pk_bf16(v0[0], v0[1]); w.y = cvt_pk_bf16(v0[2], v0[3]); w.z = cvt_pk_bf16(v1[0], v1[1]); w.w = cvt_pk_bf16(v1[2], v1[3]);
                    *(u32x4*)(rowp + bj * HALF) = w; } }
    }
};
struct EpiQKV {
    static constexpr bool PERM = true, AFTER_DRAIN = false;
    bf16_t* Oq; int ldq; bf16_t* Okv; int ldkv; const float* rq; const float* rkv; int split;
    __device__ __forceinline__ void operator()(const f32x4 (&acc)[2][2][4][2], const Unit& u, int wr, int wc, int fr, int fq) const {
        const bool first = u.pn < split;
        bf16_t* base = first ? Oq : Okv; const int ld = first ? ldq : ldkv; const float* rs = first ? rq : rkv;
        const int row0 = u.pm * BM + wr * 64 + fr, col0 = (first ? u.pn : u.pn - split) * BM + wc * 32 + 8 * fq;
        float sv[2][4];
#pragma unroll
        for (int ai = 0; ai < 2; ++ai)
#pragma unroll
            for (int m = 0; m < 4; ++m) sv[ai][m] = rs[row0 + ai * HALF + m * 16];
#pragma unroll
        for (int ai = 0; ai < 2; ++ai)
#pragma unroll
            for (int m = 0; m < 4; ++m) { const int row = row0 + ai * HALF + m * 16; const float s = 1.0f / sqrtf(sv[ai][m] * (1.0f / 512.0f) + 1e-6f); bf16_t* rowp = base + (size_t)row * ld + col0;
#pragma unroll
                for (int bj = 0; bj < 2; ++bj) { const f32x4 v0 = acc[ai][bj][m][0] * s, v1 = acc[ai][bj][m][1] * s;
                    u32x4 w; w.x = cvt_pk_bf16(v0[0], v0[1]); w.y = cvt_pk_bf16(v0[2], v0[3]); w.z = cvt_pk_bf16(v1[0], v1[1]); w.w = cvt_pk_bf16(v1[2], v1[3]);
                    *(u32x4*)(rowp + bj * HALF) = w; } }
    }
};
struct EpiRes {
    static constexpr bool PERM = false, AFTER_DRAIN = false;
    const float* base_l; const float* base_c; float* out_l; float* out_c; const float* gate; int gpitch; int ncols;
    __device__ __forceinline__ void operator()(const f32x4 (&acc)[2][2][4][2], const Unit& u, int wr, int wc, int fr, int fq) const {
        const bool lat = u.pm < (NLAT / BM);
        const int gi = lat ? (u.pm >> 4) : BATCH;
        const float* bs = lat ? base_l : base_c; float* os = lat ? out_l : out_c;
        const int row0 = (lat ? u.pm : u.pm - NLAT / BM) * BM + wr * 64 + fr, col0 = u.pn * BM + wc * 32 + 4 * fq;
        f32x4 gv[2][2];
#pragma unroll
        for (int bj = 0; bj < 2; ++bj)
#pragma unroll
            for (int n = 0; n < 2; ++n) gv[bj][n] = *(const f32x4*)(gate + (size_t)gi * gpitch + col0 + bj * HALF + n * 16);
#pragma unroll
        for (int ai = 0; ai < 2; ++ai)
#pragma unroll
            for (int m = 0; m < 4; ++m) { const size_t off = (size_t)(row0 + ai * HALF + m * 16) * ncols + col0;
#pragma unroll
                for (int bj = 0; bj < 2; ++bj)
#pragma unroll
                    for (int n = 0; n < 2; ++n) { const f32x4 b = *(const f32x4*)(bs + off + bj * HALF + n * 16); *(f32x4*)(os + off + bj * HALF + n * 16) = b + gv[bj][n] * acc[ai][bj][m][n]; }
                asm volatile("" ::: "memory"); }
    }
};
struct EpiSwiglu {
    static constexpr bool PERM = true, AFTER_DRAIN = false;
    bf16_t* O; int ldc; int tiled_rows;
    __device__ __forceinline__ void operator()(const f32x4 (&acc)[2][2][4][2], const Unit& u, int wr, int wc, int fr, int fq) const {
        const int row0 = u.pm * BM + (u.hm == 2 ? HALF : 0) + wr * 64 + fr, col0 = u.pn * HALF + wc * 32 + 8 * fq;
#pragma unroll
        for (int ai = 0; ai < 2; ++ai) { if (ai == 1 && u.hm) break;
#pragma unroll
            for (int m = 0; m < 4; ++m) { const int row = row0 + ai * HALF + m * 16;
                bf16_t* rowp = tiled_rows ? O + ((size_t)(col0 >> 6) * tiled_rows + row) * 64 + (col0 & 63) : O + (size_t)row * ldc + col0;
                float r[8];
#pragma unroll
                for (int n = 0; n < 2; ++n)
#pragma unroll
                    for (int i = 0; i < 4; ++i) { const float g = acc[ai][0][m][n][i], up = acc[ai][1][m][n][i]; r[n * 4 + i] = g * fast_sigmoid(g) * up; }
                u32x4 w; w.x = cvt_pk_bf16(r[0], r[1]); w.y = cvt_pk_bf16(r[2], r[3]); w.z = cvt_pk_bf16(r[4], r[5]); w.w = cvt_pk_bf16(r[6], r[7]);
#if NT_ACT
                __builtin_nontemporal_store(w, (u32x4*)rowp);
#else
                *(u32x4*)rowp = w;
#endif
                }
        }
    }
};

struct EpiSum {
    static constexpr bool PERM = false, AFTER_DRAIN = false;
    float* O;
    __device__ __forceinline__ void operator()(const f32x4 (&acc)[2][2][4][2], const Unit& u, int wr, int wc, int fr, int fq) const {
        float s = 0.f;
#pragma unroll
        for (int ai = 0; ai < 2; ++ai)
#pragma unroll
            for (int bj = 0; bj < 2; ++bj)
#pragma unroll
                for (int m = 0; m < 4; ++m)
#pragma unroll
                    for (int n = 0; n < 2; ++n) s += (acc[ai][bj][m][n][0] + acc[ai][bj][m][n][1]) + (acc[ai][bj][m][n][2] + acc[ai][bj][m][n][3]);
        O[(size_t)(u.pm * 8 + u.pn) * 512 + (wr * 4 + wc) * 64 + fq * 16 + fr] = s;
    }
};

struct EpiPart {
    static constexpr bool PERM = false, AFTER_DRAIN = false;
    float* slab; const float* gate; int nrows, ncols;
    __device__ __forceinline__ void operator()(const f32x4 (&acc)[2][2][4][2], const Unit& u, int wr, int wc, int fr, int fq) const {
        const int row0 = u.pm * BM + wr * 64 + fr, col0 = u.pn * BM + wc * 32 + 4 * fq;
        float* os = slab + (size_t)u.ks * nrows * ncols;
        f32x4 gv[2][2];
#pragma unroll
        for (int bj = 0; bj < 2; ++bj)
#pragma unroll
            for (int n = 0; n < 2; ++n) gv[bj][n] = *(const f32x4*)(gate + col0 + bj * HALF + n * 16);
#pragma unroll
        for (int ai = 0; ai < 2; ++ai)
#pragma unroll
            for (int m = 0; m < 4; ++m) { const size_t off = (size_t)(row0 + ai * HALF + m * 16) * ncols + col0;
#pragma unroll
                for (int bj = 0; bj < 2; ++bj)
#pragma unroll
                    for (int n = 0; n < 2; ++n) *(f32x4*)(os + off + bj * HALF + n * 16) = gv[bj][n] * acc[ai][bj][m][n]; }
    }
};

struct EpiResNorm {
    static constexpr bool PERM = false, AFTER_DRAIN = false;
    const float* base_l; float* out_l; const float* gate; int gpitch;
    bf16_t* H;
    const float* gvec; const float* shiftp; const float* scalep;
    float* slots; unsigned* cnt; unsigned* tmo;
    PG8_LAS unsigned char* scr;
    int fin;
    __device__ __forceinline__ void operator()(f32x4 (&acc)[2][2][4][2], const Unit& u, int wr, int wc, int fr, int fq) const {
        const int gi = u.pm >> 4, row0 = u.pm * BM + wr * 64 + fr, col0 = u.pn * BM + wc * 32 + 4 * fq, wid = wr * 4 + wc, lane = fq * 16 + fr, tid = wid * 64 + lane;
        PG8_LAS float* P = (PG8_LAS float*)scr; PG8_LAS float* S = (PG8_LAS float*)(scr + 4096); PG8_LAS unsigned* flag = (PG8_LAS unsigned*)(scr + 5120);
        { f32x4 gv[2][2];
#pragma unroll
          for (int bj = 0; bj < 2; ++bj)
#pragma unroll
              for (int n = 0; n < 2; ++n) gv[bj][n] = *(const f32x4*)(gate + (size_t)gi * gpitch + col0 + bj * HALF + n * 16);
          f32x4 bb[2][2][2];
#define ERN_LOADB(it_, buf_) do { const size_t o_ = (size_t)(row0 + ((it_) >> 2) * HALF + ((it_) & 3) * 16) * 2048 + col0; \
    _Pragma("unroll") for (int bj = 0; bj < 2; ++bj) _Pragma("unroll") for (int n = 0; n < 2; ++n) bb[buf_][bj][n] = *(const f32x4*)(base_l + o_ + bj * HALF + n * 16); } while (0)
          ERN_LOADB(0, 0);
#pragma unroll
          for (int it = 0; it < 8; ++it) { const int ai = it >> 2, m = it & 3; const size_t off = (size_t)(row0 + ai * HALF + m * 16) * 2048 + col0; float ss = 0.f;
                  if (it + 1 < 8) ERN_LOADB(it + 1, (it + 1) & 1);
#pragma unroll
                  for (int bj = 0; bj < 2; ++bj)
#pragma unroll
                      for (int n = 0; n < 2; ++n) { const f32x4 b = bb[it & 1][bj][n]; const f32x4 x = b + gv[bj][n] * acc[ai][bj][m][n]; acc[ai][bj][m][n] = x;
                          if (!fin) *(f32x4*)(out_l + off + bj * HALF + n * 16) = x; ss += (x[0] * x[0] + x[1] * x[1]) + (x[2] * x[2] + x[3] * x[3]); }
                  ss += __int_as_float(__builtin_amdgcn_ds_swizzle(__float_as_int(ss), (16 << 10) | 0x1f));
                  { auto rr = __builtin_amdgcn_permlane32_swap(__float_as_uint(ss), __float_as_uint(ss), false, false); ss = __uint_as_float(rr[0]) + __uint_as_float(rr[1]); }
                  if (fq == 0) P[(ai * HALF + wr * 64 + m * 16 + fr) * 4 + wc] = ss;
                  asm volatile("" ::: "memory"); }
#undef ERN_LOADB
        }
        asm volatile("s_waitcnt lgkmcnt(0)" ::: "memory"); __builtin_amdgcn_s_barrier(); asm volatile("" ::: "memory");
        if (tid < 256) { const f32x4 p = *(const PG8_LAS f32x4*)(P + tid * 4); const float s = (p[0] + p[1]) + (p[2] + p[3]);
            __hip_atomic_store((unsigned*)slots + ((size_t)(u.pm * 256 + tid) * 8 + u.pn), __float_as_uint(s), __ATOMIC_RELAXED, __HIP_MEMORY_SCOPE_AGENT);
            asm volatile("s_waitcnt vmcnt(0)" ::: "memory");
            if (lane == 0) __hip_atomic_fetch_add(cnt + 64 * u.pm, 1u, __ATOMIC_RELAXED, __HIP_MEMORY_SCOPE_AGENT); }
        if (wid == 0) { unsigned dead = 0u, sp = 0u;
            while ((unsigned)__builtin_amdgcn_readfirstlane(__hip_atomic_load(cnt + 64 * u.pm, __ATOMIC_RELAXED, __HIP_MEMORY_SCOPE_AGENT)) < 32u) {
                __builtin_amdgcn_s_sleep(1);
                if ((++sp & 255u) == 0u) { if (__builtin_amdgcn_readfirstlane(__hip_atomic_load(tmo, __ATOMIC_RELAXED, __HIP_MEMORY_SCOPE_AGENT)) != 0u) { dead = 1u; break; }
                    if (sp > (1u << 20)) { if (lane == 0) __hip_atomic_fetch_add(tmo, 1u, __ATOMIC_RELAXED, __HIP_MEMORY_SCOPE_AGENT); dead = 1u; break; } } }
            __builtin_amdgcn_fence(__ATOMIC_ACQUIRE, "agent");
            if (lane == 0) flag[0] = dead; }
        asm volatile("s_waitcnt vmcnt(0) lgkmcnt(0)" ::: "memory"); __builtin_amdgcn_s_barrier(); asm volatile("" ::: "memory");
        if (tid < 256) { const unsigned* sl = (const unsigned*)slots + (size_t)(u.pm * 256 + tid) * 8; float t = 0.f;
#pragma unroll
            for (int q = 0; q < 8; ++q) t += __uint_as_float(__hip_atomic_load(sl + q, __ATOMIC_RELAXED, __HIP_MEMORY_SCOPE_AGENT));
            S[tid] = 1.0f / sqrtf(t * (1.0f / 2048.0f) + 1e-6f); }
        asm volatile("s_waitcnt lgkmcnt(0)" ::: "memory"); __builtin_amdgcn_s_barrier(); asm volatile("" ::: "memory");
        const bool bad = flag[0] != 0u; const float qnan = __builtin_nanf("");
        f32x4 gs[2][2], sh[2][2];
#pragma unroll
        for (int bj = 0; bj < 2; ++bj)
#pragma unroll
            for (int n = 0; n < 2; ++n) { const int c = col0 + bj * HALF + n * 16; const f32x4 g4 = *(const f32x4*)(gvec + c);
                if (fin) { gs[bj][n] = g4; sh[bj][n] = (f32x4){0.f, 0.f, 0.f, 0.f}; }
                else { gs[bj][n] = g4 * (*(const f32x4*)(scalep + (size_t)gi * gpitch + c) + 1.0f); sh[bj][n] = *(const f32x4*)(shiftp + (size_t)gi * gpitch + c); } }
#pragma unroll
        for (int ai = 0; ai < 2; ++ai)
#pragma unroll
            for (int m = 0; m < 4; ++m) { const int r = ai * HALF + wr * 64 + m * 16 + fr; const float rs = bad ? qnan : S[r]; const size_t off = (size_t)(u.pm * BM + r) * 2048 + col0;
#pragma unroll
                for (int bj = 0; bj < 2; ++bj)
#pragma unroll
                    for (int n = 0; n < 2; ++n) { const f32x4 y = (acc[ai][bj][m][n] * rs) * gs[bj][n] + sh[bj][n];
                        if (fin) __builtin_nontemporal_store(y, (f32x4*)(out_l + off + bj * HALF + n * 16));
                        else { u32x2 w; w.x = cvt_pk_bf16(y[0], y[1]); w.y = cvt_pk_bf16(y[2], y[3]); *(u32x2*)(H + off + bj * HALF + n * 16) = w; } } }
    }
};

__host__ __device__ __forceinline__ int w_in_row(int c) {
    if (c >= 1856 && c < 2112) { const int B = 1856 + ((c - 1856) & ~127), d = (c - 1856) & 127, blk = d >> 6, n = (d & 63) >> 5, i = d & 31; return B + 8 * (blk * 8 + (i >> 2)) + 4 * n + (i & 3); }
    if (c >= 1024 && c < 1088) { const int d = c - 1024, blk = d >> 5, n = (d & 31) >> 4, i = d & 15; return 1024 + 8 * (blk * 4 + (i >> 2)) + 4 * n + (i & 3); }
    return c;
}
struct EpiInProj {
    static constexpr bool PERM = true, AFTER_DRAIN = false;
    bf16_t* O; int ldc; float* ssq; int ssq_rows; const float* tab32; const float* tab16; int nlat, seqmask;
    __device__ __forceinline__ void operator()(const f32x4 (&acc)[2][2][4][2], const Unit& u, int wr, int wc, int fr, int fq) const {
        const int row0 = u.pm * BM + (u.hm == 2 ? HALF : 0) + wr * 64 + fr; const bool stat = u.pn < 4; const bool lat = u.pm * BM < nlat; const int nai = u.hm ? 1 : 2;
#pragma unroll
        for (int bj = 0; bj < 2; ++bj) {
            const int p0 = u.pn * BM + bj * HALF + wc * 32 + 8 * fq;
            const bool inKS = p0 >= 1856 && p0 < 2112, inKR = p0 >= 1024 && p0 < 1088;
            if (inKS || inKR) {
                const int half = inKS ? 32 : 16, base = inKS ? 1856 + ((p0 - 1856) & ~127) : 1024, t = (p0 - base) >> 3, blk = inKS ? (t >> 3) : (t >> 2), i0 = 4 * (inKS ? (t & 7) : (t & 3));
                const float* tb = inKS ? tab32 : tab16; const int c1 = base + blk * 2 * half + i0;
#pragma unroll
                for (int ai = 0; ai < 2; ++ai) if (ai < nai)
#pragma unroll
                    for (int m = 0; m < 4; ++m) { const int row = row0 + ai * HALF + m * 16; f32x4 x1 = acc[ai][bj][m][0], x2 = acc[ai][bj][m][1];
                        if (lat) { const int ns = row & seqmask, pos = blk ? (ns & 63) : (ns >> 6); const f32x4 c = *(const f32x4*)(tb + pos * half + i0), s = *(const f32x4*)(tb + 64 * half + pos * half + i0);
                            const f32x4 y1 = x1 * c - x2 * s, y2 = x2 * c + x1 * s; x1 = y1; x2 = y2; }
                        u32x2 w1, w2; w1.x = cvt_pk_bf16(x1[0], x1[1]); w1.y = cvt_pk_bf16(x1[2], x1[3]); w2.x = cvt_pk_bf16(x2[0], x2[1]); w2.y = cvt_pk_bf16(x2[2], x2[3]);
                        bf16_t* rowp = O + (size_t)row * ldc + c1; *(u32x2*)rowp = w1; *(u32x2*)(rowp + half) = w2; }
            } else {
#pragma unroll
                for (int ai = 0; ai < 2; ++ai) if (ai < nai)
#pragma unroll
                    for (int m = 0; m < 4; ++m) { const f32x4 v0 = acc[ai][bj][m][0], v1 = acc[ai][bj][m][1];
                        u32x4 w; w.x = cvt_pk_bf16(v0[0], v0[1]); w.y = cvt_pk_bf16(v0[2], v0[3]); w.z = cvt_pk_bf16(v1[0], v1[1]); w.w = cvt_pk_bf16(v1[2], v1[3]);
                        *(u32x4*)(O + (size_t)(row0 + ai * HALF + m * 16) * ldc + p0) = w; }
            }
        }
        if (stat) {
#pragma unroll
            for (int ai = 0; ai < 2; ++ai) if (ai < nai)
#pragma unroll
                for (int m = 0; m < 4; ++m) { float ss = 0.f;
#pragma unroll
                    for (int bj = 0; bj < 2; ++bj) { const f32x4 v0 = acc[ai][bj][m][0], v1 = acc[ai][bj][m][1];
                        ss += ((v0[0] * v0[0] + v0[1] * v0[1]) + (v0[2] * v0[2] + v0[3] * v0[3])) + ((v1[0] * v1[0] + v1[1] * v1[1]) + (v1[2] * v1[2] + v1[3] * v1[3])); }
                    ss += __int_as_float(__builtin_amdgcn_ds_swizzle(__float_as_int(ss), (16 << 10) | 0x1f));
                    { auto rr = __builtin_amdgcn_permlane32_swap(__float_as_uint(ss), __float_as_uint(ss), false, false); ss = __uint_as_float(rr[0]) + __uint_as_float(rr[1]); }
                    if (fq == 0) __hip_atomic_fetch_add(ssq + (size_t)(u.pn >> 1) * ssq_rows + row0 + ai * HALF + m * 16, ss, __ATOMIC_RELAXED, __HIP_MEMORY_SCOPE_AGENT); }
        }
    }
};

#ifndef PG8_ALIGN_DEFAULT
#define PG8_ALIGN_DEFAULT true
#endif
__device__ __forceinline__ f32x4 zero_quad() { f32x2 lo, hi; asm volatile("v_mov_b64 %0, 0" : "=v"(lo)); asm volatile("v_mov_b64 %0, 0" : "=v"(hi)); return (f32x4){lo[0], lo[1], hi[0], hi[1]}; }
template <class Epi, class Sched, bool ALIGN_EPI = PG8_ALIGN_DEFAULT, bool HALFM = false>
__device__ __forceinline__ void gemm_phase(PG8_LAS unsigned char* lds, const Gemm g, const Sched& S, const Epi& E, const int tid) {
    const int wid = __builtin_amdgcn_readfirstlane(tid >> 6), lane = tid & 63, wr = wid >> 2, wc = wid & 3, fr = lane & 15, fq = lane >> 4;
    const int K = g.K, nt = K / BK;
    unsigned voffA[2], voffB[2];
#pragma unroll
    for (int i = 0; i < 2; ++i) { int R, C; stage_rc(tid * 16 + i * 8192, R, C); const int Rb = Epi::PERM ? ((R & ~31) + perm32(R & 31)) : R;
        voffA[i] = (unsigned)(R * g.lda + C) * 2u; voffB[i] = (unsigned)(Rb * g.ldb + C) * 2u; }
    const size_t kstep = (size_t)(BK * 2), kstepA = g.kstepA ? (size_t)g.kstepA : kstep;
    const size_t hstepA = (size_t)HALF * g.lda * 2, hstepB = (size_t)HALF * g.ldb * 2;
    const size_t tstepA = 2 * hstepA, tstepB = 2 * hstepB; const size_t hA1 = HALFM ? (size_t)0 : hstepA;
#define PG8_AOFF(u) ((size_t)(u).pm * tstepA + ((HALFM && (u).hm == 2) ? hstepA : (size_t)0) + ((u).pn >= g.a_split_pn ? (size_t)g.a_split_off * 2 : (size_t)0) + (size_t)(u).ks * (g.ksplitA ? (size_t)g.ksplitA : (size_t)g.ksplit * 2))
#define PG8_BOFF(u) ((size_t)(u).pn * tstepB + (size_t)(u).ks * g.ksplit * 2)
    const unsigned ldsw = (unsigned)wid * 1024u;
    const int aoff = lds_byte(wr * 64 + fr, fq * 8), boff = lds_byte(wc * 32 + fr, fq * 8);
#define PG8_SA(b, h) (((b) * 2 + (h)) * HTB)
#define PG8_SB(b, h) ((4 + (b) * 2 + (h)) * HTB)
#define PG8_STAGE(bufoff, gbase, voff) do { _Pragma("unroll") for (int _i = 0; _i < 2; ++_i) \
        __builtin_amdgcn_global_load_lds((const unsigned*)((const char*)(gbase) + (voff)[_i]), (PG8_LAS unsigned*)(lds + (bufoff) + ldsw + _i * 8192), 16, 0, 0); } while (0)
#define PG8_LDA(dst, b, h) do { _Pragma("unroll") for (int m = 0; m < 4; ++m) _Pragma("unroll") for (int k = 0; k < 2; ++k) dst[m][k] = *(const PG8_LAS bf16x8*)(lds + PG8_SA(b, h) + aoff + m * 2048 + k * 1024); } while (0)
#define PG8_LDB(dst, b, h) do { _Pragma("unroll") for (int n = 0; n < 2; ++n) _Pragma("unroll") for (int k = 0; k < 2; ++k) dst[n][k] = *(const PG8_LAS bf16x8*)(lds + PG8_SB(b, h) + boff + n * 2048 + k * 1024); } while (0)
#define PG8_MMA(ai, bj, At, Bt) do { __builtin_amdgcn_s_setprio(1); _Pragma("unroll") for (int m = 0; m < 4; ++m) _Pragma("unroll") for (int n = 0; n < 2; ++n) _Pragma("unroll") for (int k = 0; k < 2; ++k) \
        acc[ai][bj][m][n] = __builtin_amdgcn_mfma_f32_16x16x32_bf16(Bt[n][k], At[m][k], acc[ai][bj][m][n], 0, 0, 0); __builtin_amdgcn_s_setprio(0); } while (0)
#define PG8_WAIT_V(n) asm volatile("s_waitcnt vmcnt(" #n ")" ::: "memory")
#define PG8_WAIT_L(n) asm volatile("s_waitcnt lgkmcnt(" #n ")" ::: "memory")
#define PG8_BAR __builtin_amdgcn_s_barrier()
#define PG8_SCHED __builtin_amdgcn_sched_barrier(0)
    Unit cur, nxt; int ui = 0;
    if (!S.next(0, cur)) return;
    f32x4 acc[2][2][4][2];
#pragma unroll
    for (int a = 0; a < 2; ++a)
#pragma unroll
        for (int b = 0; b < 2; ++b)
#pragma unroll
            for (int m = 0; m < 4; ++m)
#pragma unroll
                for (int n = 0; n < 2; ++n) acc[a][b][m][n] = zero_quad();
    bf16x8 At[4][2], B0[2][2], B1[2][2];
    const char* cA = (const char*)g.A + PG8_AOFF(cur); const char* cB = (const char*)g.Bt + PG8_BOFF(cur);
    S.a_ready(cur);
    {
        PG8_STAGE(PG8_SB(0, 0), cB, voffB); PG8_STAGE(PG8_SB(0, 1), cB + hstepB, voffB); PG8_STAGE(PG8_SA(0, 0), cA, voffA); PG8_STAGE(PG8_SA(0, 1), cA + hA1, voffA);
        if (wr == 1) PG8_BAR;
        PG8_WAIT_V(2); PG8_BAR;
        PG8_STAGE(PG8_SB(1, 0), cB + kstep, voffB); PG8_STAGE(PG8_SA(1, 0), cA + kstepA, voffA); PG8_STAGE(PG8_SB(1, 1), cB + hstepB + kstep, voffB);
        PG8_WAIT_V(6); PG8_BAR;
    }
    for (;;) {
        const bool has_next = S.next(ui + 1, nxt);
        const char* nA = has_next ? (const char*)g.A + PG8_AOFF(nxt) : cA; const char* nB = has_next ? (const char*)g.Bt + PG8_BOFF(nxt) : cB;
        for (int t = 0; t < nt; t += 2) {
            const bool last = (t == nt - 2);
            const char* a1 = cA + (size_t)(t + 1) * kstepA;
            const char* a2 = last ? nA : cA + (size_t)(t + 2) * kstepA; const char* b2 = last ? nB : cB + (size_t)(t + 2) * kstep;
            const char* a3 = a2 + kstepA; const char* b3 = b2 + kstep;
            if (last && has_next) S.a_ready(nxt);
            {
            PG8_LDB(B0, 0, 0); PG8_LDB(B1, 0, 1); PG8_SCHED; PG8_LDA(At, 0, 0); PG8_STAGE(PG8_SA(1, 1), a1 + hA1, voffA);
            PG8_WAIT_V(8); PG8_WAIT_L(0); PG8_BAR; PG8_MMA(0, 0, At, B0); PG8_MMA(0, 1, At, B1); PG8_BAR; PG8_SCHED;
            PG8_LDA(At, 0, 1); PG8_STAGE(PG8_SB(0, 0), b2, voffB); PG8_STAGE(PG8_SB(0, 1), b2 + hstepB, voffB); PG8_STAGE(PG8_SA(0, 0), a2, voffA);
            PG8_WAIT_V(8); PG8_WAIT_L(0); PG8_BAR; if constexpr (!HALFM) { PG8_MMA(1, 0, At, B0); PG8_MMA(1, 1, At, B1); } PG8_BAR; PG8_SCHED;
            PG8_LDB(B0, 1, 0); PG8_LDB(B1, 1, 1); PG8_SCHED; PG8_LDA(At, 1, 0); PG8_STAGE(PG8_SA(0, 1), a2 + hA1, voffA);
            PG8_WAIT_V(8); PG8_WAIT_L(0); PG8_BAR; PG8_MMA(0, 0, At, B0); PG8_MMA(0, 1, At, B1); PG8_BAR; PG8_SCHED;
            PG8_LDA(At, 1, 1); PG8_STAGE(PG8_SB(1, 0), b3, voffB); PG8_STAGE(PG8_SB(1, 1), b3 + hstepB, voffB); PG8_STAGE(PG8_SA(1, 0), a3, voffA);
            PG8_WAIT_V(8); PG8_WAIT_L(0); PG8_BAR; if constexpr (!HALFM) { PG8_MMA(1, 0, At, B0); PG8_MMA(1, 1, At, B1); } PG8_BAR; PG8_SCHED;
            }
        }
        if constexpr (ALIGN_EPI) { if (wr == 0) PG8_BAR; }
        if constexpr (!Epi::AFTER_DRAIN) { E(acc, cur, wr, wc, fr, fq); S.done(cur); }
        if (!has_next) break;
#pragma unroll
        for (int a = 0; a < 2; ++a)
#pragma unroll
            for (int b = 0; b < 2; ++b)
#pragma unroll
                for (int m = 0; m < 4; ++m)
#pragma unroll
                    for (int n = 0; n < 2; ++n) acc[a][b][m][n] = zero_quad();
        cur = nxt; cA = nA; cB = nB; ++ui;
        if constexpr (ALIGN_EPI) { if (wr == 1) PG8_BAR; }
    }
    PG8_WAIT_V(0);
    if constexpr (!ALIGN_EPI) { if (wr == 0) PG8_BAR; }
    PG8_BAR;
    if constexpr (Epi::AFTER_DRAIN) { E.fused(acc, cur, wr, wc, fr, fq, lds, wid, lane); S.done(cur); }
#undef PG8_AOFF
#undef PG8_BOFF
#undef PG8_SA
#undef PG8_SB
#undef PG8_STAGE
#undef PG8_LDA
#undef PG8_LDB
#undef PG8_MMA
#undef PG8_WAIT_V
#undef PG8_WAIT_L
#undef PG8_BAR
#undef PG8_SCHED
}
}
namespace att {
typedef unsigned short bf16;
using bf16x8 = __attribute__((ext_vector_type(8))) short;
using s16x4  = __attribute__((ext_vector_type(4))) short;
using f32x16 = __attribute__((ext_vector_type(16))) float;
using f32x4  = __attribute__((ext_vector_type(4))) float;
using u32x4  = __attribute__((ext_vector_type(4))) unsigned;
constexpr int NW = 8, QBLK = 32, KVBLK = 64, DV = 128;
constexpr float THR = 8.f;
#define ATT_SBAR() __builtin_amdgcn_sched_barrier(0)
__device__ __forceinline__ int crow(int r, int hi) { return (r & 3) + 8 * (r >> 2) + 4 * hi; }
typedef float f32x2_t __attribute__((ext_vector_type(2))); typedef __bf16 bf16x2_t __attribute__((ext_vector_type(2)));
__device__ __forceinline__ unsigned cvtpk(float lo, float hi) { f32x2_t v = {lo, hi}; bf16x2_t b = __builtin_convertvector(v, bf16x2_t); return __builtin_bit_cast(unsigned, b); }
__device__ __forceinline__ float bf2f(short s) { return __uint_as_float(((unsigned)(unsigned short)s) << 16); }
__device__ __forceinline__ short f2bf(float f) { unsigned u = __float_as_uint(f); u += 0x7fffu + ((u >> 16) & 1u); return (short)(u >> 16); }

template <int DQK> struct Cfg {
    static constexpr int KROW = DQK * 2 + 16;
    static constexpr int SHM_V = KVBLK * DV * 2, SHM_K = KVBLK * KROW;
    static constexpr int OFF_V = 0, OFF_K = 2 * SHM_V, OFF_WS = 2 * SHM_V + 2 * SHM_K, BYTES = OFF_WS + NW * 64 * 4;
};

__device__ __forceinline__ void partialSM(f32x16& p0, f32x16& p1, float& m_reg, float& mn, float& alpha, const float C, const float TS) {
    float pmax = p0[0];
#pragma unroll
    for (int r = 1; r < 16; ++r) pmax = fmaxf(pmax, p0[r]);
#pragma unroll
    for (int r = 0; r < 16; ++r) pmax = fmaxf(pmax, p1[r]);
    { auto rr = __builtin_amdgcn_permlane32_swap(__float_as_uint(pmax), __float_as_uint(pmax), false, false);
      pmax = fmaxf(__uint_as_float(rr[0]), __uint_as_float(rr[1])); }
    if (__builtin_expect(__all(pmax - m_reg <= TS), 1)) { mn = m_reg; alpha = 1.f; }
    else { mn = fmaxf(m_reg, pmax); alpha = __builtin_amdgcn_exp2f((m_reg - mn) * C); m_reg = mn; }
    const float mnC = -mn * C;
#pragma unroll
    for (int r = 0; r < 16; ++r) p0[r] = fmaf(p0[r], C, mnC);
#pragma unroll
    for (int r = 0; r < 16; ++r) p1[r] = fmaf(p1[r], C, mnC);
#pragma unroll
    for (int r = 0; r < 16; ++r) p0[r] = __builtin_amdgcn_exp2f(p0[r]);
}
__device__ __forceinline__ void finishSM(f32x16& p0, f32x16& p1, float alpha, float& l_reg, bf16x8& pa0, bf16x8& pa1, bf16x8& pa2, bf16x8& pa3) {
#pragma unroll
    for (int r = 0; r < 16; ++r) p1[r] = __builtin_amdgcn_exp2f(p1[r]);
    float ps = 0;
#pragma unroll
    for (int r = 0; r < 16; ++r) ps += p0[r];
#pragma unroll
    for (int r = 0; r < 16; ++r) ps += p1[r];
    { auto rr = __builtin_amdgcn_permlane32_swap(__float_as_uint(ps), __float_as_uint(ps), false, false);
      ps = __uint_as_float(rr[0]) + __uint_as_float(rr[1]); }
    l_reg = l_reg * alpha + ps;
#define ATT_PK4(P, BASE, OUT) do { unsigned a0 = cvtpk(P[BASE + 0], P[BASE + 1]), a1 = cvtpk(P[BASE + 2], P[BASE + 3]);   \
    unsigned b0 = cvtpk(P[BASE + 4], P[BASE + 5]), b1 = cvtpk(P[BASE + 6], P[BASE + 7]);                              \
    auto r0 = __builtin_amdgcn_permlane32_swap(a0, b0, false, false); auto r1 = __builtin_amdgcn_permlane32_swap(a1, b1, false, false); \
    u32x4 w = {r0[0], r1[0], r0[1], r1[1]}; OUT = *reinterpret_cast<bf16x8*>(&w); } while (0)
    ATT_PK4(p0, 0, pa0); ATT_PK4(p0, 8, pa1); ATT_PK4(p1, 0, pa2); ATT_PK4(p1, 8, pa3);
}
template <int DQK> __device__ __forceinline__ void qkt(f32x16& p0, f32x16& p1, const char* Ks, const bf16x8* qr, int r32, int hi) {
    constexpr int KROW = Cfg<DQK>::KROW;
    p0 = f32x16{}; p1 = f32x16{};
#pragma unroll
    for (int d0 = 0; d0 < DQK / 16; ++d0) { const int cb = (d0 * 16 + hi * 8) * 2;
        const bf16x8 b0 = *reinterpret_cast<const bf16x8*>(Ks + r32 * KROW + cb);
        const bf16x8 b1 = *reinterpret_cast<const bf16x8*>(Ks + (32 + r32) * KROW + cb);
        p0 = __builtin_amdgcn_mfma_f32_32x32x16_bf16(b0, qr[d0], p0, 0, 0, 0);
        p1 = __builtin_amdgcn_mfma_f32_32x32x16_bf16(b1, qr[d0], p1, 0, 0, 0); }
}
__device__ __forceinline__ int v_st(int k, int c) { const int kk = (k & ~0xC) | ((k & 4) << 1) | ((k & 8) >> 1); return ((kk >> 3) * 4 + (c >> 5)) * 512 + ((kk & 7) * 32 + (c & 31)) * 2; }
__device__ __forceinline__ int v_rd_base(int lane) { return ((lane & 3) << 3) | (((lane >> 2) & 3) << 6) | (((lane >> 4) & 1) << 5) | (((lane >> 5) & 1) << 8); }
constexpr int v_rd_off(int d0, int ks, int half) { return d0 * 512 + ks * 4096 + half * 2048; }
template <int OFF> __device__ __forceinline__ s16x4 tr_read(int vb) { s16x4 r; asm volatile("ds_read_b64_tr_b16 %0, %1 offset:%2" : "=&v"(r) : "v"(vb), "i"(OFF) : "memory"); return r; }
template <int D0> __device__ __forceinline__ void pv_one(f32x16& od, int vb, bf16x8 pa0, bf16x8 pa1, bf16x8 pa2, bf16x8 pa3) {
    const s16x4 l0 = tr_read<v_rd_off(D0, 0, 0)>(vb), h0 = tr_read<v_rd_off(D0, 0, 1)>(vb), l1 = tr_read<v_rd_off(D0, 1, 0)>(vb), h1 = tr_read<v_rd_off(D0, 1, 1)>(vb);
    const s16x4 l2 = tr_read<v_rd_off(D0, 2, 0)>(vb), h2 = tr_read<v_rd_off(D0, 2, 1)>(vb), l3 = tr_read<v_rd_off(D0, 3, 0)>(vb), h3 = tr_read<v_rd_off(D0, 3, 1)>(vb);
    asm volatile("s_waitcnt lgkmcnt(0)" ::: "memory"); ATT_SBAR();
#define ATT_PK(L, H) (bf16x8){L[0], L[1], L[2], L[3], H[0], H[1], H[2], H[3]}
    od = __builtin_amdgcn_mfma_f32_32x32x16_bf16(pa0, ATT_PK(l0, h0), od, 0, 0, 0);
    od = __builtin_amdgcn_mfma_f32_32x32x16_bf16(pa1, ATT_PK(l1, h1), od, 0, 0, 0);
    od = __builtin_amdgcn_mfma_f32_32x32x16_bf16(pa2, ATT_PK(l2, h2), od, 0, 0, 0);
    od = __builtin_amdgcn_mfma_f32_32x32x16_bf16(pa3, ATT_PK(l3, h3), od, 0, 0, 0);
}
__device__ __forceinline__ void pv_d0(f32x16* o, int vb, bf16x8 pa0, bf16x8 pa1, bf16x8 pa2, bf16x8 pa3) {
    pv_one<0>(o[0], vb, pa0, pa1, pa2, pa3); pv_one<1>(o[1], vb, pa0, pa1, pa2, pa3); pv_one<2>(o[2], vb, pa0, pa1, pa2, pa3); pv_one<3>(o[3], vb, pa0, pa1, pa2, pa3);
}
template <int OFF> __device__ __forceinline__ bf16x8 k_read(int ka) { bf16x8 r; asm volatile("ds_read_b128 %0, %1 offset:%2" : "=&v"(r) : "v"(ka), "i"(OFF) : "memory"); return r; }
template <int N> __device__ __forceinline__ void lgk_wait() { asm volatile("s_waitcnt lgkmcnt(%0)" :: "n"(N) : "memory"); }
constexpr int CS_LA = 6;
template <int DQK, int KB, int VB, bool PV, int F> __device__ __forceinline__ void cs_read(bf16x8 (&kf)[CS_LA + 1], s16x4 (&vf)[CS_LA + 1][2], const int ka, const int vb) {
    constexpr int KROW = Cfg<DQK>::KROW, KO = KB * Cfg<DQK>::SHM_K, VO = VB * Cfg<DQK>::SHM_V, NMK = DQK / 8, NM = NMK + (PV ? 16 : 0);
    if constexpr (F < NMK) kf[F % (CS_LA + 1)] = k_read<KO + (F & 1) * 32 * KROW + (F / 2) * 32>(ka);
    else if constexpr (F < NM) { constexpr int v = F - NMK;
        vf[F % (CS_LA + 1)][0] = tr_read<VO + v_rd_off(v / 4, v % 4, 0)>(vb); vf[F % (CS_LA + 1)][1] = tr_read<VO + v_rd_off(v / 4, v % 4, 1)>(vb); }
}
template <int DQK, bool PV> constexpr int cs_outstanding(int I) {
    const int NMK = DQK / 8, NM = NMK + (PV ? 16 : 0); int n = 0;
    for (int f = I + 1; f <= I + CS_LA - 1 && f < NM; ++f) n += (f < NMK) ? 1 : 2;
    return n;
}
template <int DQK, int KB, int VB, bool PV, int I> __device__ __forceinline__ void cs_step(f32x16& p0, f32x16& p1, f32x16* o, const bf16x8* qr, bf16x8 (&kf)[CS_LA + 1], s16x4 (&vf)[CS_LA + 1][2], const int ka, const int vb, const bf16x8 (&pa)[4]) {
    constexpr int NMK = DQK / 8, NM = NMK + (PV ? 16 : 0);
    if constexpr (I < NM) {
        lgk_wait<cs_outstanding<DQK, PV>(I)>(); ATT_SBAR();
        if constexpr (I < NMK) { if constexpr ((I & 1) == 0) p0 = __builtin_amdgcn_mfma_f32_32x32x16_bf16(kf[I % (CS_LA + 1)], qr[I / 2], p0, 0, 0, 0); else p1 = __builtin_amdgcn_mfma_f32_32x32x16_bf16(kf[I % (CS_LA + 1)], qr[I / 2], p1, 0, 0, 0); }
        else { constexpr int v = I - NMK; o[v / 4] = __builtin_amdgcn_mfma_f32_32x32x16_bf16(pa[v % 4], ATT_PK(vf[I % (CS_LA + 1)][0], vf[I % (CS_LA + 1)][1]), o[v / 4], 0, 0, 0); }
        ATT_SBAR();
        cs_read<DQK, KB, VB, PV, I + CS_LA>(kf, vf, ka, vb);
    }
}
template <int DQK, int KB, int VB, bool PV>
__device__ __forceinline__ void c_segment(f32x16& p0, f32x16& p1, f32x16* o, const bf16x8* qr, const int ka, const int vb, const bf16x8 pa0, const bf16x8 pa1, const bf16x8 pa2, const bf16x8 pa3) {
    bf16x8 kf[CS_LA + 1]; s16x4 vf[CS_LA + 1][2]; const bf16x8 pa[4] = {pa0, pa1, pa2, pa3};
    __builtin_amdgcn_s_setprio(1);
    cs_read<DQK, KB, VB, PV, 0>(kf, vf, ka, vb); cs_read<DQK, KB, VB, PV, 1>(kf, vf, ka, vb); cs_read<DQK, KB, VB, PV, 2>(kf, vf, ka, vb); cs_read<DQK, KB, VB, PV, 3>(kf, vf, ka, vb);
    if constexpr (CS_LA > 4) cs_read<DQK, KB, VB, PV, 4>(kf, vf, ka, vb); if constexpr (CS_LA > 5) cs_read<DQK, KB, VB, PV, 5>(kf, vf, ka, vb); if constexpr (CS_LA > 6) cs_read<DQK, KB, VB, PV, 6>(kf, vf, ka, vb); if constexpr (CS_LA > 7) cs_read<DQK, KB, VB, PV, 7>(kf, vf, ka, vb);
    p0 = f32x16{}; p1 = f32x16{};
#define CS_S(i) cs_step<DQK, KB, VB, PV, i>(p0, p1, o, qr, kf, vf, ka, vb, pa)
    CS_S(0); CS_S(1); CS_S(2); CS_S(3); CS_S(4); CS_S(5); CS_S(6); CS_S(7); CS_S(8); CS_S(9); CS_S(10); CS_S(11); CS_S(12); CS_S(13); CS_S(14); CS_S(15); CS_S(16); CS_S(17); CS_S(18); CS_S(19);
    CS_S(20); CS_S(21); CS_S(22); CS_S(23); CS_S(24); CS_S(25); CS_S(26); CS_S(27); CS_S(28); CS_S(29); CS_S(30); CS_S(31); CS_S(32); CS_S(33); CS_S(34); CS_S(35); CS_S(36); CS_S(37); CS_S(38); CS_S(39);
#undef CS_S
    __builtin_amdgcn_s_setprio(0);
}
template <int DQK, int VB>
__device__ __forceinline__ void pv_segment(f32x16* o, const int vb, const bf16x8 pa0, const bf16x8 pa1, const bf16x8 pa2, const bf16x8 pa3) {
    constexpr int VO = VB * Cfg<DQK>::SHM_V;
    s16x4 vf[CS_LA + 1][2]; const bf16x8 pa[4] = {pa0, pa1, pa2, pa3};
#define PV_RD(v) do { if constexpr ((v) < 16) { vf[(v) % (CS_LA + 1)][0] = tr_read<VO + v_rd_off((v) / 4, (v) % 4, 0)>(vb); vf[(v) % (CS_LA + 1)][1] = tr_read<VO + v_rd_off((v) / 4, (v) % 4, 1)>(vb); } } while (0)
#define PV_S(v) do { lgk_wait<2 * (((v) + CS_LA - 1 < 16 ? (v) + CS_LA - 1 : 15) - (v))>(); ATT_SBAR(); \
    o[(v) / 4] = __builtin_amdgcn_mfma_f32_32x32x16_bf16(pa[(v) % 4], ATT_PK(vf[(v) % (CS_LA + 1)][0], vf[(v) % (CS_LA + 1)][1]), o[(v) / 4], 0, 0, 0); ATT_SBAR(); PV_RD((v) + CS_LA); } while (0)
    PV_RD(0); PV_RD(1); PV_RD(2); PV_RD(3); if constexpr (CS_LA > 4) PV_RD(4); if constexpr (CS_LA > 5) PV_RD(5); if constexpr (CS_LA > 6) PV_RD(6); if constexpr (CS_LA > 7) PV_RD(7);
    PV_S(0); PV_S(1); PV_S(2); PV_S(3); PV_S(4); PV_S(5); PV_S(6); PV_S(7); PV_S(8); PV_S(9); PV_S(10); PV_S(11); PV_S(12); PV_S(13); PV_S(14); PV_S(15);
#undef PV_RD
#undef PV_S
}
__device__ __forceinline__ void rope_pair(bf16x8& a, bf16x8& b, const float* cs, const float* sn) {
    const f32x4 c0 = *(const f32x4*)cs, c1 = *(const f32x4*)(cs + 4), s0 = *(const f32x4*)sn, s1 = *(const f32x4*)(sn + 4);
#pragma unroll
    for (int e = 0; e < 8; ++e) { const float c = e < 4 ? c0[e & 3] : c1[e & 3], s = e < 4 ? s0[e & 3] : s1[e & 3]; const float x1 = bf2f(a[e]), x2 = bf2f(b[e]);
        a[e] = f2bf(x1 * c - x2 * s); b[e] = f2bf(x2 * c + x1 * s); }
}

struct Unit {
    const bf16* Q;
    const bf16* Kn;
    const bf16* Kr;
    const bf16* V;
    int t0a, nta, t0b, ntb;
    int mask;
    int qpos0, kpos0;
    int has_sink; float sink;
    int rope;
    const float* tab;
    bf16* O;
};

template <int DQK, int SDEPTH, int LDQ, int LDKN, int LDKR, int LDV, int LDO, int VAR = 0>
__device__ __forceinline__ void attn_unit(const Unit& U, char* lds, const float scale, const int tid) {
    using C_ = Cfg<DQK>;
    constexpr int KROW = C_::KROW, SHM_V = C_::SHM_V, SHM_K = C_::SHM_K, ND = DQK / 16;
    const float C = scale * 1.4426950408889634f, TS = THR / scale;
    const int wid = __builtin_amdgcn_readfirstlane(tid >> 6), lane = tid & 63, r32 = lane & 31, hi = lane >> 5;
    char* V_lds = lds + C_::OFF_V; char* K_lds = lds + C_::OFF_K;
    float* ws = (float*)(lds + C_::OFF_WS) + wid * 64; float* li_l = ws; float* al_l = ws + 32;
    float m_reg = -1e30f, l_reg = 0; f32x16 o[4] = {}; bf16x8 qr[ND];
    const int sr = tid >> 4, sc = (tid & 15) * 8, vst0 = v_st(sr, sc), vst1 = v_st(32 + sr, sc);
    const int kr_r = tid >> 3, kr_c = (tid & 7) * 8;
    const int vb0 = (int)(uintptr_t)V_lds + v_rd_base(lane), ka0 = (int)(uintptr_t)K_lds + r32 * KROW + hi * 16;
    bf16x8 vs0, vs1, ks0, ks1, kx;
    const int NT = U.nta + U.ntb;
#define ATT_TOK(j) ((j) < U.nta ? U.t0a + (j) * KVBLK : U.t0b + ((j) - U.nta) * KVBLK)
    const unsigned offV = (unsigned)(sr * LDV + sc) * 2u, offK = (unsigned)(sr * LDKN + sc) * 2u, offR = (unsigned)(kr_r * LDKR + kr_c) * 2u;
#define ATT_LOADV(j) do { const long tk = ATT_TOK(j); const char* vb_ = (const char*)(U.V + tk * LDV); \
    vs0 = *reinterpret_cast<const bf16x8*>(vb_ + offV); vs1 = *reinterpret_cast<const bf16x8*>(vb_ + (size_t)(32 * LDV * 2) + offV); } while (0)
#define ATT_LOADK(j) do { const long tk = ATT_TOK(j); const char* kb_ = (const char*)(U.Kn + tk * LDKN); \
    ks0 = *reinterpret_cast<const bf16x8*>(kb_ + offK); ks1 = *reinterpret_cast<const bf16x8*>(kb_ + (size_t)(32 * LDKN * 2) + offK); \
    if constexpr (DQK == 192) { const char* rb_ = (const char*)(U.Kr + tk * LDKR); kx = *reinterpret_cast<const bf16x8*>(rb_ + offR); } } while (0)
#define ATT_WRITEV(b) do { *(bf16x8*)(V_lds + (b) * SHM_V + vst0) = vs0; *(bf16x8*)(V_lds + (b) * SHM_V + vst1) = vs1; } while (0)
#define ATT_WRITEK(b) do { *(bf16x8*)(K_lds + (b) * SHM_K + sr * KROW + sc * 2) = ks0; *(bf16x8*)(K_lds + (b) * SHM_K + (32 + sr) * KROW + sc * 2) = ks1; \
    if constexpr (DQK == 192) *(bf16x8*)(K_lds + (b) * SHM_K + kr_r * KROW + (128 + kr_c) * 2) = kx; } while (0)
#define ATT_VWAIT() asm volatile("s_waitcnt vmcnt(0)" ::: "memory")
#define ATT_RESC(a) do { if (__any((a) < 1.f)) { if (hi == 0) al_l[r32] = (a); asm volatile("s_waitcnt lgkmcnt(0)" ::: "memory"); \
    _Pragma("unroll") for (int d = 0; d < 4; ++d) _Pragma("unroll") for (int r = 0; r < 16; ++r) o[d][r] *= al_l[crow(r, hi)]; } } while (0)
    const int qpos = U.qpos0 + wid * QBLK + r32;
#define ATT_MASK(P0, P1, j) do { if (U.mask && (j) < U.nta) { const int kb = U.kpos0 + (j) * KVBLK + 4 * hi - qpos; \
    _Pragma("unroll") for (int r = 0; r < 16; ++r) { const int dk = kb + (r & 3) + 8 * (r >> 2); \
        if (dk > 128 || dk < -128) P0[r] = -INFINITY; if (dk + 32 > 128 || dk + 32 < -128) P1[r] = -INFINITY; } } } while (0)
#define ATT_SEAM() do { ATT_SBAR(); __syncthreads(); ATT_SBAR(); } while (0)
#define ATT_L(j) do { if constexpr ((VAR & 1) != 0) { ATT_PK4(p0, 0, pa0); ATT_PK4(p0, 8, pa1); ATT_PK4(p1, 0, pa2); ATT_PK4(p1, 8, pa3); } else { \
    ATT_MASK(p0, p1, j); partialSM(p0, p1, m_reg, mn, al, C, TS); finishSM(p0, p1, al, l_reg, pa0, pa1, pa2, pa3); ATT_RESC(al); } } while (0)
    ATT_LOADK(0); ATT_LOADV(0);
    const bf16* Qw = U.Q + (long)(wid * QBLK + r32) * LDQ + hi * 8;
#pragma unroll
    for (int d0 = 0; d0 < ND; ++d0) qr[d0] = __builtin_nontemporal_load(reinterpret_cast<const bf16x8*>(Qw + d0 * 16));
    if (U.rope) {
        const int n = U.qpos0 + wid * QBLK + r32, prow = n >> 6, pcol = n & 63;
        if constexpr (DQK == 128) {
            const float* cr = U.tab + prow * 32 + hi * 8; const float* cc = U.tab + pcol * 32 + hi * 8;
            rope_pair(qr[0], qr[2], cr, cr + 2048); rope_pair(qr[1], qr[3], cr + 16, cr + 16 + 2048);
            rope_pair(qr[4], qr[6], cc, cc + 2048); rope_pair(qr[5], qr[7], cc + 16, cc + 16 + 2048);
        } else {
            const float* cr = U.tab + prow * 16 + hi * 8; const float* cc = U.tab + pcol * 16 + hi * 8;
            rope_pair(qr[8], qr[9], cr, cr + 1024); rope_pair(qr[10], qr[11], cc, cc + 1024);
        }
    }
    f32x16 p0, p1; float mn, al; bf16x8 pa0, pa1, pa2, pa3;
    ATT_VWAIT(); ATT_WRITEK(0); ATT_LOADK(1);
    ATT_SEAM();
#define ATT_LOADK_L(j) do { if constexpr ((VAR & 2) == 0) ATT_LOADK(j); } while (0)
#define ATT_LOADV_L(j) do { if constexpr ((VAR & 2) == 0) ATT_LOADV(j); } while (0)
    if (wid >= 4) __builtin_amdgcn_s_barrier();
    ATT_SBAR();
    c_segment<DQK, 0, 0, false>(p0, p1, o, qr, ka0, vb0, pa0, pa1, pa2, pa3);
    if constexpr ((VAR & 4) == 0) { ATT_VWAIT(); ATT_WRITEK(1); ATT_WRITEV(0); }
    if (2 < NT) ATT_LOADK_L(2); ATT_LOADV_L(1);
    ATT_SEAM(); ATT_L(0); ATT_SEAM();
    for (int j = 1; j + 1 < NT; j += 2) {
        c_segment<DQK, 1, 0, true>(p0, p1, o, qr, ka0, vb0, pa0, pa1, pa2, pa3);
        if constexpr ((VAR & 4) == 0) { ATT_VWAIT(); ATT_WRITEK(0); ATT_WRITEV(1); }
        ATT_LOADK_L(j + 2); ATT_LOADV_L(j + 1);
        ATT_SEAM(); ATT_L(j); ATT_SEAM();
        c_segment<DQK, 0, 1, true>(p0, p1, o, qr, ka0, vb0, pa0, pa1, pa2, pa3);
        if constexpr ((VAR & 4) == 0) { ATT_VWAIT(); ATT_WRITEK(1); ATT_WRITEV(0); }
        if (j + 3 < NT) ATT_LOADK_L(j + 3); ATT_LOADV_L(j + 2);
        ATT_SEAM(); ATT_L(j + 1); ATT_SEAM();
    }
    c_segment<DQK, 1, 0, true>(p0, p1, o, qr, ka0, vb0, pa0, pa1, pa2, pa3);
    if constexpr ((VAR & 4) == 0) { ATT_VWAIT(); ATT_WRITEV(1); }
    ATT_SEAM(); ATT_L(NT - 1); ATT_SEAM();
    pv_segment<DQK, 1>(o, vb0, pa0, pa1, pa2, pa3);
    ATT_SBAR();
    if (wid < 4) __builtin_amdgcn_s_barrier();
    ATT_SBAR();
    if (U.has_sink) l_reg += __builtin_amdgcn_exp2f(U.sink * 1.4426950408889634f - m_reg * C);
    if (hi == 0) li_l[r32] = l_reg; asm volatile("s_waitcnt lgkmcnt(0)" ::: "memory");
    float rli[16];
#pragma unroll
    for (int r = 0; r < 16; ++r) rli[r] = __builtin_amdgcn_rcpf(li_l[crow(r, hi)]);
    bf16* Ow = U.O + (long)(wid * QBLK) * LDO;
#pragma unroll
    for (int r = 0; r < 16; ++r) { const int orow = crow(r, hi);
#pragma unroll
        for (int d0 = 0; d0 < 4; ++d0) Ow[(long)orow * LDO + d0 * 32 + r32] = (bf16)f2bf(o[d0][r] * rli[r]); }
    __syncthreads();
#undef ATT_TOK
#undef ATT_LOADV
#undef ATT_LOADK
#undef ATT_WRITEV
#undef ATT_WRITEK
#undef ATT_VWAIT
#undef ATT_RESC
#undef ATT_MASK
#undef ATT_SEAM
#undef ATT_L
#undef ATT_LOADK_L
#undef ATT_LOADV_L
}
}

namespace gla {
using att::bf16; using att::bf16x8; using att::s16x4; using att::f32x16; using att::f32x4; using att::u32x4; using att::crow; using att::cvtpk; using att::bf2f; using att::f2bf;
constexpr int ROWB = 144;
constexpr int T_QI = 0, T_KI = 64 * ROWB, T_KIT = 2 * 64 * ROWB, T_V = 3 * 64 * ROWB  , T_BYTES = T_V + 16384  ;
constexpr int OFF_ST = 2 * T_BYTES  , OFF_DEC = OFF_ST + 128 * ROWB  , BYTES = OFF_DEC + 2 * 256;
static_assert(T_V % 16 == 0 && T_BYTES % 16 == 0 && OFF_ST % 16 == 0 && BYTES <= 131072, "gla LDS map");
struct Unit {
    const bf16* P; int ldp;
    const float* wg; const float* bg;
    bf16* og;
    int b, h, dir;
};
__device__ __forceinline__ float log_sigmoid(float z) { return fminf(z, 0.f) - __logf(1.f + __expf(-fabsf(z))); }
template <int CTRL, int ROWMASK> __device__ __forceinline__ float dpp_add(float v) { return v + __int_as_float(__builtin_amdgcn_update_dpp(0, __float_as_int(v), CTRL, ROWMASK, 0xf, false)); }
__device__ __forceinline__ float wave_prefix(float v) {
    v = dpp_add<0x111, 0xf>(v); v = dpp_add<0x112, 0xf>(v); v = dpp_add<0x114, 0xf>(v); v = dpp_add<0x118, 0xf>(v);
    v = dpp_add<0x142, 0xa>(v);
    v = dpp_add<0x143, 0xc>(v);
    return v;
}

__device__ __forceinline__ void gla_unit(const Unit& U, char* lds, const int tid) {
    const int wid = __builtin_amdgcn_readfirstlane(tid >> 6), lane = tid & 63, r32 = lane & 31, hi = lane >> 5;
    const int h = U.h, dir = U.dir;
    for (int i = tid; i < 128 * ROWB / 4; i += 512) ((unsigned*)(lds + OFF_ST))[i] = 0u;
#define GLA_TB(s) ((s) < 4 ? NLAT + U.b * CTX + 64 * (dir ? 3 - (s) : (s)) : U.b * SEQ + 64 * (dir ? 67 - (s) : (s) - 4))
#define GLA_TOK(tb, i) ((long)((tb) + (dir ? 63 - (i) : (i))))
    if (wid < 4) {
        typedef short s16x4v __attribute__((ext_vector_type(4)));
        const int w = wid, pt = tid, t16 = lane & 15, dq = lane >> 4;
        s16x4v wa; f32x4 bias4;
#pragma unroll
        for (int e = 0; e < 4; ++e) { wa[e] = f2bf(U.wg[(4 * dq + e) * 256 + h * 64 + 16 * w + t16]); bias4[e] = U.bg[h * 64 + 16 * w + 4 * dq + e]; }
        s16x4v qr_[4], kr_[4], gr_[4]; bf16x8 vv[4];
#define GLA_LOAD(s) do { const int tb_ = GLA_TB(s); \
    _Pragma("unroll") for (int b4 = 0; b4 < 4; ++b4) { const bf16* row = U.P + GLA_TOK(tb_, 16 * b4 + t16) * U.ldp; \
        qr_[b4] = *reinterpret_cast<const s16x4v*>(row + C_GQ + h * 64 + 16 * w + 4 * dq); kr_[b4] = *reinterpret_cast<const s16x4v*>(row + C_GK + h * 64 + 16 * w + 4 * dq); \
        gr_[b4] = *reinterpret_cast<const s16x4v*>(row + C_GLR + dir * 16 + 4 * dq); } \
    _Pragma("unroll") for (int c_ = 0; c_ < 4; ++c_) { const int ch = pt + 256 * c_; vv[c_] = *reinterpret_cast<const bf16x8*>(U.P + GLA_TOK(tb_, ch >> 4) * U.ldp + C_GV + h * 128 + (ch & 15) * 8); } } while (0)
#define GLA_PREP(buf) do { char* T = lds + (buf) * T_BYTES; \
    f32x4 carry = {0.f, 0.f, 0.f, 0.f}; \
    _Pragma("unroll") for (int b4 = 0; b4 < 4; ++b4) { const int irow = 16 * b4 + t16; \
        f32x4 z = __builtin_amdgcn_mfma_f32_16x16x16bf16_1k(wa, gr_[b4], bias4, 0, 0, 0);            \
        s16x4v qo, ko; \
        _Pragma("unroll") for (int r = 0; r < 4; ++r) { float v = log_sigmoid(z[r]) * (1.f / 16.f); \
            v = dpp_add<0x111, 0xf>(v); v = dpp_add<0x112, 0xf>(v); v = dpp_add<0x114, 0xf>(v); v = dpp_add<0x118, 0xf>(v);     \
            v += carry[r]; carry[r] = __int_as_float(__builtin_amdgcn_ds_swizzle(__float_as_int(v), 0x1F0));                    \
            const short ks = f2bf(bf2f(kr_[b4][r]) * __expf(-v)); \
            qo[r] = f2bf(bf2f(qr_[b4][r]) * 0.125f * __expf(v)); ko[r] = ks; \
            *(short*)(T + T_KIT + (16 * w + 4 * dq + r) * ROWB + irow * 2) = ks; } \
        *(s16x4v*)(T + T_QI + irow * ROWB + (16 * w + 4 * dq) * 2) = qo; *(s16x4v*)(T + T_KI + irow * ROWB + (16 * w + 4 * dq) * 2) = ko; } \
    if (t16 == 0) { f32x4 dv; _Pragma("unroll") for (int r = 0; r < 4; ++r) dv[r] = __expf(carry[r]); *(f32x4*)(lds + OFF_DEC + (buf) * 256 + (16 * w + 4 * dq) * 4) = dv; } \
    _Pragma("unroll") for (int c_ = 0; c_ < 4; ++c_) { const int ch = pt + 256 * c_; *(bf16x8*)(T + T_V + att::v_st(ch >> 4, (ch & 15) * 8)) = vv[c_]; } } while (0)
        GLA_LOAD(0); GLA_PREP(0); GLA_LOAD(1);
        __syncthreads();
        for (int s = 0; s < 68; ++s) {
            if (s + 1 < 68) { GLA_PREP((s + 1) & 1); if (s + 2 < 68) GLA_LOAD(s + 2); }
            __syncthreads();
            __syncthreads();
        }
#undef GLA_LOAD
#undef GLA_PREP
    } else {
        const int m = wid - 4, rh = m & 1, ebp = m >> 1;
        f32x16 S0 = {}, S1 = {};
        __syncthreads();
        for (int s = 0; s < 68; ++s) {
            const int tb = GLA_TB(s); const char* T = lds + (s & 1) * T_BYTES; const float* DEC = (const float*)(lds + OFF_DEC + (s & 1) * 256);
            const int vb = (int)(uintptr_t)(T + T_V) + att::v_rd_base(lane) + (2 * ebp) * 512;
            bf16x8 qf[4];
#pragma unroll
            for (int d0 = 0; d0 < 4; ++d0) qf[d0] = *reinterpret_cast<const bf16x8*>(T + T_QI + (rh * 32 + r32) * ROWB + (d0 * 16 + hi * 8) * 2);
            f32x16 p0 = {}, p1 = {};
#pragma unroll
            for (int d0 = 0; d0 < 4; ++d0) { const int cb = (d0 * 16 + hi * 8) * 2;
                const bf16x8 ka = *reinterpret_cast<const bf16x8*>(T + T_KI + r32 * ROWB + cb), kb = *reinterpret_cast<const bf16x8*>(T + T_KI + (32 + r32) * ROWB + cb);
                p0 = __builtin_amdgcn_mfma_f32_32x32x16_bf16(ka, qf[d0], p0, 0, 0, 0); p1 = __builtin_amdgcn_mfma_f32_32x32x16_bf16(kb, qf[d0], p1, 0, 0, 0); }
            { const int irow = rh * 32 + r32 - dir;
#pragma unroll
              for (int r = 0; r < 16; ++r) { const int mm = crow(r, hi); if (mm > irow) p0[r] = 0.f; if (mm + 32 > irow) p1[r] = 0.f; } }
            bf16x8 pa0, pa1, pa2, pa3;
            ATT_PK4(p0, 0, pa0); ATT_PK4(p0, 8, pa1); ATT_PK4(p1, 0, pa2); ATT_PK4(p1, 8, pa3);
            bf16x8 kf[4];
#pragma unroll
            for (int ks = 0; ks < 4; ++ks) kf[ks] = *reinterpret_cast<const bf16x8*>(T + T_KIT + (rh * 32 + r32) * ROWB + (ks * 16 + hi * 8) * 2);
            float dec[16];
#pragma unroll
            for (int r = 0; r < 16; ++r) dec[r] = DEC[rh * 32 + crow(r, hi)];
#pragma unroll
            for (int eb2 = 0; eb2 < 2; ++eb2) { const int eb = 2 * ebp + eb2;
                f32x16 o = {};
                att::pv_one<0>(o, vb + eb2 * 512, pa0, pa1, pa2, pa3);
#pragma unroll
                for (int d0 = 0; d0 < 4; ++d0) { const bf16x8 sf = *reinterpret_cast<const bf16x8*>(lds + OFF_ST + (eb * 32 + r32) * ROWB + (d0 * 16 + hi * 8) * 2);
                    o = __builtin_amdgcn_mfma_f32_32x32x16_bf16(qf[d0], sf, o, 0, 0, 0); }
#pragma unroll
                for (int r = 0; r < 16; ++r) U.og[GLA_TOK(tb, rh * 32 + crow(r, hi)) * 512 + h * 128 + eb * 32 + r32] = (bf16)f2bf(o[r]);
                if (eb2 == 0) { att::pv_one<0>(S0, vb, kf[0], kf[1], kf[2], kf[3]);
#pragma unroll
                    for (int r = 0; r < 16; ++r) S0[r] *= dec[r]; }
                else { att::pv_one<0>(S1, vb + 512, kf[0], kf[1], kf[2], kf[3]);
#pragma unroll
                    for (int r = 0; r < 16; ++r) S1[r] *= dec[r]; }
            }
            __syncthreads();
#pragma unroll
            for (int g = 0; g < 4; ++g) { uint2 wv; wv.x = cvtpk(S0[4 * g], S0[4 * g + 1]); wv.y = cvtpk(S0[4 * g + 2], S0[4 * g + 3]);
                *(uint2*)(lds + OFF_ST + ((2 * ebp) * 32 + r32) * ROWB + (rh * 32 + 8 * g + 4 * hi) * 2) = wv;
                uint2 wu; wu.x = cvtpk(S1[4 * g], S1[4 * g + 1]); wu.y = cvtpk(S1[4 * g + 2], S1[4 * g + 3]);
                *(uint2*)(lds + OFF_ST + ((2 * ebp + 1) * 32 + r32) * ROWB + (rh * 32 + 8 * g + 4 * hi) * 2) = wu; }
            __syncthreads();
        }
    }
    __syncthreads();
#undef GLA_TB
#undef GLA_TOK
}
}

constexpr size_t MiB = 1u << 20;
constexpr size_t WS_CTL = 0, CTL_BYTES = 1 * MiB;
constexpr size_t WS_SSQ = 1 * MiB;
constexpr size_t MOD_BYTES = (size_t)DEPTH * 9 * NMOD * D_MODEL * 4;
constexpr size_t ZERO_BYTES = 3 * MiB;
static_assert(WS_SSQ + (size_t)DEPTH * 2 * NTOK * 4 <= ZERO_BYTES, "zeroed region");
constexpr size_t WS_TAB = 3 * MiB;
constexpr size_t WS_RSTD = WS_TAB + 64 * 1024;
constexpr size_t WS_W = 4 * MiB;
constexpr size_t W_IN = 0, W_UQKV = W_IN + (size_t)IN_WP * D_MODEL * 2, W_OUT = W_UQKV + (size_t)(UQ_WP + UKV_W) * 512 * 2, W_GU = W_OUT + (size_t)D_MODEL * D_MODEL * 2,
                 W_DOWN = W_GU + (size_t)2 * FFN * D_MODEL * 2, W_LAYER = W_DOWN + (size_t)D_MODEL * FFN * 2;
constexpr size_t WS_H = WS_W + DEPTH * W_LAYER;
constexpr size_t WS_MIX = WS_H + (size_t)NTOK * D_MODEL * 2;
constexpr size_t WS_XC = WS_MIX + (size_t)NTOK * D_MODEL * 2;
constexpr size_t WS_R1 = WS_XC + (size_t)NCTX * D_MODEL * 4;
constexpr size_t WS_P = WS_R1, WS_Q = WS_P + (size_t)NTOK * IN_WP * 2, WS_KV = WS_Q + (size_t)NTOK * UQ_WP * 2, WS_GOF = WS_KV + (size_t)NTOK * UKV_W * 2,
                 WS_GOB = WS_GOF + (size_t)NTOK * 512 * 4, WS_R1_END = WS_GOB + (size_t)NTOK * 512 * 4;
constexpr size_t WS_ACT = WS_R1;
static_assert(WS_ACT + (size_t)NTOK * FFN * 2 <= WS_R1_END, "ACT overlay fits");
constexpr size_t WS_PART = WS_R1_END;
constexpr size_t WS_XS = WS_PART + (size_t)4 * NCTX * D_MODEL * 4;
constexpr size_t WS_MODX = WS_XS + 2 * MiB;
constexpr size_t WS_END = WS_MODX + 2 * MiB;
static_assert(W_LAYER % 256 == 0 && WS_H % 256 == 0 && WS_R1 % 256 == 0 && WS_Q % 256 == 0 && WS_KV % 256 == 0 && WS_GOF % 256 == 0, "alignment");
constexpr int CW_BAR = 4096;
constexpr int CW_PANEL = 32768;
constexpr int CW_QUEUE = 16384;
constexpr int RING_BYTES = 131072, LDSCTL_OFF = RING_BYTES, LDS_BYTES = 147456;

#define GAS __attribute__((address_space(1)))
#define LAS __attribute__((address_space(3)))
typedef unsigned short bf16;
typedef unsigned v4u __attribute__((ext_vector_type(4)));
typedef unsigned v2u __attribute__((ext_vector_type(2)));
typedef float f32x4 __attribute__((ext_vector_type(4)));
#define LDS_WAIT() asm volatile("s_waitcnt lgkmcnt(0)" ::: "memory")
__device__ __forceinline__ unsigned f2bf(float f) { unsigned u = __builtin_bit_cast(unsigned, f); return (u + 0x7fffu + ((u >> 16) & 1u)) >> 16; }
__device__ __forceinline__ unsigned pk2(float lo, float hi) { return f2bf(lo) | (f2bf(hi) << 16); }
__device__ __forceinline__ float bflo(unsigned w) { return __uint_as_float(w << 16); }
__device__ __forceinline__ float bfhi(unsigned w) { return __uint_as_float(w & 0xffff0000u); }
template <int O> __device__ __forceinline__ float swz_xor(float v) { return __int_as_float(__builtin_amdgcn_ds_swizzle(__float_as_int(v), (O << 10) | 0x1f)); }
__device__ __forceinline__ float sum16(float v) { v += swz_xor<1>(v); v += swz_xor<2>(v); v += swz_xor<4>(v); v += swz_xor<8>(v); return v; }
__device__ __forceinline__ float sum32(float v) { v = sum16(v); v += swz_xor<16>(v); return v; }
__device__ __forceinline__ float wave_sum(float v) { v = sum32(v); auto rr = __builtin_amdgcn_permlane32_swap(__float_as_uint(v), __float_as_uint(v), false, false); return __uint_as_float(rr[0]) + __uint_as_float(rr[1]); }

#define XB_TMO      128
#define XB_XCNT(j)  (256  + 64 * (j))
#define XB_XSUB(j)  (1280 + 64 * (j))
#define XB_XGEN(j)  (2304 + 64 * (j))
#define XB_TOP      3328
#define XB_TOPGEN   3392
#define XCD_BAR_WORDS 3456
#define XB_SPIN_CAP (1u << 21)
__device__ __forceinline__ unsigned xb_ld(unsigned* p)              { return __hip_atomic_load(p, __ATOMIC_RELAXED, __HIP_MEMORY_SCOPE_AGENT); }
__device__ __forceinline__ unsigned xb_add(unsigned* p, unsigned v) { return __hip_atomic_fetch_add(p, v, __ATOMIC_RELAXED, __HIP_MEMORY_SCOPE_AGENT); }
__device__ __forceinline__ unsigned xb_xcc_id() { return (unsigned)__builtin_amdgcn_s_getreg((3 << 11) | 20) & 0xFu; }
#define XB_SPIN(cond, bar) do { unsigned _sp = 0; while (cond) { __builtin_amdgcn_s_sleep(1); \
    if ((++_sp & 255u) == 0u) { if (xb_ld(&(bar)[XB_TMO])) break; if (_sp > XB_SPIN_CAP) { atomicAdd(&(bar)[XB_TMO], 1u); break; } } } } while (0)
struct XcdBarrier { unsigned* bar; unsigned x; volatile LAS unsigned* st; };
__device__ __forceinline__ XcdBarrier xcd_barrier_post(unsigned* bar, volatile LAS unsigned* st) {
    XcdBarrier b; b.bar = bar; b.x = xb_xcc_id(); b.st = st;
    if (threadIdx.x == 0) (void)xb_add(&bar[XB_XCNT(b.x)], 1u);
    return b;
}
__device__ __forceinline__ void xcd_barrier_complete(unsigned* bar, unsigned x, unsigned& nloc, unsigned& nx) {
    const unsigned G = gridDim.x * gridDim.y * gridDim.z;
    unsigned sum, cnt, mine, sp = 0u;
    for (;;) {
        sum = 0u; cnt = 0u; mine = 0u;
#pragma unroll
        for (unsigned j = 0; j < 16; ++j) { const unsigned c = xb_ld(&bar[XB_XCNT(j)]); sum += c; cnt += (c > 0u) ? 1u : 0u; mine = (j == x) ? c : mine; }
        if (sum == G) break;
        __builtin_amdgcn_s_sleep(1);
        if ((++sp & 255u) == 0u) { if (xb_ld(&bar[XB_TMO])) break; if (sp > XB_SPIN_CAP) { atomicAdd(&bar[XB_TMO], 1u); break; } }
    }
    nloc = mine > 0u ? mine : 1u; nx = cnt > 0u ? cnt : 1u;
}
__device__ __forceinline__ void xcd_barrier(const XcdBarrier& b) {
    asm volatile("s_waitcnt vmcnt(0)" ::: "memory");
    __syncthreads();
    if (threadIdx.x == 0) {
        unsigned* bar = b.bar;
        const unsigned bx_ = (unsigned)__builtin_amdgcn_readfirstlane((int)xb_xcc_id());
        __builtin_amdgcn_s_waitcnt(0);
        unsigned nloc = b.st[0], nx = b.st[1];
        if (nloc == 0u) { xcd_barrier_complete(bar, bx_, nloc, nx); b.st[0] = nloc; b.st[1] = nx; }
        const unsigned old = xb_add(&bar[XB_XSUB(bx_)], 1u);
        const unsigned gen = old / nloc;
        if (old + 1u == (gen + 1u) * nloc) {
            __builtin_amdgcn_fence(__ATOMIC_RELEASE, "agent");
            asm volatile("s_waitcnt vmcnt(0)" ::: "memory");
            const unsigned og = xb_add(&bar[XB_TOP], 1u);
            const unsigned tg = og / nx;
            if (og + 1u == (tg + 1u) * nx) xb_add(&bar[XB_TOPGEN], 1u);
            else XB_SPIN(xb_ld(&bar[XB_TOPGEN]) == tg, bar);
            __builtin_amdgcn_fence(__ATOMIC_ACQUIRE, "agent");
            xb_add(&bar[XB_XGEN(bx_)], 1u);
            asm volatile("s_waitcnt vmcnt(0)" ::: "memory");
        } else {
            XB_SPIN(xb_ld(&bar[XB_XGEN(bx_)]) == gen, bar);
            __builtin_amdgcn_fence(__ATOMIC_ACQUIRE, "agent");
            asm volatile("s_waitcnt vmcnt(0)" ::: "memory");
        }
    }
    __syncthreads();
}

constexpr int NWAVES = 8;
struct Ptrs {
    const float *x, *c, *ctx, *c_ctx, *w_mod, *b_mod, *g_mix, *g_ffn, *w_in, *g_mla_q, *g_mla_kv, *w_mla_uq, *w_mla_ukv, *swa_sink, *w_gate_f, *b_gate_f, *w_gate_b, *b_gate_b, *g_gla_out,
                *w_out, *w_ffn_gu, *w_ffn_down, *g_final;
    float* out; unsigned char* ws;
};

template <bool INMAP = false>
__device__ __forceinline__ void transpose_item(const float* W, int K, int N, bf16* WT, int drow0, int k0, int n0, const float* kscale, LAS float* scr, int lane) {
    const int kk = lane >> 3, n4 = (lane & 7) * 4;
    f32x4 v[8];
#pragma unroll
    for (int i = 0; i < 8; ++i) v[i] = __builtin_nontemporal_load((const f32x4*)(W + (size_t)(k0 + 8 * i + kk) * N + n0 + n4));
#pragma unroll
    for (int i = 0; i < 8; ++i) { const int k = 8 * i + kk; f32x4 x = v[i]; if (kscale) x = x * kscale[k0 + k];
        scr[k * 33 + n4] = x.x; scr[k * 33 + n4 + 1] = x.y; scr[k * 33 + n4 + 2] = x.z; scr[k * 33 + n4 + 3] = x.w; }
    LDS_WAIT(); asm volatile("" ::: "memory");
    const int c = lane & 7;
#pragma unroll
    for (int j = 0; j < 4; ++j) { const int n = (lane >> 3) + 8 * j; const LAS float* s = scr + (8 * c) * 33 + n;
        v4u o; o.x = pk2(s[0 * 33], s[1 * 33]); o.y = pk2(s[2 * 33], s[3 * 33]); o.z = pk2(s[4 * 33], s[5 * 33]); o.w = pk2(s[6 * 33], s[7 * 33]);
        const int drow = INMAP ? pg8::w_in_row(drow0 + n) : drow0 + n;
        *(GAS v4u*)(WT + (size_t)drow * K + k0 + 8 * c) = o; }
    LDS_WAIT(); asm volatile("" ::: "memory");
}
constexpr int TI_IN = 32 * 123, TI_UQ = 8 * 36, TI_UKV = 8 * 48, TI_OUT = 32 * 64, TI_GU = 32 * 352, TI_DOWN = 88 * 64, TI_LAYER = TI_IN + TI_UQ + TI_UKV + TI_OUT + TI_GU + TI_DOWN, TI_EARLY = TI_IN + TI_UQ + TI_UKV;

__device__ __forceinline__ void sincos_d(double a, double& s, double& c) {
    const double TWO_PI = 6.283185307179586476925287, INV = 0.15915494309189533576888;
    const double k = __builtin_rint(a * INV); const double r = a - k * TWO_PI, r2 = r * r;
    double ts = 1.0, tc = 1.0;
#pragma unroll
    for (int n = 12; n >= 1; --n) { ts = 1.0 - ts * r2 / (double)((2 * n) * (2 * n + 1)); tc = 1.0 - tc * r2 / (double)((2 * n - 1) * (2 * n)); }
    s = r * ts; c = tc;
}

__device__ __forceinline__ void norm_rows(const float* xl, const float* xc, int M, bf16* H, const float* g, const float* modl, int ch_shift, int ch_scale, int gw, int NGW, int lane, const float* part, float* xc_out, int row_begin) {
    for (int row = row_begin + 2 * gw; row < M; row += 2 * NGW) {
        const bool lat = row < NLAT; const int gi = lat ? (row >> 12) : BATCH;
        const float* xr = lat ? xl + (size_t)row * D_MODEL : xc + (size_t)(row - NLAT) * D_MODEL;
        const float* sh = modl + (size_t)gi * (NMOD * D_MODEL) + ch_shift * D_MODEL; const float* sc = modl + (size_t)gi * (NMOD * D_MODEL) + ch_scale * D_MODEL;
        f32x4 v[2][8]; float ss[2] = {0.f, 0.f};
#pragma unroll
        for (int r = 0; r < 2; ++r)
#pragma unroll
            for (int j = 0; j < 8; ++j) v[r][j] = *(const f32x4*)(xr + (size_t)r * D_MODEL + 4 * lane + 256 * j);
        if (!lat && part) {
#pragma unroll
            for (int r = 0; r < 2; ++r) { const float* pr = part + (size_t)(row + r - NLAT) * D_MODEL + 4 * lane; float* xo = xc_out + (size_t)(row + r - NLAT) * D_MODEL + 4 * lane;
#pragma unroll
                for (int j = 0; j < 8; ++j) { const f32x4 p0 = *(const f32x4*)(pr + 256 * j), p1 = *(const f32x4*)(pr + (size_t)NCTX * D_MODEL + 256 * j), p2 = *(const f32x4*)(pr + (size_t)2 * NCTX * D_MODEL + 256 * j), p3 = *(const f32x4*)(pr + (size_t)3 * NCTX * D_MODEL + 256 * j);
                    v[r][j] = v[r][j] + ((p0 + p1) + (p2 + p3)); *(f32x4*)(xo + 256 * j) = v[r][j]; } }
        }
#pragma unroll
        for (int r = 0; r < 2; ++r)
#pragma unroll
            for (int j = 0; j < 8; ++j) ss[r] += (v[r][j].x * v[r][j].x + v[r][j].y * v[r][j].y) + (v[r][j].z * v[r][j].z + v[r][j].w * v[r][j].w);
        const float rstd0 = 1.f / sqrtf(wave_sum(ss[0]) * (1.f / D_MODEL) + EPS), rstd1 = 1.f / sqrtf(wave_sum(ss[1]) * (1.f / D_MODEL) + EPS);
        bf16* hr = H + (size_t)row * D_MODEL;
#pragma unroll
        for (int j = 0; j < 8; ++j) { const int col = 4 * lane + 256 * j; const f32x4 gv = *(const f32x4*)(g + col), sv = *(const f32x4*)(sc + col), hv = *(const f32x4*)(sh + col);
            const f32x4 gs = gv * (sv + 1.f);
            const f32x4 y0 = (v[0][j] * rstd0) * gs + hv, y1 = (v[1][j] * rstd1) * gs + hv;
            v2u o0; o0.x = pk2(y0.x, y0.y); o0.y = pk2(y0.z, y0.w); *(v2u*)(hr + col) = o0;
            v2u o1; o1.x = pk2(y1.x, y1.y); o1.y = pk2(y1.z, y1.w); *(v2u*)(hr + D_MODEL + col) = o1; }
    }
}
#ifndef DUP_G5
#define DUP_G5 1
#endif
#ifndef ACT_TILED
#define ACT_TILED 1
#endif
#ifndef EN_CONV
#define EN_CONV 1
#endif
#ifndef FUSE_NORM
#define FUSE_NORM 1
#endif
#ifndef BURN_MFMA
#define BURN_MFMA 0
#endif
#ifndef WGM_G1
#define WGM_G1 4
#endif
#ifndef WGM_G2
#define WGM_G2 8
#endif
#ifndef WGM_G4
#define WGM_G4 4
#endif
#ifndef REV_G5
#define REV_G5 1
#endif
#ifndef WGM_RES
#define WGM_RES 4
#endif
#ifndef DUP_G5
#define DUP_G5 1
#endif
#ifndef STAG_ON
#define STAG_ON 0
#endif
#ifndef DUP_MLA
#define DUP_MLA 1
#endif
#ifndef DUP_SWA
#define DUP_SWA 1
#endif
#ifndef DUP_P0T
#define DUP_P0T 1
#endif
#ifndef DUP_N1
#define DUP_N1 1
#endif
#ifndef DUP_G1
#define DUP_G1 1
#endif
#ifndef DUP_G2
#define DUP_G2 1
#endif
#ifndef DUP_GLA
#define DUP_GLA 1
#endif
#ifndef DUP_GL2
#define DUP_GL2 1
#endif
#ifndef DUP_N2
#define DUP_N2 1
#endif
#ifndef DUP_G4
#define DUP_G4 1
#endif
#ifndef EN_P0
#define EN_P0 1
#endif
#ifndef EN_N1
#define EN_N1 1
#endif
#ifndef EN_G1
#define EN_G1 1
#endif
#ifndef EN_GL1
#define EN_GL1 1
#endif
#ifndef EN_G2
#define EN_G2 1
#endif
#ifndef EN_MIX
#define EN_MIX 1
#endif
#ifndef EN_GL2
#define EN_GL2 1
#endif
#ifndef HALVE_LAST
#define HALVE_LAST 1
#endif
#ifndef PROBE_ATT
#define PROBE_ATT 0
#endif
#ifndef PROBE_ATT_VAR
#define PROBE_ATT_VAR 0
#endif
#ifndef EN_G3
#define EN_G3 1
#endif
#ifndef EN_N2
#define EN_N2 1
#endif
#ifndef EN_G4
#define EN_G4 1
#endif
#ifndef EN_G5
#define EN_G5 1
#endif
#ifndef EN_GLA
#define EN_GLA 1
#endif
#ifndef EN_MLA
#define EN_MLA 1
#endif
#ifndef EN_SWA
#define EN_SWA 1
#endif
#define CONVERT_ITEM(lc, rr) do { const int cl_ = (lc); int r = (rr); \
            bf16* wl = (bf16*)(ws + WS_W + (size_t)cl_ * W_LAYER); \
            if (r < TI_IN) { const int kb = r / 123, nb = r % 123; transpose_item<true>(AP->w_in + (size_t)cl_ * D_MODEL * IN_W, D_MODEL, IN_W, (bf16*)((char*)wl + W_IN), 32 * nb, 64 * kb, 32 * nb, nullptr, scr, lane); break; } r -= TI_IN; \
            if (r < TI_UQ) { const int kb = r / 36, nb = r % 36; transpose_item(AP->w_mla_uq + (size_t)cl_ * 512 * UQ_W, 512, UQ_W, (bf16*)((char*)wl + W_UQKV), 32 * nb, 64 * kb, 32 * nb, AP->g_mla_q + cl_ * 512, scr, lane); break; } r -= TI_UQ; \
            if (r < TI_UKV) { const int kb = r / 48, nb = r % 48; transpose_item(AP->w_mla_ukv + (size_t)cl_ * 512 * UKV_W, 512, UKV_W, (bf16*)((char*)wl + W_UQKV), UQ_WP + 32 * nb, 64 * kb, 32 * nb, AP->g_mla_kv + cl_ * 512, scr, lane); break; } r -= TI_UKV; \
            if (r < TI_OUT) { const int kb = r / 64, nb = r % 64; transpose_item(AP->w_out + (size_t)cl_ * D_MODEL * D_MODEL, D_MODEL, D_MODEL, (bf16*)((char*)wl + W_OUT), 32 * nb, 64 * kb, 32 * nb, nullptr, scr, lane); break; } r -= TI_OUT; \
            if (r < TI_GU) { const int kb = r / 352, nb = r % 352; const int n0 = 32 * nb; const int j = n0 < FFN ? n0 : n0 - FFN; const int drow = (j >> 7) * 256 + (n0 < FFN ? 0 : 128) + (j & 127); \
                transpose_item(AP->w_ffn_gu + (size_t)cl_ * D_MODEL * 2 * FFN, D_MODEL, 2 * FFN, (bf16*)((char*)wl + W_GU), drow, 64 * kb, n0, nullptr, scr, lane); break; } r -= TI_GU; \
            { const int kb = r / 64, nb = r % 64; transpose_item(AP->w_ffn_down + (size_t)cl_ * FFN * D_MODEL, FFN, D_MODEL, (bf16*)((char*)wl + W_DOWN), 32 * nb, 64 * kb, 32 * nb, nullptr, scr, lane); } \
    } while (0)
__global__ void __launch_bounds__(NWAVES * 64, 2) fwd_kernel(Ptrs A) {
    extern __shared__ __attribute__((aligned(16))) unsigned char lds_raw[];
    LAS unsigned char* lds = (LAS unsigned char*)lds_raw;
    const int G = gridDim.x, bx = blockIdx.x, NGW = G * NWAVES;
    const int vcu = (G % 8 == 0) ? (bx % 8) * (G / 8) + bx / 8 : bx;
#define STAGGER(nunits_, T_) do { if (STAG_ON) { const int r_ = (nunits_) % G; const int lg_ = bx >> 6, lgfree_ = (r_ + 63) >> 6; \
    if (r_ != 0 && lg_ >= lgfree_) { const unsigned long long w_ = (unsigned long long)((lg_ - lgfree_ + 1) * (T_) / (4 - lgfree_ + 1)); const unsigned long long t0_ = __builtin_amdgcn_s_memrealtime(); \
        while (__builtin_amdgcn_s_memrealtime() - t0_ < w_) __builtin_amdgcn_s_sleep(8); } } } while (0)
typedef const __attribute__((address_space(4))) Ptrs* KArgP;
#define PHASE_IDS() int tid = threadIdx.x; asm volatile("" : "+v"(tid)); const int lane = tid & 63, wave = __builtin_amdgcn_readfirstlane(tid >> 6), gw = vcu * NWAVES + wave; (void)lane; (void)gw; \
    KArgP AP = (KArgP)__builtin_amdgcn_kernarg_segment_ptr(); asm volatile("" : "+s"(AP)); \
    unsigned char* const ws = AP->ws; unsigned* const ctl = (unsigned*)(ws + WS_CTL); float* const MOD = (float*)(ws + WS_MODX); float* const SSQ = (float*)(ws + WS_SSQ) + (size_t)l * 2 * NTOK; (void)SSQ; float* const TAB32 = (float*)(ws + WS_TAB); float* const TAB16 = TAB32 + 4096; \
    float* const RSTDQ = (float*)(ws + WS_RSTD); float* const RSTDKV = RSTDQ + NTOK; bf16* const Hb = (bf16*)(ws + WS_H); bf16* const MIX = (bf16*)(ws + WS_MIX); float* const XC = (float*)(ws + WS_XC); \
    bf16* const Pb = (bf16*)(ws + WS_P); bf16* const Qb = (bf16*)(ws + WS_Q); bf16* const KVb = (bf16*)(ws + WS_KV); bf16* const GOF = (bf16*)(ws + WS_GOF); bf16* const GOB = (bf16*)(ws + WS_GOB); bf16* const ACT = (bf16*)(ws + WS_ACT); float* const PART = (float*)(ws + WS_PART); (void)PART; \
    const float* const modl = MOD + (size_t)l * 9 * (NMOD * D_MODEL); const float* const xl_in = (l == 0) ? AP->x : AP->out; const float* const xc_in = (l == 0) ? AP->ctx : XC; \
    const char* const wl = (const char*)(ws + WS_W + (size_t)l * W_LAYER); \
    (void)ctl; (void)MOD; (void)TAB32; (void)TAB16; (void)RSTDQ; (void)RSTDKV; (void)Hb; (void)MIX; (void)XC; (void)Pb; (void)Qb; (void)KVb; (void)GOF; (void)GOB; (void)ACT; (void)modl; (void)xl_in; (void)xc_in; (void)wl
    volatile LAS unsigned* LCTL = (volatile LAS unsigned*)(lds + LDSCTL_OFF);
    for (int u = threadIdx.x; u < (LDS_BYTES - LDSCTL_OFF) / 4; u += NWAVES * 64) LCTL[u] = 0u;
    __syncthreads();
    XcdBarrier bar = xcd_barrier_post((unsigned*)(A.ws + WS_CTL) + CW_BAR, LCTL);
#define GRID_BAR() xcd_barrier(bar)

#if EN_P0
        { const int l = 0; PHASE_IDS(); asm volatile("; PHASE_MARK EN_P0");
    {
        LAS float* sS = (LAS float*)lds;
        LAS float* sR = (LAS float*)(lds + 73728);
        for (int u = tid; u < 9 * D_MODEL; u += 512) { const int i = u >> 11, kx = u & (D_MODEL - 1); const float cv = i < BATCH ? AP->c[i * D_MODEL + kx] : AP->c_ctx[kx]; sS[u] = cv * pg8::fast_sigmoid(cv); }
        __syncthreads();
        for (int it = bx; it < DEPTH * 192; it += G) {
            const int l = it / 192, cchunk = it % 192, kk = lane >> 4, c4 = (lane & 15) * 4;
            f32x4 acc[9];
#pragma unroll
            for (int i = 0; i < 9; ++i) acc[i] = (f32x4){0.f, 0.f, 0.f, 0.f};
            const float* wp = AP->w_mod + ((size_t)l * D_MODEL + wave * 256 + kk) * (NMOD * D_MODEL) + cchunk * 64 + c4;
#pragma unroll 1
            for (int k8 = 0; k8 < 64; k8 += 8) { f32x4 wv[8];
#pragma unroll
                for (int q = 0; q < 8; ++q) wv[q] = __builtin_nontemporal_load((const f32x4*)(wp + (size_t)(4 * (k8 + q)) * (NMOD * D_MODEL)));
#pragma unroll
                for (int q = 0; q < 8; ++q) {
#pragma unroll
                    for (int i = 0; i < 9; ++i) acc[i] += wv[q] * sS[i * D_MODEL + wave * 256 + 4 * (k8 + q) + kk];
                    __builtin_amdgcn_sched_barrier(0); } }
#pragma unroll
            for (int i = 0; i < 9; ++i)
#pragma unroll
                for (int e = 0; e < 4; ++e) { float s = acc[i][e]; s += swz_xor<16>(s); auto rr = __builtin_amdgcn_permlane32_swap(__float_as_uint(s), __float_as_uint(s), false, false); acc[i][e] = __uint_as_float(rr[0]) + __uint_as_float(rr[1]); }
            if (lane < 16) {
#pragma unroll
                for (int i = 0; i < 9; ++i) *(LAS f32x4*)(sR + (wave * 9 + i) * 64 + c4) = acc[i]; }
            __syncthreads();
            for (int u = tid; u < 9 * 64; u += 512) { float s = 0.f;
#pragma unroll
                for (int w8 = 0; w8 < 8; ++w8) s += sR[w8 * 576 + u];
                const int i = u >> 6, col = cchunk * 64 + (u & 63);
                MOD[((size_t)l * 9 + i) * (NMOD * D_MODEL) + col] = s + AP->b_mod[(size_t)l * (NMOD * D_MODEL) + col]; }
            __syncthreads();
        }
        LAS float* scr = (LAS float*)(lds + wave * 16384);
        for (int it = gw; it < TI_LAYER; it += NGW) CONVERT_ITEM(0, it);
        for (int u = bx * 512 + tid; u < DEPTH * (160 * 2048 + 128 * 512) / 8; u += G * 512) {
            const int l = u / ((160 * 2048 + 128 * 512) / 8); const int r = u % ((160 * 2048 + 128 * 512) / 8);
            char* wl = (char*)(ws + WS_W + (size_t)l * W_LAYER);
            v4u z = {0u, 0u, 0u, 0u};
            if (r < 160 * 2048 / 8) *(v4u*)(wl + W_IN + (size_t)IN_W * D_MODEL * 2 + (size_t)r * 16) = z;
            else *(v4u*)(wl + W_UQKV + (size_t)UQ_W * 512 * 2 + (size_t)(r - 160 * 2048 / 8) * 16) = z;
        }
        for (int u = bx * 512 + tid; u < 64 * 32 + 64 * 16; u += G * 512) {
            const bool big = u < 2048; const int v = big ? u : u - 2048; const int half = big ? 32 : 16; const int pos = v / half, i = v % half;
            const double rr = big ? 0.74989420933245582730 : 0.56234132519034908039;
            double f = 1.0; for (int q = 0; q < i; ++q) f *= rr;
            double s, c; sincos_d((double)pos * f, s, c);
            float* T = big ? TAB32 : TAB16; T[v] = (float)c; T[64 * half + v] = (float)s;
        }
    }
        }
#endif
    GRID_BAR();

    for (int l = 0; l < DEPTH; ++l) {
        const bool last = (l == DEPTH - 1);
        const bool fused = FUSE_NORM && (G == 256);
        const int Mres = last ? NLAT : NTOK;

#if EN_N1
        { PHASE_IDS(); asm volatile("; PHASE_MARK EN_N1");
        _Pragma("unroll") for (int rep_ = 0; rep_ < DUP_N1; ++rep_) { if (rep_) GRID_BAR();
        norm_rows(xl_in, xc_in, NTOK, Hb, AP->g_mix + l * D_MODEL, modl, 0, 1, gw, NGW, lane, l > 0 ? PART : nullptr, XC, (fused && l > 0) ? NLAT : 0);
        }
        }
#endif
        GRID_BAR();

#if EN_G1
        { PHASE_IDS(); asm volatile("; PHASE_MARK EN_G1");
        _Pragma("unroll") for (int rep_ = 0; rep_ < DUP_G1; ++rep_) {
        { pg8::Gemm g{Hb, (const bf16*)(wl + W_IN), NTOK, IN_WP, D_MODEL, D_MODEL, 1 << 30, 0, D_MODEL, 0, 0, 0}; pg8::StaticOrder S; S.init(NTOK, IN_WP, G, bx, WGM_G1); S.mode = HALVE_LAST;
          pg8::EpiInProj E{Pb, IN_WP, SSQ, NTOK, TAB32, TAB16, NLAT, SEQ - 1};
          STAGGER((NTOK / 256) * (IN_WP / 256), 4000); pg8::gemm_phase<pg8::EpiInProj, pg8::StaticOrder>(lds, g, S, E, tid);
          if (HALVE_LAST) { S.mode = 2; pg8::gemm_phase<pg8::EpiInProj, pg8::StaticOrder, PG8_ALIGN_DEFAULT, true>(lds, g, S, E, tid); } }
        }
        }
#endif
        GRID_BAR();

#if EN_G2
        { PHASE_IDS(); asm volatile("; PHASE_MARK EN_G2");
        _Pragma("unroll") for (int rep_ = 0; rep_ < DUP_G2; ++rep_) {
        { pg8::Gemm g{Pb, (const bf16*)(wl + W_UQKV), NTOK, UQ_WP + UKV_W, 512, IN_WP, UQ_WP / 256, C_CKV, 512, 0, 0, 0}; pg8::StaticOrder S; S.init(NTOK, UQ_WP + UKV_W, G, bx, WGM_G2);
          pg8::EpiQKV E{Qb, UQ_WP, KVb, UKV_W, SSQ, SSQ + NTOK, UQ_WP / 256};
          STAGGER((NTOK / 256) * ((UQ_WP + UKV_W) / 256), 1000); pg8::gemm_phase<pg8::EpiQKV, pg8::StaticOrder>(lds, g, S, E, tid); }
        }
        }
#endif
        GRID_BAR();

#if EN_MIX
#if EN_GLA
        { PHASE_IDS(); asm volatile("; PHASE_MARK EN_GLA");
        _Pragma("nounroll") for (int rep_ = 0; rep_ < DUP_GLA; ++rep_) {
        if (bx < 64) {
            gla::Unit U; U.P = Pb; U.ldp = IN_WP; U.b = bx >> 3; U.h = (bx >> 1) & 3; U.dir = bx & 1;
            U.wg = (U.dir ? AP->w_gate_b : AP->w_gate_f) + (size_t)l * 16 * 256; U.bg = (U.dir ? AP->b_gate_b : AP->b_gate_f) + (size_t)l * 256; U.og = U.dir ? GOB : GOF;
            gla::gla_unit(U, (char*)lds_raw, tid);
        }
        }
        }
#endif
#if EN_CONV
        if (l + 1 < DEPTH && bx >= 64 && bx < 128) { PHASE_IDS();
            LAS float* scr = (LAS float*)(lds + wave * 16384);
            for (int it = (bx - 64) * NWAVES + wave; it < TI_LAYER; it += 64 * NWAVES) CONVERT_ITEM(l + 1, it);
            __syncthreads();
        }
#endif
#if EN_MLA
        { PHASE_IDS(); asm volatile("; PHASE_MARK EN_MLA");
        {
            const int nitem = last ? 768 : 816; unsigned* head = ctl + CW_QUEUE + (l * 2 + 0) * 64;
            for (;;) {
                if (tid == 0) LCTL[4] = xb_add(head, 1u);
                __syncthreads(); int it = (int)LCTL[4]; __syncthreads();
                if (it >= nitem * DUP_MLA) break;
                if (DUP_MLA > 1) it %= nitem;
                att::Unit U; const bool lat = it < 768; const int bh = lat ? it >> 4 : it - 768, qb = lat ? it & 15 : 0, b = bh / 6, h = bh % 6;
                const long row0 = lat ? (long)b * SEQ + qb * 256 : (long)NLAT + b * CTX;
                U.Q = Qb + row0 * UQ_WP + h * 192;
                U.Kn = KVb + h * 256; U.V = KVb + h * 256 + 128; U.Kr = Pb + C_KR;
                U.t0a = lat ? b * SEQ : NLAT + b * CTX; U.nta = lat ? 64 : 4; U.t0b = NLAT + b * CTX; U.ntb = lat ? 4 : 0;
                U.mask = 0; U.qpos0 = qb * 256; U.kpos0 = 0; U.has_sink = 0; U.sink = 0.f; U.rope = lat ? 1 : 0; U.tab = TAB16;
                U.O = MIX + row0 * D_MODEL + MX_MLA + h * 128;
                att::attn_unit<192, 1, UQ_WP, UKV_W, IN_WP, UKV_W, D_MODEL>(U, (char*)lds_raw, 0.07216878364870322f, tid);
            }
        }
        }
#endif
#if EN_SWA
        { PHASE_IDS(); asm volatile("; PHASE_MARK EN_SWA");
        {
            const int nitem = last ? 768 : 816; unsigned* head = ctl + CW_QUEUE + (l * 2 + 1) * 64;
            for (;;) {
                if (tid == 0) LCTL[4] = xb_add(head, 1u);
                __syncthreads(); int it = (int)LCTL[4]; __syncthreads();
                if (it >= nitem * DUP_SWA) break;
                if (DUP_SWA > 1) it %= nitem;
                att::Unit U; const bool lat = it < 768; const int bh = lat ? it >> 4 : it - 768, qb = lat ? it & 15 : 0, b = bh / 6, hq = bh % 6, kvh = hq / 3;
                const long row0 = lat ? (long)b * SEQ + qb * 256 : (long)NLAT + b * CTX;
                const int ks = lat ? (qb * 256 - 128 < 0 ? 0 : qb * 256 - 128) : 0, ke = lat ? (qb * 256 + 384 > SEQ ? SEQ : qb * 256 + 384) : 0;
                U.Q = Pb + row0 * IN_WP + C_QS + hq * 128;
                U.Kn = Pb + C_KS + kvh * 128; U.V = Pb + C_VS + kvh * 128; U.Kr = nullptr;
                U.t0a = lat ? b * SEQ + ks : NLAT + b * CTX; U.nta = lat ? (ke - ks) / 64 : 4; U.t0b = NLAT + b * CTX; U.ntb = lat ? 4 : 0;
                U.mask = lat ? 1 : 0; U.qpos0 = qb * 256; U.kpos0 = ks; U.has_sink = 1; U.sink = AP->swa_sink[l * 6 + hq]; U.rope = lat ? 1 : 0; U.tab = TAB32;
                U.O = MIX + row0 * D_MODEL + MX_SWA + hq * 128;
                att::attn_unit<128, 2, IN_WP, IN_WP, IN_WP, IN_WP, D_MODEL>(U, (char*)lds_raw, 0.08838834764831845f, tid);
            }
        }
        }
#endif
#if PROBE_ATT
        { PHASE_IDS(); asm volatile("; PHASE_MARK PROBE_ATT");
        {
            const int nitem = last ? 768 : 816; unsigned* head = ctl + CW_QUEUE + 2048 + l * 64;
            for (;;) {
                if (tid == 0) LCTL[4] = xb_add(head, 1u);
                __syncthreads(); int it = (int)LCTL[4]; __syncthreads();
                if (it >= nitem) break;
                att::Unit U; const bool lat = it < 768; const int bh = lat ? it >> 4 : it - 768, qb = lat ? it & 15 : 0, b = bh / 6, h = bh % 6;
                const long row0 = lat ? (long)b * SEQ + qb * 256 : (long)NLAT + b * CTX;
                U.Q = Qb + row0 * UQ_WP + h * 192;
                U.Kn = KVb + h * 256; U.V = KVb + h * 256 + 128; U.Kr = Pb + C_KR;
                U.t0a = lat ? b * SEQ : NLAT + b * CTX; U.nta = lat ? 64 : 4; U.t0b = NLAT + b * CTX; U.ntb = lat ? 4 : 0;
                U.mask = 0; U.qpos0 = qb * 256; U.kpos0 = 0; U.has_sink = 0; U.sink = 0.f; U.rope = lat ? 1 : 0; U.tab = TAB16;
                U.O = (att::bf16*)(ws + WS_PART) + (size_t)(it & 31) * 256 * D_MODEL + h * 128;
                att::attn_unit<192, 1, UQ_WP, UKV_W, IN_WP, UKV_W, D_MODEL, PROBE_ATT_VAR>(U, (char*)lds_raw, 0.07216878364870322f, tid);
            }
        }
        }
#endif
#endif
        GRID_BAR();

#if EN_GL2
        { PHASE_IDS(); asm volatile("; PHASE_MARK EN_GL2");
        _Pragma("unroll") for (int rep_ = 0; rep_ < DUP_GL2; ++rep_) { if (rep_) GRID_BAR();
        for (int row = gw; row < Mres; row += NGW) {
            const v4u fa = *(const v4u*)(GOF + (size_t)row * 512 + lane * 8), fb = *(const v4u*)(GOB + (size_t)row * 512 + lane * 8);
            const f32x4 o0 = {bflo(fa.x) + bflo(fb.x), bfhi(fa.x) + bfhi(fb.x), bflo(fa.y) + bflo(fb.y), bfhi(fa.y) + bfhi(fb.y)};
            const f32x4 o1 = {bflo(fa.z) + bflo(fb.z), bfhi(fa.z) + bfhi(fb.z), bflo(fa.w) + bflo(fb.w), bfhi(fa.w) + bfhi(fb.w)};
            float ss = (o0.x * o0.x + o0.y * o0.y) + (o0.z * o0.z + o0.w * o0.w) + (o1.x * o1.x + o1.y * o1.y) + (o1.z * o1.z + o1.w * o1.w);
            ss = sum16(ss);
            const float rs = 1.f / sqrtf(ss * (1.f / 128.f) + EPS);
            const float* gp = AP->g_gla_out + l * 512 + lane * 8; const f32x4 g0 = *(const f32x4*)gp, g1 = *(const f32x4*)(gp + 4);
            const v4u rw = *(const v4u*)(Pb + (size_t)row * IN_WP + C_GR + lane * 8);
            float r[8] = {bflo(rw.x), bfhi(rw.x), bflo(rw.y), bfhi(rw.y), bflo(rw.z), bfhi(rw.z), bflo(rw.w), bfhi(rw.w)};
            float y[8] = {o0.x * g0.x, o0.y * g0.y, o0.z * g0.z, o0.w * g0.w, o1.x * g1.x, o1.y * g1.y, o1.z * g1.z, o1.w * g1.w};
#pragma unroll
            for (int e = 0; e < 8; ++e) y[e] = y[e] * rs * (r[e] * pg8::fast_sigmoid(r[e]));
            v4u w; w.x = pk2(y[0], y[1]); w.y = pk2(y[2], y[3]); w.z = pk2(y[4], y[5]); w.w = pk2(y[6], y[7]);
            *(v4u*)(MIX + (size_t)row * D_MODEL + MX_GLA + lane * 8) = w;
        }
        }
        }
#endif
        GRID_BAR();

#if EN_G3
        { PHASE_IDS(); asm volatile("; PHASE_MARK EN_G3");
        {
          pg8::Gemm g{MIX, (const bf16*)(wl + W_OUT), NLAT, D_MODEL, D_MODEL, D_MODEL, 1 << 30, 0, D_MODEL, 0, 0, 0}; pg8::StaticOrder S; S.init(NLAT, D_MODEL, G, bx, WGM_RES);
          if (fused) { pg8::EpiResNorm E{xl_in, AP->out, modl + 2 * D_MODEL, NMOD * D_MODEL, Hb, AP->g_ffn + l * D_MODEL, modl + 3 * D_MODEL, modl + 4 * D_MODEL,
                                        (float*)(ws + WS_XS), ctl + CW_PANEL + ((l * 2 + 0) * 128) * 64, ctl + CW_BAR + XB_TMO, lds + LDSCTL_OFF + 2048, 0};
              pg8::gemm_phase<pg8::EpiResNorm, pg8::StaticOrder>(lds, g, S, E, tid); }
          else { pg8::EpiRes E{xl_in, xc_in, AP->out, XC, modl + 2 * D_MODEL, NMOD * D_MODEL, D_MODEL};
              pg8::gemm_phase<pg8::EpiRes, pg8::StaticOrder>(lds, g, S, E, tid); }
          if (!last) { pg8::Gemm g2{MIX + (size_t)NLAT * D_MODEL, (const bf16*)(wl + W_OUT), NCTX, D_MODEL, D_MODEL / 4, D_MODEL, 1 << 30, 0, D_MODEL, D_MODEL / 4, 0, 0}; pg8::SplitKOrder S2; S2.init(NCTX / 256, D_MODEL / 256, 4, G, bx);
              pg8::EpiPart E2{PART, modl + (size_t)BATCH * (NMOD * D_MODEL) + 2 * D_MODEL, NCTX, D_MODEL};
              pg8::gemm_phase<pg8::EpiPart, pg8::SplitKOrder>(lds, g2, S2, E2, tid); } }
        }
#endif
        GRID_BAR();

#if EN_N2
        { PHASE_IDS(); asm volatile("; PHASE_MARK EN_N2");
        _Pragma("unroll") for (int rep_ = 0; rep_ < DUP_N2; ++rep_) { if (rep_) GRID_BAR();
        norm_rows(AP->out, xc_in, Mres, Hb, AP->g_ffn + l * D_MODEL, modl, 3, 4, gw, NGW, lane, last ? nullptr : PART, XC, fused ? NLAT : 0);
        }
        }
#endif
        GRID_BAR();

#if EN_G4
        { PHASE_IDS(); asm volatile("; PHASE_MARK EN_G4");
        _Pragma("unroll") for (int rep_ = 0; rep_ < (DUP_G4 == 3 ? 1 : DUP_G4); ++rep_) {
        { pg8::Gemm g{Hb, (const bf16*)(wl + W_GU), Mres, 2 * FFN, D_MODEL, D_MODEL, 1 << 30, 0, D_MODEL, 0, 0, 0}; pg8::StaticOrder S; S.init(Mres, 2 * FFN, G, bx, WGM_G4); S.mode = HALVE_LAST;
          pg8::EpiSwiglu E{ACT, FFN, ACT_TILED ? NTOK : 0};
          STAGGER((Mres / 256) * (2 * FFN / 256), 4000);
          if (DUP_G4 == 3) { pg8::EpiSum E3{(float*)(ws + WS_MIX)};
              pg8::gemm_phase<pg8::EpiSum, pg8::StaticOrder>(lds, g, S, E3, tid); }
          pg8::gemm_phase<pg8::EpiSwiglu, pg8::StaticOrder>(lds, g, S, E, tid);
          if (HALVE_LAST) { S.mode = 2; pg8::gemm_phase<pg8::EpiSwiglu, pg8::StaticOrder, PG8_ALIGN_DEFAULT, true>(lds, g, S, E, tid); } }
        }
        }
#endif
        GRID_BAR();

#if EN_G5
        { PHASE_IDS(); asm volatile("; PHASE_MARK EN_G5");
        { pg8::Gemm g{ACT, (const bf16*)(wl + W_DOWN), NLAT, D_MODEL, FFN, ACT_TILED ? 64 : FFN, 1 << 30, 0, FFN, 0, ACT_TILED ? (long)NTOK * 128 : 0, 0}; pg8::StaticOrder S; S.init(NLAT, D_MODEL, G, bx, WGM_RES, REV_G5);
          if (fused) { const float* modn = MOD + (size_t)(l + 1) * 9 * (NMOD * D_MODEL);
              pg8::EpiResNorm E{AP->out, AP->out, modl + 5 * D_MODEL, NMOD * D_MODEL, Hb, last ? AP->g_final : AP->g_mix + (l + 1) * D_MODEL, modn, modn + D_MODEL,
                                (float*)(ws + WS_XS) + 128 * 256 * 8, ctl + CW_PANEL + ((l * 2 + 1) * 128) * 64, ctl + CW_BAR + XB_TMO, lds + LDSCTL_OFF + 2048, last ? 1 : 0};
              pg8::gemm_phase<pg8::EpiResNorm, pg8::StaticOrder>(lds, g, S, E, tid); }
          else { pg8::EpiRes E{AP->out, XC, AP->out, XC, modl + 5 * D_MODEL, NMOD * D_MODEL, D_MODEL};
              pg8::gemm_phase<pg8::EpiRes, pg8::StaticOrder>(lds, g, S, E, tid); }
          if (DUP_G5 >= 3) { pg8::StaticOrder S3; S3.init(NLAT, D_MODEL, G, bx, WGM_RES, REV_G5); if (DUP_G5 == 4) S3.pm_mod = 16;
              pg8::EpiSum E3{(float*)(ws + WS_MIX)}; pg8::gemm_phase<pg8::EpiSum, pg8::StaticOrder>(lds, g, S3, E3, tid); }
          if (!last) { pg8::Gemm g2{ACT + (size_t)NLAT * (ACT_TILED ? 64 : FFN), (const bf16*)(wl + W_DOWN), NCTX, D_MODEL, FFN / 4, ACT_TILED ? 64 : FFN, 1 << 30, 0, FFN, FFN / 4, ACT_TILED ? (long)NTOK * 128 : 0, ACT_TILED ? (long)(FFN / 4 / 64) * NTOK * 128 : 0}; pg8::SplitKOrder S2; S2.init(NCTX / 256, D_MODEL / 256, 4, G, bx);
              pg8::EpiPart E2{PART, modl + (size_t)BATCH * (NMOD * D_MODEL) + 5 * D_MODEL, NCTX, D_MODEL};
              pg8::gemm_phase<pg8::EpiPart, pg8::SplitKOrder>(lds, g2, S2, E2, tid); } }
        }
#endif
        GRID_BAR();
    }

#if BURN_MFMA
    {
        typedef short bx8 __attribute__((ext_vector_type(8))); typedef float fx4 __attribute__((ext_vector_type(4)));
        int t_ = threadIdx.x; asm volatile("" : "+v"(t_));
        bx8 a_, b_; for (int e = 0; e < 8; ++e) { a_[e] = (short)(0x3c00 + ((t_ * 7 + e) & 127)); b_[e] = (short)(0x3c00 + ((t_ * 13 + e * 5) & 127)); }
        fx4 c_[8]; for (int i = 0; i < 8; ++i) c_[i] = (fx4){0.f, 0.f, 0.f, 0.f};
#pragma unroll 1
        for (int it = 0; it < BURN_MFMA * 128; ++it) {
#pragma unroll
            for (int i = 0; i < 8; ++i) c_[i] = __builtin_amdgcn_mfma_f32_16x16x32_bf16(a_, b_, c_[i], 0, 0, 0);
        }
        float s_ = 0.f; for (int i = 0; i < 8; ++i) s_ += c_[i][0] + c_[i][1] + c_[i][2] + c_[i][3];
        ((float*)(A.ws + WS_PART))[blockIdx.x * 512 + threadIdx.x] = s_;
    }
#endif
    const int l = 0; PHASE_IDS();
    if (!(FUSE_NORM && G == 256))
    for (int row = gw; row < NLAT; row += NGW) {
        float* xr = AP->out + (size_t)row * D_MODEL;
        f32x4 v[8]; float ss = 0.f;
#pragma unroll
        for (int j = 0; j < 8; ++j) { v[j] = *(const f32x4*)(xr + 4 * lane + 256 * j); ss += (v[j].x * v[j].x + v[j].y * v[j].y) + (v[j].z * v[j].z + v[j].w * v[j].w); }
        const float rstd = 1.f / sqrtf(wave_sum(ss) * (1.f / D_MODEL) + EPS);
#pragma unroll
        for (int j = 0; j < 8; ++j) { const int col = 4 * lane + 256 * j; const f32x4 gv = *(const f32x4*)(AP->g_final + col); *(f32x4*)(xr + col) = (v[j] * rstd) * gv; }
    }
}

extern "C" void kernel_launch(void* const* d_in, const int* in_sizes, int n_in, void* d_out, int out_size, void* d_ws, size_t ws_size, hipStream_t stream) {
    static int grid = 0;
    if (grid == 0) {
        if (n_in != 23 || in_sizes[0] != NLAT * D_MODEL || out_size != NLAT * D_MODEL || ws_size < WS_END) {
            fprintf(stderr, "kernel_launch: unexpected shapes: n_in %d in0 %d out %d ws %zu (need %zu)\n", n_in, n_in > 0 ? in_sizes[0] : -1, out_size, ws_size, (size_t)WS_END); grid = -1; return; }
        int dev = 0, cus = 0, per_cu = 0;
        if (hipGetDevice(&dev) != hipSuccess || hipDeviceGetAttribute(&cus, hipDeviceAttributeMultiprocessorCount, dev) != hipSuccess) { fprintf(stderr, "kernel_launch: device query failed\n"); grid = -1; return; }
        if (hipFuncSetAttribute((const void*)fwd_kernel, hipFuncAttributeMaxDynamicSharedMemorySize, LDS_BYTES) != hipSuccess) { fprintf(stderr, "kernel_launch: hipFuncSetAttribute failed\n"); grid = -1; return; }
        if (hipOccupancyMaxActiveBlocksPerMultiprocessor(&per_cu, (const void*)fwd_kernel, NWAVES * 64, LDS_BYTES) != hipSuccess || per_cu < 1) { fprintf(stderr, "kernel_launch: occupancy query reports %d workgroups per CU\n", per_cu); (void)hipGetLastError(); grid = -1; return; }
        grid = cus;
    }
    if (grid < 0) return;
    if (hipMemsetAsync((char*)d_ws, 0, ZERO_BYTES, stream) != hipSuccess) { fprintf(stderr, "kernel_launch: memset failed\n"); return; }
    Ptrs p{};
    const float** pf = (const float**)&p;
    for (int i = 0; i < 23; ++i) pf[i] = (const float*)d_in[i];
    p.out = (float*)d_out; p.ws = (unsigned char*)d_ws;
    hipLaunchKernelGGL(fwd_kernel, dim3(grid), dim3(NWAVES * 64), LDS_BYTES, stream, p);
    const hipError_t le = hipPeekAtLastError();
    if (le != hipSuccess) fprintf(stderr, "kernel_launch: launch failed: %s\n", hipGetErrorName(le));
}
```

```cpp
#include <hip/hip_runtime.h>
#include <cstdio>
#include <cstdint>
#include <cmath>

constexpr int D_MODEL = 2048, BATCH = 8, SEQ = 4096, DEPTH = 4, CTX = 256;
constexpr int NLAT = BATCH * SEQ;
constexpr int NCTX = BATCH * CTX;
constexpr int NTOK = NLAT + NCTX;
constexpr int IN_W = 3936, IN_WP = 4096;
constexpr int FFN = 5632, NMOD = 6;
constexpr int UQ_W = 1152, UQ_WP = 1280, UKV_W = 1536;
constexpr float EPS = 1e-6f;
constexpr int C_CQ = 0, C_CKV = 512, C_KR = 1024, C_QS = 1088, C_KS = 1856, C_VS = 2112, C_GQ = 2368, C_GK = 2624, C_GV = 2880, C_GLR = 3392, C_GR = 3424;
constexpr int MX_MLA = 0, MX_SWA = 768, MX_GLA = 1536;

namespace pg8 {
#define PG8_LAS __attribute__((address_space(3)))
typedef unsigned short bf16_t;
typedef short bf16x8 __attribute__((ext_vector_type(8)));
typedef float f32x4 __attribute__((ext_vector_type(4)));
typedef unsigned u32x4 __attribute__((ext_vector_type(4)));
constexpr int BM = 256, BK = 64, HALF = 128, HTB = HALF * BK * 2  , STAGE_BYTES = 8 * HTB, NXCD = 8, WGM = 8;

__host__ __device__ __forceinline__ int lds_byte(int r, int c) { const int st = (r >> 4) * 2 + (c >> 5), rr = r & 15, cc = c & 31, ob = rr * 64 + cc * 2; return st * 1024 + (ob ^ (((ob >> 9) & 1) << 5)); }
__host__ __device__ __forceinline__ void stage_rc(int b, int& R, int& C) { const int st = b / 1024, sb = b % 1024, swz = sb ^ (((sb >> 9) & 1) << 5); R = (st >> 1) * 16 + swz / 64; C = (st & 1) * 32 + (swz % 64) / 2; }
__host__ __device__ __forceinline__ int perm32(int rho) { const int n = rho >> 4, i = rho & 15; return 8 * (i >> 2) + 4 * n + (i & 3); }

struct Unit { int pm, pn, ks; int hm = 0; };
struct Gemm { const bf16_t* A; const bf16_t* Bt; int M, N, K, lda, a_split_pn, a_split_off, ldb, ksplit; long kstepA, ksplitA; };

struct StaticOrder {
    int nM, nN, nwg, G, c, wgm, rev, pm_mod = 0, mode = 0;
    __host__ __device__ void init(int M, int N, int G_, int c_, int wgm_ = WGM, int rev_ = 0) { nM = M / BM; nN = N / BM; nwg = nM * nN; G = G_; c = c_; wgm = wgm_; rev = rev_; }
    __host__ __device__ bool next(int i, Unit& u) const {
        long L = (long)i * G + c; u.hm = 0;
        if (mode) { const int full = nwg / G, R = nwg - full * G; const bool split = R > 0 && 2 * R <= G;
            if (mode == 1) { if (split && i >= full) return false; }
            else { if (!split || i > 0 || c >= 2 * R) return false; L = (long)full * G + (c >> 1); u.hm = 1 + (c & 1); } }
        if (L >= nwg) return false;
        int wgid = (int)L; { const int q = nwg / NXCD, r = nwg % NXCD, xcd = wgid % NXCD, off = wgid / NXCD; wgid = (xcd < r ? xcd * (q + 1) : r * (q + 1) + (xcd - r) * q) + off; }
        const int nig = wgm * nN, gid = wgid / nig, fm = gid * wgm, gsz = (nM - fm) < wgm ? (nM - fm) : wgm;
        u.pm = fm + ((wgid % nig) % gsz); u.pn = (wgid % nig) / gsz; u.ks = 0; if (rev) u.pm = nM - 1 - u.pm; if (pm_mod) u.pm %= pm_mod; return true;
    }
    __device__ __forceinline__ void a_ready(const Unit&) const {}
    __device__ __forceinline__ void done(const Unit&) const {}
};

struct SplitKOrder {
    int nM, nN, nS, G, c;
    __host__ __device__ void init(int nM_, int nN_, int nS_, int G_, int c_) { nM = nM_; nN = nN_; nS = nS_; G = G_; c = c_; }
    __host__ __device__ bool next(int i, Unit& u) const { const int L = i * G + c; if (L >= nM * nN * nS) return false; u.ks = L % nS; u.pm = (L / nS) % nM; u.pn = L / (nS * nM); return true; }
    __device__ __forceinline__ void a_ready(const Unit&) const {}
    __device__ __forceinline__ void done(const Unit&) const {}
};

typedef float f32x2_t __attribute__((ext_vector_type(2))); typedef __bf16 bf16x2_t __attribute__((ext_vector_type(2)));
__device__ __forceinline__ unsigned cvt_pk_bf16(float lo, float hi) { f32x2_t v = {lo, hi}; bf16x2_t b = __builtin_convertvector(v, bf16x2_t); return __builtin_bit_cast(unsigned, b); }
typedef float f32x2 __attribute__((ext_vector_type(2)));
#ifndef NT_ACT
#define NT_ACT 0
#endif
typedef unsigned u32x2 __attribute__((ext_vector_type(2)));
__device__ __forceinline__ float fast_sigmoid(float x) { return __builtin_amdgcn_rcpf(1.0f + __builtin_amdgcn_exp2f(-1.4426950408889634f * x)); }
struct EpiStoreBf16 {
    static constexpr bool PERM = true, AFTER_DRAIN = false;
    bf16_t* O; int ldc;
    __device__ __forceinline__ void operator()(const f32x4 (&acc)[2][2][4][2], const Unit& u, int wr, int wc, int fr, int fq) const {
        const int row0 = u.pm * BM + wr * 64 + fr, col0 = u.pn * BM + wc * 32 + 8 * fq;
#pragma unroll
        for (int ai = 0; ai < 2; ++ai)
#pragma unroll
            for (int m = 0; m < 4; ++m) { bf16_t* rowp = O + (size_t)(row0 + ai * HALF + m * 16) * ldc + col0;
#pragma unroll
                for (int bj = 0; bj < 2; ++bj) { const f32x4 v0 = acc[ai][bj][m][0], v1 = acc[ai][bj][m][1];
                    u32x4 w; w.x = cvt_pk_bf16(v0[0], v0[1]); w.y = cvt_pk_bf16(v0[2], v0[3]); w.z = cvt_pk_bf16(v1[0], v1[1]); w.w = cvt_pk_bf16(v1[2], v1[3]);
                    *(u32x4*)(rowp + bj * HALF) = w; } }
    }
};
struct EpiQKV {
    static constexpr bool PERM = true, AFTER_DRAIN = false;
    bf16_t* Oq; int ldq; bf16_t* Okv; int ldkv; const float* rq; const float* rkv; int split;
    __device__ __forceinline__ void operator()(const f32x4 (&acc)[2][2][4][2], const Unit& u, int wr, int wc, int fr, int fq) const {
        const bool first = u.pn < split;
        bf16_t* base = first ? Oq : Okv; const int ld = first ? ldq : ldkv; const float* rs = first ? rq : rkv;
        const int row0 = u.pm * BM + wr * 64 + fr, col0 = (first ? u.pn : u.pn - split) * BM + wc * 32 + 8 * fq;
        float sv[2][4];
#pragma unroll
        for (int ai = 0; ai < 2; ++ai)
#pragma unroll
            for (int m = 0; m < 4; ++m) sv[ai][m] = rs[row0 + ai * HALF + m * 16];
#pragma unroll
        for (int ai = 0; ai < 2; ++ai)
#pragma unroll
            for (int m = 0; m < 4; ++m) { const int row = row0 + ai * HALF + m * 16; const float s = __builtin_amdgcn_rsqf(sv[ai][m] * (1.0f / 512.0f) + 1e-6f); bf16_t* rowp = base + (size_t)row * ld + col0;
#pragma unroll
                for (int bj = 0; bj < 2; ++bj) { const f32x4 v0 = acc[ai][bj][m][0] * s, v1 = acc[ai][bj][m][1] * s;
                    u32x4 w; w.x = cvt_pk_bf16(v0[0], v0[1]); w.y = cvt_pk_bf16(v0[2], v0[3]); w.z = cvt_pk_bf16(v1[0], v1[1]); w.w = cvt_pk_bf16(v1[2], v1[3]);
                    *(u32x4*)(rowp + bj * HALF) = w; } }
    }
};
struct EpiRes {
    static constexpr bool PERM = false, AFTER_DRAIN = false;
    const float* base_l; const float* base_c; float* out_l; float* out_c; const float* gate; int gpitch; int ncols;
    __device__ __forceinline__ void operator()(const f32x4 (&acc)[2][2][4][2], const Unit& u, int wr, int wc, int fr, int fq) const {
        const bool lat = u.pm < (NLAT / BM);
        const int gi = lat ? (u.pm >> 4) : BATCH;
        const float* bs = lat ? base_l : base_c; float* os = lat ? out_l : out_c;
        const int row0 = (lat ? u.pm : u.pm - NLAT / BM) * BM + wr * 64 + fr, col0 = u.pn * BM + wc * 32 + 4 * fq;
        f32x4 gv[2][2];
#pragma unroll
        for (int bj = 0; bj < 2; ++bj)
#pragma unroll
            for (int n = 0; n < 2; ++n) gv[bj][n] = *(const f32x4*)(gate + (size_t)gi * gpitch + col0 + bj * HALF + n * 16);
#pragma unroll
        for (int ai = 0; ai < 2; ++ai)
#pragma unroll
            for (int m = 0; m < 4; ++m) { const size_t off = (size_t)(row0 + ai * HALF + m * 16) * ncols + col0;
#pragma unroll
                for (int bj = 0; bj < 2; ++bj)
#pragma unroll
                    for (int n = 0; n < 2; ++n) { const f32x4 b = *(const f32x4*)(bs + off + bj * HALF + n * 16); *(f32x4*)(os + off + bj * HALF + n * 16) = b + gv[bj][n] * acc[ai][bj][m][n]; }
                asm volatile("" ::: "memory"); }
    }
};
struct EpiSwiglu {
    static constexpr bool PERM = true, AFTER_DRAIN = false;
    bf16_t* O; int ldc; int tiled_rows;
    __device__ __forceinline__ void operator()(const f32x4 (&acc)[2][2][4][2], const Unit& u, int wr, int wc, int fr, int fq) const {
        const int row0 = u.pm * BM + (u.hm == 2 ? HALF : 0) + wr * 64 + fr, col0 = u.pn * HALF + wc * 32 + 8 * fq;
#pragma unroll
        for (int ai = 0; ai < 2; ++ai) { if (ai == 1 && u.hm) break;
#pragma unroll
            for (int m = 0; m < 4; ++m) { const int row = row0 + ai * HALF + m * 16;
                bf16_t* rowp = tiled_rows ? O + ((size_t)(col0 >> 6) * tiled_rows + row) * 64 + (col0 & 63) : O + (size_t)row * ldc + col0;
                float r[8];
#pragma unroll
                for (int n = 0; n < 2; ++n)
#pragma unroll
                    for (int i = 0; i < 4; ++i) { const float g = acc[ai][0][m][n][i], up = acc[ai][1][m][n][i]; r[n * 4 + i] = g * fast_sigmoid(g) * up; }
                u32x4 w; w.x = cvt_pk_bf16(r[0], r[1]); w.y = cvt_pk_bf16(r[2], r[3]); w.z = cvt_pk_bf16(r[4], r[5]); w.w = cvt_pk_bf16(r[6], r[7]);
#if NT_ACT
                __builtin_nontemporal_store(w, (u32x4*)rowp);
#else
                *(u32x4*)rowp = w;
#endif
                }
        }
    }
};

struct EpiSum {
    static constexpr bool PERM = false, AFTER_DRAIN = false;
    float* O;
    __device__ __forceinline__ void operator()(const f32x4 (&acc)[2][2][4][2], const Unit& u, int wr, int wc, int fr, int fq) const {
        float s = 0.f;
#pragma unroll
        for (int ai = 0; ai < 2; ++ai)
#pragma unroll
            for (int bj = 0; bj < 2; ++bj)
#pragma unroll
                for (int m = 0; m < 4; ++m)
#pragma unroll
                    for (int n = 0; n < 2; ++n) s += (acc[ai][bj][m][n][0] + acc[ai][bj][m][n][1]) + (acc[ai][bj][m][n][2] + acc[ai][bj][m][n][3]);
        O[(size_t)(u.pm * 8 + u.pn) * 512 + (wr * 4 + wc) * 64 + fq * 16 + fr] = s;
    }
};

struct EpiPart {
    static constexpr bool PERM = false, AFTER_DRAIN = false;
    float* slab; const float* gate; int nrows, ncols;
    __device__ __forceinline__ void operator()(const f32x4 (&acc)[2][2][4][2], const Unit& u, int wr, int wc, int fr, int fq) const {
        const int row0 = u.pm * BM + wr * 64 + fr, col0 = u.pn * BM + wc * 32 + 4 * fq;
        float* os = slab + (size_t)u.ks * nrows * ncols;
        f32x4 gv[2][2];
#pragma unroll
        for (int bj = 0; bj < 2; ++bj)
#pragma unroll
            for (int n = 0; n < 2; ++n) gv[bj][n] = *(const f32x4*)(gate + col0 + bj * HALF + n * 16);
#pragma unroll
        for (int ai = 0; ai < 2; ++ai)
#pragma unroll
            for (int m = 0; m < 4; ++m) { const size_t off = (size_t)(row0 + ai * HALF + m * 16) * ncols + col0;
#pragma unroll
                for (int bj = 0; bj < 2; ++bj)
#pragma unroll
                    for (int n = 0; n < 2; ++n) *(f32x4*)(os + off + bj * HALF + n * 16) = gv[bj][n] * acc[ai][bj][m][n]; }
    }
};

struct EpiResNorm {
    static constexpr bool PERM = false, AFTER_DRAIN = false;
    const float* base_l; float* out_l; const float* gate; int gpitch;
    bf16_t* H;
    const float* gvec; const float* shiftp; const float* scalep;
    float* slots; unsigned* cnt; unsigned* tmo;
    PG8_LAS unsigned char* scr;
    int fin;
    __device__ __forceinline__ void operator()(f32x4 (&acc)[2][2][4][2], const Unit& u, int wr, int wc, int fr, int fq) const {
        const int gi = u.pm >> 4, row0 = u.pm * BM + wr * 64 + fr, col0 = u.pn * BM + wc * 32 + 4 * fq, wid = wr * 4 + wc, lane = fq * 16 + fr, tid = wid * 64 + lane;
        PG8_LAS float* P = (PG8_LAS float*)scr; PG8_LAS float* S = (PG8_LAS float*)(scr + 4096); PG8_LAS unsigned* flag = (PG8_LAS unsigned*)(scr + 5120);
        { f32x4 gv[2][2];
#pragma unroll
          for (int bj = 0; bj < 2; ++bj)
#pragma unroll
              for (int n = 0; n < 2; ++n) gv[bj][n] = *(const f32x4*)(gate + (size_t)gi * gpitch + col0 + bj * HALF + n * 16);
          f32x4 bb[2][2][2];
#define ERN_LOADB(it_, buf_) do { const size_t o_ = (size_t)(row0 + ((it_) >> 2) * HALF + ((it_) & 3) * 16) * 2048 + col0; \
    _Pragma("unroll") for (int bj = 0; bj < 2; ++bj) _Pragma("unroll") for (int n = 0; n < 2; ++n) bb[buf_][bj][n] = *(const f32x4*)(base_l + o_ + bj * HALF + n * 16); } while (0)
          ERN_LOADB(0, 0);
#pragma unroll
          for (int it = 0; it < 8; ++it) { const int ai = it >> 2, m = it & 3; const size_t off = (size_t)(row0 + ai * HALF + m * 16) * 2048 + col0; float ss = 0.f;
                  if (it + 1 < 8) ERN_LOADB(it + 1, (it + 1) & 1);
#pragma unroll
                  for (int bj = 0; bj < 2; ++bj)
#pragma unroll
                      for (int n = 0; n < 2; ++n) { const f32x4 b = bb[it & 1][bj][n]; const f32x4 x = b + gv[bj][n] * acc[ai][bj][m][n]; acc[ai][bj][m][n] = x;
                          if (!fin) *(f32x4*)(out_l + off + bj * HALF + n * 16) = x; ss += (x[0] * x[0] + x[1] * x[1]) + (x[2] * x[2] + x[3] * x[3]); }
                  ss += __int_as_float(__builtin_amdgcn_ds_swizzle(__float_as_int(ss), (16 << 10) | 0x1f));
                  { auto rr = __builtin_amdgcn_permlane32_swap(__float_as_uint(ss), __float_as_uint(ss), false, false); ss = __uint_as_float(rr[0]) + __uint_as_float(rr[1]); }
                  if (fq == 0) P[(ai * HALF + wr * 64 + m * 16 + fr) * 4 + wc] = ss;
                  asm volatile("" ::: "memory"); }
#undef ERN_LOADB
        }
        asm volatile("s_waitcnt lgkmcnt(0)" ::: "memory"); __builtin_amdgcn_s_barrier(); asm volatile("" ::: "memory");
        if (tid < 256) { const f32x4 p = *(const PG8_LAS f32x4*)(P + tid * 4); const float s = (p[0] + p[1]) + (p[2] + p[3]);
            __hip_atomic_store((unsigned*)slots + ((size_t)(u.pm * 256 + tid) * 8 + u.pn), __float_as_uint(s), __ATOMIC_RELAXED, __HIP_MEMORY_SCOPE_AGENT);
            asm volatile("s_waitcnt vmcnt(0)" ::: "memory");
            if (lane == 0) __hip_atomic_fetch_add(cnt + 64 * u.pm, 1u, __ATOMIC_RELAXED, __HIP_MEMORY_SCOPE_AGENT); }
        if (wid == 0) { unsigned dead = 0u, sp = 0u;
            while ((unsigned)__builtin_amdgcn_readfirstlane(__hip_atomic_load(cnt + 64 * u.pm, __ATOMIC_RELAXED, __HIP_MEMORY_SCOPE_AGENT)) < 32u) {
                __builtin_amdgcn_s_sleep(1);
                if ((++sp & 255u) == 0u) { if (__builtin_amdgcn_readfirstlane(__hip_atomic_load(tmo, __ATOMIC_RELAXED, __HIP_MEMORY_SCOPE_AGENT)) != 0u) { dead = 1u; break; }
                    if (sp > (1u << 20)) { if (lane == 0) __hip_atomic_fetch_add(tmo, 1u, __ATOMIC_RELAXED, __HIP_MEMORY_SCOPE_AGENT); dead = 1u; break; } } }
            __builtin_amdgcn_fence(__ATOMIC_ACQUIRE, "agent");
            if (lane == 0) flag[0] = dead; }
        asm volatile("s_waitcnt vmcnt(0) lgkmcnt(0)" ::: "memory"); __builtin_amdgcn_s_barrier(); asm volatile("" ::: "memory");
        if (tid < 256) { const unsigned* sl = (const unsigned*)slots + (size_t)(u.pm * 256 + tid) * 8; float t = 0.f;
#pragma unroll
            for (int q = 0; q < 8; ++q) t += __uint_as_float(__hip_atomic_load(sl + q, __ATOMIC_RELAXED, __HIP_MEMORY_SCOPE_AGENT));
            S[tid] = __builtin_amdgcn_rsqf(t * (1.0f / 2048.0f) + 1e-6f); }
        asm volatile("s_waitcnt lgkmcnt(0)" ::: "memory"); __builtin_amdgcn_s_barrier(); asm volatile("" ::: "memory");
        const bool bad = flag[0] != 0u; const float qnan = __builtin_nanf("");
        f32x4 gs[2][2], sh[2][2];
#pragma unroll
        for (int bj = 0; bj < 2; ++bj)
#pragma unroll
            for (int n = 0; n < 2; ++n) { const int c = col0 + bj * HALF + n * 16; const f32x4 g4 = *(const f32x4*)(gvec + c);
                if (fin) { gs[bj][n] = g4; sh[bj][n] = (f32x4){0.f, 0.f, 0.f, 0.f}; }
                else { gs[bj][n] = g4 * (*(const f32x4*)(scalep + (size_t)gi * gpitch + c) + 1.0f); sh[bj][n] = *(const f32x4*)(shiftp + (size_t)gi * gpitch + c); } }
#pragma unroll
        for (int ai = 0; ai < 2; ++ai)
#pragma unroll
            for (int m = 0; m < 4; ++m) { const int r = ai * HALF + wr * 64 + m * 16 + fr; const float rs = bad ? qnan : S[r]; const size_t off = (size_t)(u.pm * BM + r) * 2048 + col0;
#pragma unroll
                for (int bj = 0; bj < 2; ++bj)
#pragma unroll
                    for (int n = 0; n < 2; ++n) { const f32x4 y = (acc[ai][bj][m][n] * rs) * gs[bj][n] + sh[bj][n];
                        if (fin) *(f32x4*)(out_l + off + bj * HALF + n * 16) = y;
                        else { u32x2 w; w.x = cvt_pk_bf16(y[0], y[1]); w.y = cvt_pk_bf16(y[2], y[3]); *(u32x2*)(H + off + bj * HALF + n * 16) = w; } } }
    }
};

__host__ __device__ __forceinline__ int w_in_row(int c) {
    if (c >= 1856 && c < 2112) { const int B = 1856 + ((c - 1856) & ~127), d = (c - 1856) & 127, blk = d >> 6, n = (d & 63) >> 5, i = d & 31; return B + 8 * (blk * 8 + (i >> 2)) + 4 * n + (i & 3); }
    if (c >= 1024 && c < 1088) { const int d = c - 1024, blk = d >> 5, n = (d & 31) >> 4, i = d & 15; return 1024 + 8 * (blk * 4 + (i >> 2)) + 4 * n + (i & 3); }
    return c;
}
struct EpiInProj {
    static constexpr bool PERM = true, AFTER_DRAIN = false;
    bf16_t* O; int ldc; float* ssq; int ssq_rows; const float* tab32; const float* tab16; int nlat, seqmask;
    __device__ __forceinline__ void operator()(const f32x4 (&acc)[2][2][4][2], const Unit& u, int wr, int wc, int fr, int fq) const {
        const int row0 = u.pm * BM + (u.hm == 2 ? HALF : 0) + wr * 64 + fr; const bool stat = u.pn < 4; const bool lat = u.pm * BM < nlat; const int nai = u.hm ? 1 : 2;
#pragma unroll
        for (int bj = 0; bj < 2; ++bj) {
            const int p0 = u.pn * BM + bj * HALF + wc * 32 + 8 * fq;
            const bool inKS = p0 >= 1856 && p0 < 2112, inKR = p0 >= 1024 && p0 < 1088;
            if (inKS || inKR) {
                const int half = inKS ? 32 : 16, base = inKS ? 1856 + ((p0 - 1856) & ~127) : 1024, t = (p0 - base) >> 3, blk = inKS ? (t >> 3) : (t >> 2), i0 = 4 * (inKS ? (t & 7) : (t & 3));
                const float* tb = inKS ? tab32 : tab16; const int c1 = base + blk * 2 * half + i0;
#pragma unroll
                for (int ai = 0; ai < 2; ++ai) if (ai < nai)
#pragma unroll
                    for (int m = 0; m < 4; ++m) { const int row = row0 + ai * HALF + m * 16; f32x4 x1 = acc[ai][bj][m][0], x2 = acc[ai][bj][m][1];
                        if (lat) { const int ns = row & seqmask, pos = blk ? (ns & 63) : (ns >> 6); const f32x4 c = *(const f32x4*)(tb + pos * half + i0), s = *(const f32x4*)(tb + 64 * half + pos * half + i0);
                            const f32x4 y1 = x1 * c - x2 * s, y2 = x2 * c + x1 * s; x1 = y1; x2 = y2; }
                        u32x2 w1, w2; w1.x = cvt_pk_bf16(x1[0], x1[1]); w1.y = cvt_pk_bf16(x1[2], x1[3]); w2.x = cvt_pk_bf16(x2[0], x2[1]); w2.y = cvt_pk_bf16(x2[2], x2[3]);
                        bf16_t* rowp = O + (size_t)row * ldc + c1; *(u32x2*)rowp = w1; *(u32x2*)(rowp + half) = w2; }
            } else {
#pragma unroll
                for (int ai = 0; ai < 2; ++ai) if (ai < nai)
#pragma unroll
                    for (int m = 0; m < 4; ++m) { const f32x4 v0 = acc[ai][bj][m][0], v1 = acc[ai][bj][m][1];
                        u32x4 w; w.x = cvt_pk_bf16(v0[0], v0[1]); w.y = cvt_pk_bf16(v0[2], v0[3]); w.z = cvt_pk_bf16(v1[0], v1[1]); w.w = cvt_pk_bf16(v1[2], v1[3]);
                        *(u32x4*)(O + (size_t)(row0 + ai * HALF + m * 16) * ldc + p0) = w; }
            }
        }
        if (stat) {
#pragma unroll
            for (int ai = 0; ai < 2; ++ai) if (ai < nai)
#pragma unroll
                for (int m = 0; m < 4; ++m) { float ss = 0.f;
#pragma unroll
                    for (int bj = 0; bj < 2; ++bj) { const f32x4 v0 = acc[ai][bj][m][0], v1 = acc[ai][bj][m][1];
                        ss += ((v0[0] * v0[0] + v0[1] * v0[1]) + (v0[2] * v0[2] + v0[3] * v0[3])) + ((v1[0] * v1[0] + v1[1] * v1[1]) + (v1[2] * v1[2] + v1[3] * v1[3])); }
                    ss += __int_as_float(__builtin_amdgcn_ds_swizzle(__float_as_int(ss), (16 << 10) | 0x1f));
                    { auto rr = __builtin_amdgcn_permlane32_swap(__float_as_uint(ss), __float_as_uint(ss), false, false); ss = __uint_as_float(rr[0]) + __uint_as_float(rr[1]); }
                    if (fq == 0) __hip_atomic_fetch_add(ssq + (size_t)(u.pn >> 1) * ssq_rows + row0 + ai * HALF + m * 16, ss, __ATOMIC_RELAXED, __HIP_MEMORY_SCOPE_AGENT); }
        }
    }
};

#ifndef PG8_ALIGN_DEFAULT
#define PG8_ALIGN_DEFAULT true
#endif
__device__ __forceinline__ f32x4 zero_quad() { f32x2 lo, hi; asm volatile("v_mov_b64 %0, 0" : "=v"(lo)); asm volatile("v_mov_b64 %0, 0" : "=v"(hi)); return (f32x4){lo[0], lo[1], hi[0], hi[1]}; }
template <class Epi, class Sched, bool ALIGN_EPI = PG8_ALIGN_DEFAULT, bool HALFM = false>
__device__ __forceinline__ void gemm_phase(PG8_LAS unsigned char* lds, const Gemm g, const Sched& S, const Epi& E, const int tid) {
    const int wid = __builtin_amdgcn_readfirstlane(tid >> 6), lane = tid & 63, wr = wid >> 2, wc = wid & 3, fr = lane & 15, fq = lane >> 4;
    const int K = g.K, nt = K / BK;
    unsigned voffA[2], voffB[2];
#pragma unroll
    for (int i = 0; i < 2; ++i) { int R, C; stage_rc(tid * 16 + i * 8192, R, C); const int Rb = Epi::PERM ? ((R & ~31) + perm32(R & 31)) : R;
        voffA[i] = (unsigned)(R * g.lda + C) * 2u; voffB[i] = (unsigned)(Rb * g.ldb + C) * 2u; }
    const size_t kstep = (size_t)(BK * 2), kstepA = g.kstepA ? (size_t)g.kstepA : kstep;
    const size_t hstepA = (size_t)HALF * g.lda * 2, hstepB = (size_t)HALF * g.ldb * 2;
    const size_t tstepA = 2 * hstepA, tstepB = 2 * hstepB; const size_t hA1 = HALFM ? (size_t)0 : hstepA;
#define PG8_AOFF(u) ((size_t)(u).pm * tstepA + ((HALFM && (u).hm == 2) ? hstepA : (size_t)0) + ((u).pn >= g.a_split_pn ? (size_t)g.a_split_off * 2 : (size_t)0) + (size_t)(u).ks * (g.ksplitA ? (size_t)g.ksplitA : (size_t)g.ksplit * 2))
#define PG8_BOFF(u) ((size_t)(u).pn * tstepB + (size_t)(u).ks * g.ksplit * 2)
    const unsigned ldsw = (unsigned)wid * 1024u;
    const int aoff = lds_byte(wr * 64 + fr, fq * 8), boff = lds_byte(wc * 32 + fr, fq * 8);
#define PG8_SA(b, h) (((b) * 2 + (h)) * HTB)
#define PG8_SB(b, h) ((4 + (b) * 2 + (h)) * HTB)
#define PG8_STAGE(bufoff, gbase, voff) do { _Pragma("unroll") for (int _i = 0; _i < 2; ++_i) \
        __builtin_amdgcn_global_load_lds((const unsigned*)((const char*)(gbase) + (voff)[_i]), (PG8_LAS unsigned*)(lds + (bufoff) + ldsw + _i * 8192), 16, 0, 0); } while (0)
#define PG8_LDA(dst, b, h) do { _Pragma("unroll") for (int m = 0; m < 4; ++m) _Pragma("unroll") for (int k = 0; k < 2; ++k) dst[m][k] = *(const PG8_LAS bf16x8*)(lds + PG8_SA(b, h) + aoff + m * 2048 + k * 1024); } while (0)
#define PG8_LDB(dst, b, h) do { _Pragma("unroll") for (int n = 0; n < 2; ++n) _Pragma("unroll") for (int k = 0; k < 2; ++k) dst[n][k] = *(const PG8_LAS bf16x8*)(lds + PG8_SB(b, h) + boff + n * 2048 + k * 1024); } while (0)
#define PG8_MMA(ai, bj, At, Bt) do { __builtin_amdgcn_s_setprio(1); _Pragma("unroll") for (int m = 0; m < 4; ++m) _Pragma("unroll") for (int n = 0; n < 2; ++n) _Pragma("unroll") for (int k = 0; k < 2; ++k) \
        acc[ai][bj][m][n] = __builtin_amdgcn_mfma_f32_16x16x32_bf16(Bt[n][k], At[m][k], acc[ai][bj][m][n], 0, 0, 0); __builtin_amdgcn_s_setprio(0); } while (0)
#define PG8_WAIT_V(n) asm volatile("s_waitcnt vmcnt(" #n ")" ::: "memory")
#define PG8_WAIT_L(n) asm volatile("s_waitcnt lgkmcnt(" #n ")" ::: "memory")
#define PG8_BAR __builtin_amdgcn_s_barrier()
#define PG8_SCHED __builtin_amdgcn_sched_barrier(0)
    Unit cur, nxt; int ui = 0;
    if (!S.next(0, cur)) return;
    f32x4 acc[2][2][4][2];
#pragma unroll
    for (int a = 0; a < 2; ++a)
#pragma unroll
        for (int b = 0; b < 2; ++b)
#pragma unroll
            for (int m = 0; m < 4; ++m)
#pragma unroll
                for (int n = 0; n < 2; ++n) acc[a][b][m][n] = zero_quad();
    bf16x8 At[4][2], B0[2][2], B1[2][2];
    const char* cA = (const char*)g.A + PG8_AOFF(cur); const char* cB = (const char*)g.Bt + PG8_BOFF(cur);
    S.a_ready(cur);
    {
        PG8_STAGE(PG8_SB(0, 0), cB, voffB); PG8_STAGE(PG8_SB(0, 1), cB + hstepB, voffB); PG8_STAGE(PG8_SA(0, 0), cA, voffA); PG8_STAGE(PG8_SA(0, 1), cA + hA1, voffA);
        if (wr == 1) PG8_BAR;
        PG8_WAIT_V(2); PG8_BAR;
        PG8_STAGE(PG8_SB(1, 0), cB + kstep, voffB); PG8_STAGE(PG8_SA(1, 0), cA + kstepA, voffA); PG8_STAGE(PG8_SB(1, 1), cB + hstepB + kstep, voffB);
        PG8_WAIT_V(6); PG8_BAR;
    }
    for (;;) {
        const bool has_next = S.next(ui + 1, nxt);
        const char* nA = has_next ? (const char*)g.A + PG8_AOFF(nxt) : cA; const char* nB = has_next ? (const char*)g.Bt + PG8_BOFF(nxt) : cB;
        for (int t = 0; t < nt; t += 2) {
            const bool last = (t == nt - 2);
            const char* a1 = cA + (size_t)(t + 1) * kstepA;
            const char* a2 = last ? nA : cA + (size_t)(t + 2) * kstepA; const char* b2 = last ? nB : cB + (size_t)(t + 2) * kstep;
            const char* a3 = a2 + kstepA; const char* b3 = b2 + kstep;
            if (last && has_next) S.a_ready(nxt);
            {
            PG8_LDB(B0, 0, 0); PG8_LDB(B1, 0, 1); PG8_SCHED; PG8_LDA(At, 0, 0); PG8_STAGE(PG8_SA(1, 1), a1 + hA1, voffA);
            PG8_WAIT_V(8); PG8_WAIT_L(0); PG8_BAR; PG8_MMA(0, 0, At, B0); PG8_MMA(0, 1, At, B1); PG8_BAR; PG8_SCHED;
            PG8_LDA(At, 0, 1); PG8_STAGE(PG8_SB(0, 0), b2, voffB); PG8_STAGE(PG8_SB(0, 1), b2 + hstepB, voffB); PG8_STAGE(PG8_SA(0, 0), a2, voffA);
            PG8_WAIT_V(8); PG8_WAIT_L(0); PG8_BAR; if constexpr (!HALFM) { PG8_MMA(1, 0, At, B0); PG8_MMA(1, 1, At, B1); } PG8_BAR; PG8_SCHED;
            PG8_LDB(B0, 1, 0); PG8_LDB(B1, 1, 1); PG8_SCHED; PG8_LDA(At, 1, 0); PG8_STAGE(PG8_SA(0, 1), a2 + hA1, voffA);
            PG8_WAIT_V(8); PG8_WAIT_L(0); PG8_BAR; PG8_MMA(0, 0, At, B0); PG8_MMA(0, 1, At, B1); PG8_BAR; PG8_SCHED;
            PG8_LDA(At, 1, 1); PG8_STAGE(PG8_SB(1, 0), b3, voffB); PG8_STAGE(PG8_SB(1, 1), b3 + hstepB, voffB); PG8_STAGE(PG8_SA(1, 0), a3, voffA);
            PG8_WAIT_V(8); PG8_WAIT_L(0); PG8_BAR; if constexpr (!HALFM) { PG8_MMA(1, 0, At, B0); PG8_MMA(1, 1, At, B1); } PG8_BAR; PG8_SCHED;
            }
        }
        if constexpr (ALIGN_EPI) { if (wr == 0) PG8_BAR; }
        if constexpr (!Epi::AFTER_DRAIN) { E(acc, cur, wr, wc, fr, fq); S.done(cur); }
        if (!has_next) break;
#pragma unroll
        for (int a = 0; a < 2; ++a)
#pragma unroll
            for (int b = 0; b < 2; ++b)
#pragma unroll
                for (int m = 0; m < 4; ++m)
#pragma unroll
                    for (int n = 0; n < 2; ++n) acc[a][b][m][n] = zero_quad();
        cur = nxt; cA = nA; cB = nB; ++ui;
        if constexpr (ALIGN_EPI) { if (wr == 1) PG8_BAR; }
    }
    PG8_WAIT_V(0);
    if constexpr (!ALIGN_EPI) { if (wr == 0) PG8_BAR; }
    PG8_BAR;
    if constexpr (Epi::AFTER_DRAIN) { E.fused(acc, cur, wr, wc, fr, fq, lds, wid, lane); S.done(cur); }
#undef PG8_AOFF
#undef PG8_BOFF
#undef PG8_SA
#undef PG8_SB
#undef PG8_STAGE
#undef PG8_LDA
#undef PG8_LDB
#undef PG8_MMA
#undef PG8_WAIT_V
#undef PG8_WAIT_L
#undef PG8_BAR
#undef PG8_SCHED
}
}
namespace att {
typedef unsigned short bf16;
using bf16x8 = __attribute__((ext_vector_type(8))) short;
using s16x4  = __attribute__((ext_vector_type(4))) short;
using f32x16 = __attribute__((ext_vector_type(16))) float;
using f32x4  = __attribute__((ext_vector_type(4))) float;
using u32x4  = __attribute__((ext_vector_type(4))) unsigned;
constexpr int NW = 8, QBLK = 32, KVBLK = 64, DV = 128;
constexpr float THR = 8.f;
#define ATT_SBAR() __builtin_amdgcn_sched_barrier(0)
__device__ __forceinline__ int crow(int r, int hi) { return (r & 3) + 8 * (r >> 2) + 4 * hi; }
typedef float f32x2_t __attribute__((ext_vector_type(2))); typedef __bf16 bf16x2_t __attribute__((ext_vector_type(2)));
__device__ __forceinline__ unsigned cvtpk(float lo, float hi) { f32x2_t v = {lo, hi}; bf16x2_t b = __builtin_convertvector(v, bf16x2_t); return __builtin_bit_cast(unsigned, b); }
__device__ __forceinline__ float bf2f(short s) { return __uint_as_float(((unsigned)(unsigned short)s) << 16); }
__device__ __forceinline__ short f2bf(float f) { unsigned u = __float_as_uint(f); u += 0x7fffu + ((u >> 16) & 1u); return (short)(u >> 16); }

template <int DQK> struct Cfg {
    static constexpr int KROW = DQK * 2 + 16;
    static constexpr int SHM_V = KVBLK * DV * 2, SHM_K = KVBLK * KROW;
    static constexpr int OFF_V = 0, OFF_K = 2 * SHM_V, OFF_WS = 2 * SHM_V + 2 * SHM_K, BYTES = OFF_WS + NW * 64 * 4;
};

__device__ __forceinline__ void partialSM(f32x16& p0, f32x16& p1, float& m_reg, float& mn, float& alpha, const float C, const float TS) {
    float pmax = p0[0];
#pragma unroll
    for (int r = 1; r < 16; ++r) pmax = fmaxf(pmax, p0[r]);
#pragma unroll
    for (int r = 0; r < 16; ++r) pmax = fmaxf(pmax, p1[r]);
    { auto rr = __builtin_amdgcn_permlane32_swap(__float_as_uint(pmax), __float_as_uint(pmax), false, false);
      pmax = fmaxf(__uint_as_float(rr[0]), __uint_as_float(rr[1])); }
    if (__builtin_expect(__all(pmax - m_reg <= TS), 1)) { mn = m_reg; alpha = 1.f; }
    else { mn = fmaxf(m_reg, pmax); alpha = __builtin_amdgcn_exp2f((m_reg - mn) * C); m_reg = mn; }
    const float mnC = -mn * C;
#pragma unroll
    for (int r = 0; r < 16; ++r) p0[r] = fmaf(p0[r], C, mnC);
#pragma unroll
    for (int r = 0; r < 16; ++r) p1[r] = fmaf(p1[r], C, mnC);
#pragma unroll
    for (int r = 0; r < 16; ++r) p0[r] = __builtin_amdgcn_exp2f(p0[r]);
}
__device__ __forceinline__ void finishSM(f32x16& p0, f32x16& p1, float alpha, float& l_reg, bf16x8& pa0, bf16x8& pa1, bf16x8& pa2, bf16x8& pa3) {
#pragma unroll
    for (int r = 0; r < 16; ++r) p1[r] = __builtin_amdgcn_exp2f(p1[r]);
    float ps = 0;
#pragma unroll
    for (int r = 0; r < 16; ++r) ps += p0[r];
#pragma unroll
    for (int r = 0; r < 16; ++r) ps += p1[r];
    { auto rr = __builtin_amdgcn_permlane32_swap(__float_as_uint(ps), __float_as_uint(ps), false, false);
      ps = __uint_as_float(rr[0]) + __uint_as_float(rr[1]); }
    l_reg = l_reg * alpha + ps;
#define ATT_PK4(P, BASE, OUT) do { unsigned a0 = cvtpk(P[BASE + 0], P[BASE + 1]), a1 = cvtpk(P[BASE + 2], P[BASE + 3]);   \
    unsigned b0 = cvtpk(P[BASE + 4], P[BASE + 5]), b1 = cvtpk(P[BASE + 6], P[BASE + 7]);                              \
    auto r0 = __builtin_amdgcn_permlane32_swap(a0, b0, false, false); auto r1 = __builtin_amdgcn_permlane32_swap(a1, b1, false, false); \
    u32x4 w = {r0[0], r1[0], r0[1], r1[1]}; OUT = *reinterpret_cast<bf16x8*>(&w); } while (0)
    ATT_PK4(p0, 0, pa0); ATT_PK4(p0, 8, pa1); ATT_PK4(p1, 0, pa2); ATT_PK4(p1, 8, pa3);
}
template <int DQK> __device__ __forceinline__ void qkt(f32x16& p0, f32x16& p1, const char* Ks, const bf16x8* qr, int r32, int hi) {
    constexpr int KROW = Cfg<DQK>::KROW;
    p0 = f32x16{}; p1 = f32x16{};
#pragma unroll
    for (int d0 = 0; d0 < DQK / 16; ++d0) { const int cb = (d0 * 16 + hi * 8) * 2;
        const bf16x8 b0 = *reinterpret_cast<const bf16x8*>(Ks + r32 * KROW + cb);
        const bf16x8 b1 = *reinterpret_cast<const bf16x8*>(Ks + (32 + r32) * KROW + cb);
        p0 = __builtin_amdgcn_mfma_f32_32x32x16_bf16(b0, qr[d0], p0, 0, 0, 0);
        p1 = __builtin_amdgcn_mfma_f32_32x32x16_bf16(b1, qr[d0], p1, 0, 0, 0); }
}
__device__ __forceinline__ int v_st(int k, int c) { const int kk = (k & ~0xC) | ((k & 4) << 1) | ((k & 8) >> 1); return ((kk >> 3) * 4 + (c >> 5)) * 512 + ((kk & 7) * 32 + (c & 31)) * 2; }
__device__ __forceinline__ int v_rd_base(int lane) { return ((lane & 3) << 3) | (((lane >> 2) & 3) << 6) | (((lane >> 4) & 1) << 5) | (((lane >> 5) & 1) << 8); }
constexpr int v_rd_off(int d0, int ks, int half) { return d0 * 512 + ks * 4096 + half * 2048; }
template <int OFF> __device__ __forceinline__ s16x4 tr_read(int vb) { s16x4 r; asm volatile("ds_read_b64_tr_b16 %0, %1 offset:%2" : "=&v"(r) : "v"(vb), "i"(OFF) : "memory"); return r; }
template <int D0> __device__ __forceinline__ void pv_one(f32x16& od, int vb, bf16x8 pa0, bf16x8 pa1, bf16x8 pa2, bf16x8 pa3) {
    const s16x4 l0 = tr_read<v_rd_off(D0, 0, 0)>(vb), h0 = tr_read<v_rd_off(D0, 0, 1)>(vb), l1 = tr_read<v_rd_off(D0, 1, 0)>(vb), h1 = tr_read<v_rd_off(D0, 1, 1)>(vb);
    const s16x4 l2 = tr_read<v_rd_off(D0, 2, 0)>(vb), h2 = tr_read<v_rd_off(D0, 2, 1)>(vb), l3 = tr_read<v_rd_off(D0, 3, 0)>(vb), h3 = tr_read<v_rd_off(D0, 3, 1)>(vb);
    asm volatile("s_waitcnt lgkmcnt(0)" ::: "memory"); ATT_SBAR();
#define ATT_PK(L, H) (bf16x8){L[0], L[1], L[2], L[3], H[0], H[1], H[2], H[3]}
    od = __builtin_amdgcn_mfma_f32_32x32x16_bf16(pa0, ATT_PK(l0, h0), od, 0, 0, 0);
    od = __builtin_amdgcn_mfma_f32_32x32x16_bf16(pa1, ATT_PK(l1, h1), od, 0, 0, 0);
    od = __builtin_amdgcn_mfma_f32_32x32x16_bf16(pa2, ATT_PK(l2, h2), od, 0, 0, 0);
    od = __builtin_amdgcn_mfma_f32_32x32x16_bf16(pa3, ATT_PK(l3, h3), od, 0, 0, 0);
}
__device__ __forceinline__ void pv_d0(f32x16* o, int vb, bf16x8 pa0, bf16x8 pa1, bf16x8 pa2, bf16x8 pa3) {
    pv_one<0>(o[0], vb, pa0, pa1, pa2, pa3); pv_one<1>(o[1], vb, pa0, pa1, pa2, pa3); pv_one<2>(o[2], vb, pa0, pa1, pa2, pa3); pv_one<3>(o[3], vb, pa0, pa1, pa2, pa3);
}
template <int OFF> __device__ __forceinline__ bf16x8 k_read(int ka) { bf16x8 r; asm volatile("ds_read_b128 %0, %1 offset:%2" : "=&v"(r) : "v"(ka), "i"(OFF) : "memory"); return r; }
template <int N> __device__ __forceinline__ void lgk_wait() { asm volatile("s_waitcnt lgkmcnt(%0)" :: "n"(N) : "memory"); }
constexpr int CS_LA = 6;
template <int DQK, int KB, int VB, bool PV, int F> __device__ __forceinline__ void cs_read(bf16x8 (&kf)[CS_LA + 1], s16x4 (&vf)[CS_LA + 1][2], const int ka, const int vb) {
    constexpr int KROW = Cfg<DQK>::KROW, KO = KB * Cfg<DQK>::SHM_K, VO = VB * Cfg<DQK>::SHM_V, NMK = DQK / 8, NM = NMK + (PV ? 16 : 0);
    if constexpr (F < NMK) kf[F % (CS_LA + 1)] = k_read<KO + (F & 1) * 32 * KROW + (F / 2) * 32>(ka);
    else if constexpr (F < NM) { constexpr int v = F - NMK;
        vf[F % (CS_LA + 1)][0] = tr_read<VO + v_rd_off(v / 4, v % 4, 0)>(vb); vf[F % (CS_LA + 1)][1] = tr_read<VO + v_rd_off(v / 4, v % 4, 1)>(vb); }
}
template <int DQK, bool PV> constexpr int cs_outstanding(int I) {
    const int NMK = DQK / 8, NM = NMK + (PV ? 16 : 0); int n = 0;
    for (int f = I + 1; f <= I + CS_LA - 1 && f < NM; ++f) n += (f < NMK) ? 1 : 2;
    return n;
}
template <int DQK, int KB, int VB, bool PV, int I> __device__ __forceinline__ void cs_step(f32x16& p0, f32x16& p1, f32x16* o, const bf16x8* qr, bf16x8 (&kf)[CS_LA + 1], s16x4 (&vf)[CS_LA + 1][2], const int ka, const int vb, const bf16x8 (&pa)[4]) {
    constexpr int NMK = DQK / 8, NM = NMK + (PV ? 16 : 0);
    if constexpr (I < NM) {
        lgk_wait<cs_outstanding<DQK, PV>(I)>(); ATT_SBAR();
        if constexpr (I < NMK) { if constexpr ((I & 1) == 0) p0 = __builtin_amdgcn_mfma_f32_32x32x16_bf16(kf[I % (CS_LA + 1)], qr[I / 2], p0, 0, 0, 0); else p1 = __builtin_amdgcn_mfma_f32_32x32x16_bf16(kf[I % (CS_LA + 1)], qr[I / 2], p1, 0, 0, 0); }
        else { constexpr int v = I - NMK; o[v / 4] = __builtin_amdgcn_mfma_f32_32x32x16_bf16(pa[v % 4], ATT_PK(vf[I % (CS_LA + 1)][0], vf[I % (CS_LA + 1)][1]), o[v / 4], 0, 0, 0); }
        ATT_SBAR();
        cs_read<DQK, KB, VB, PV, I + CS_LA>(kf, vf, ka, vb);
    }
}
template <int DQK, int KB, int VB, bool PV>
__device__ __forceinline__ void c_segment(f32x16& p0, f32x16& p1, f32x16* o, const bf16x8* qr, const int ka, const int vb, const bf16x8 pa0, const bf16x8 pa1, const bf16x8 pa2, const bf16x8 pa3) {
    bf16x8 kf[CS_LA + 1]; s16x4 vf[CS_LA + 1][2]; const bf16x8 pa[4] = {pa0, pa1, pa2, pa3};
    __builtin_amdgcn_s_setprio(1);
    cs_read<DQK, KB, VB, PV, 0>(kf, vf, ka, vb); cs_read<DQK, KB, VB, PV, 1>(kf, vf, ka, vb); cs_read<DQK, KB, VB, PV, 2>(kf, vf, ka, vb); cs_read<DQK, KB, VB, PV, 3>(kf, vf, ka, vb);
    if constexpr (CS_LA > 4) cs_read<DQK, KB, VB, PV, 4>(kf, vf, ka, vb); if constexpr (CS_LA > 5) cs_read<DQK, KB, VB, PV, 5>(kf, vf, ka, vb); if constexpr (CS_LA > 6) cs_read<DQK, KB, VB, PV, 6>(kf, vf, ka, vb); if constexpr (CS_LA > 7) cs_read<DQK, KB, VB, PV, 7>(kf, vf, ka, vb);
    p0 = f32x16{}; p1 = f32x16{};
#define CS_S(i) cs_step<DQK, KB, VB, PV, i>(p0, p1, o, qr, kf, vf, ka, vb, pa)
    CS_S(0); CS_S(1); CS_S(2); CS_S(3); CS_S(4); CS_S(5); CS_S(6); CS_S(7); CS_S(8); CS_S(9); CS_S(10); CS_S(11); CS_S(12); CS_S(13); CS_S(14); CS_S(15); CS_S(16); CS_S(17); CS_S(18); CS_S(19);
    CS_S(20); CS_S(21); CS_S(22); CS_S(23); CS_S(24); CS_S(25); CS_S(26); CS_S(27); CS_S(28); CS_S(29); CS_S(30); CS_S(31); CS_S(32); CS_S(33); CS_S(34); CS_S(35); CS_S(36); CS_S(37); CS_S(38); CS_S(39);
#undef CS_S
    __builtin_amdgcn_s_setprio(0);
}
template <int DQK, int VB>
__device__ __forceinline__ void pv_segment(f32x16* o, const int vb, const bf16x8 pa0, const bf16x8 pa1, const bf16x8 pa2, const bf16x8 pa3) {
    constexpr int VO = VB * Cfg<DQK>::SHM_V;
    s16x4 vf[CS_LA + 1][2]; const bf16x8 pa[4] = {pa0, pa1, pa2, pa3};
#define PV_RD(v) do { if constexpr ((v) < 16) { vf[(v) % (CS_LA + 1)][0] = tr_read<VO + v_rd_off((v) / 4, (v) % 4, 0)>(vb); vf[(v) % (CS_LA + 1)][1] = tr_read<VO + v_rd_off((v) / 4, (v) % 4, 1)>(vb); } } while (0)
#define PV_S(v) do { lgk_wait<2 * (((v) + CS_LA - 1 < 16 ? (v) + CS_LA - 1 : 15) - (v))>(); ATT_SBAR(); \
    o[(v) / 4] = __builtin_amdgcn_mfma_f32_32x32x16_bf16(pa[(v) % 4], ATT_PK(vf[(v) % (CS_LA + 1)][0], vf[(v) % (CS_LA + 1)][1]), o[(v) / 4], 0, 0, 0); ATT_SBAR(); PV_RD((v) + CS_LA); } while (0)
    PV_RD(0); PV_RD(1); PV_RD(2); PV_RD(3); if constexpr (CS_LA > 4) PV_RD(4); if constexpr (CS_LA > 5) PV_RD(5); if constexpr (CS_LA > 6) PV_RD(6); if constexpr (CS_LA > 7) PV_RD(7);
    PV_S(0); PV_S(1); PV_S(2); PV_S(3); PV_S(4); PV_S(5); PV_S(6); PV_S(7); PV_S(8); PV_S(9); PV_S(10); PV_S(11); PV_S(12); PV_S(13); PV_S(14); PV_S(15);
#undef PV_RD
#undef PV_S
}
__device__ __forceinline__ void rope_pair(bf16x8& a, bf16x8& b, const float* cs, const float* sn) {
    const f32x4 c0 = *(const f32x4*)cs, c1 = *(const f32x4*)(cs + 4), s0 = *(const f32x4*)sn, s1 = *(const f32x4*)(sn + 4);
#pragma unroll
    for (int e = 0; e < 8; ++e) { const float c = e < 4 ? c0[e & 3] : c1[e & 3], s = e < 4 ? s0[e & 3] : s1[e & 3]; const float x1 = bf2f(a[e]), x2 = bf2f(b[e]);
        a[e] = f2bf(x1 * c - x2 * s); b[e] = f2bf(x2 * c + x1 * s); }
}

struct Unit {
    const bf16* Q;
    const bf16* Kn;
    const bf16* Kr;
    const bf16* V;
    int t0a, nta, t0b, ntb;
    int mask;
    int qpos0, kpos0;
    int has_sink; float sink;
    int rope;
    const float* tab;
    bf16* O;
};

template <int DQK, int SDEPTH, int LDQ, int LDKN, int LDKR, int LDV, int LDO, int VAR = 0>
__device__ __forceinline__ void attn_unit(const Unit& U, char* lds, const float scale, const int tid) {
    using C_ = Cfg<DQK>;
    constexpr int KROW = C_::KROW, SHM_V = C_::SHM_V, SHM_K = C_::SHM_K, ND = DQK / 16;
    const float C = scale * 1.4426950408889634f, TS = THR / scale;
    const int wid = __builtin_amdgcn_readfirstlane(tid >> 6), lane = tid & 63, r32 = lane & 31, hi = lane >> 5;
    char* V_lds = lds + C_::OFF_V; char* K_lds = lds + C_::OFF_K;
    float* ws = (float*)(lds + C_::OFF_WS) + wid * 64; float* li_l = ws; float* al_l = ws + 32;
    float m_reg = -1e30f, l_reg = 0; f32x16 o[4] = {}; bf16x8 qr[ND];
    const int sr = tid >> 4, sc = (tid & 15) * 8, vst0 = v_st(sr, sc), vst1 = v_st(32 + sr, sc);
    const int kr_r = tid >> 3, kr_c = (tid & 7) * 8;
    const int vb0 = (int)(uintptr_t)V_lds + v_rd_base(lane), ka0 = (int)(uintptr_t)K_lds + r32 * KROW + hi * 16;
    bf16x8 vs0, vs1, ks0, ks1, kx;
    const int NT = U.nta + U.ntb;
#define ATT_TOK(j) ((j) < U.nta ? U.t0a + (j) * KVBLK : U.t0b + ((j) - U.nta) * KVBLK)
    const unsigned offV = (unsigned)(sr * LDV + sc) * 2u, offK = (unsigned)(sr * LDKN + sc) * 2u, offR = (unsigned)(kr_r * LDKR + kr_c) * 2u;
#define ATT_LOADV(j) do { const long tk = ATT_TOK(j); const char* vb_ = (const char*)(U.V + tk * LDV); \
    vs0 = *reinterpret_cast<const bf16x8*>(vb_ + offV); vs1 = *reinterpret_cast<const bf16x8*>(vb_ + (size_t)(32 * LDV * 2) + offV); } while (0)
#define ATT_LOADK(j) do { const long tk = ATT_TOK(j); const char* kb_ = (const char*)(U.Kn + tk * LDKN); \
    ks0 = *reinterpret_cast<const bf16x8*>(kb_ + offK); ks1 = *reinterpret_cast<const bf16x8*>(kb_ + (size_t)(32 * LDKN * 2) + offK); \
    if constexpr (DQK == 192) { const char* rb_ = (const char*)(U.Kr + tk * LDKR); kx = *reinterpret_cast<const bf16x8*>(rb_ + offR); } } while (0)
#define ATT_WRITEV(b) do { *(bf16x8*)(V_lds + (b) * SHM_V + vst0) = vs0; *(bf16x8*)(V_lds + (b) * SHM_V + vst1) = vs1; } while (0)
#define ATT_WRITEK(b) do { *(bf16x8*)(K_lds + (b) * SHM_K + sr * KROW + sc * 2) = ks0; *(bf16x8*)(K_lds + (b) * SHM_K + (32 + sr) * KROW + sc * 2) = ks1; \
    if constexpr (DQK == 192) *(bf16x8*)(K_lds + (b) * SHM_K + kr_r * KROW + (128 + kr_c) * 2) = kx; } while (0)
#define ATT_VWAIT() asm volatile("s_waitcnt vmcnt(0)" ::: "memory")
#define ATT_RESC(a) do { if (__any((a) < 1.f)) { if (hi == 0) al_l[r32] = (a); asm volatile("s_waitcnt lgkmcnt(0)" ::: "memory"); \
    _Pragma("unroll") for (int d = 0; d < 4; ++d) _Pragma("unroll") for (int r = 0; r < 16; ++r) o[d][r] *= al_l[crow(r, hi)]; } } while (0)
    const int qpos = U.qpos0 + wid * QBLK + r32;
#define ATT_MASK(P0, P1, j) do { if (U.mask && (j) < U.nta) { const int kb = U.kpos0 + (j) * KVBLK + 4 * hi - qpos; \
    _Pragma("unroll") for (int r = 0; r < 16; ++r) { const int dk = kb + (r & 3) + 8 * (r >> 2); \
        if (dk > 128 || dk < -128) P0[r] = -INFINITY; if (dk + 32 > 128 || dk + 32 < -128) P1[r] = -INFINITY; } } } while (0)
#define ATT_SEAM() do { ATT_SBAR(); __syncthreads(); ATT_SBAR(); } while (0)
#define ATT_L(j) do { if constexpr ((VAR & 1) != 0) { ATT_PK4(p0, 0, pa0); ATT_PK4(p0, 8, pa1); ATT_PK4(p1, 0, pa2); ATT_PK4(p1, 8, pa3); } else { \
    ATT_MASK(p0, p1, j); partialSM(p0, p1, m_reg, mn, al, C, TS); finishSM(p0, p1, al, l_reg, pa0, pa1, pa2, pa3); ATT_RESC(al); } } while (0)
    ATT_LOADK(0); ATT_LOADV(0);
    const bf16* Qw = U.Q + (long)(wid * QBLK + r32) * LDQ + hi * 8;
#pragma unroll
    for (int d0 = 0; d0 < ND; ++d0) qr[d0] = *reinterpret_cast<const bf16x8*>(Qw + d0 * 16);
    if (U.rope) {
        const int n = U.qpos0 + wid * QBLK + r32, prow = n >> 6, pcol = n & 63;
        if constexpr (DQK == 128) {
            const float* cr = U.tab + prow * 32 + hi * 8; const float* cc = U.tab + pcol * 32 + hi * 8;
            rope_pair(qr[0], qr[2], cr, cr + 2048); rope_pair(qr[1], qr[3], cr + 16, cr + 16 + 2048);
            rope_pair(qr[4], qr[6], cc, cc + 2048); rope_pair(qr[5], qr[7], cc + 16, cc + 16 + 2048);
        } else {
            const float* cr = U.tab + prow * 16 + hi * 8; const float* cc = U.tab + pcol * 16 + hi * 8;
            rope_pair(qr[8], qr[9], cr, cr + 1024); rope_pair(qr[10], qr[11], cc, cc + 1024);
        }
    }
    f32x16 p0, p1; float mn, al; bf16x8 pa0, pa1, pa2, pa3;
    ATT_VWAIT(); ATT_WRITEK(0); ATT_LOADK(1);
    ATT_SEAM();
#define ATT_LOADK_L(j) do { if constexpr ((VAR & 2) == 0) ATT_LOADK(j); } while (0)
#define ATT_LOADV_L(j) do { if constexpr ((VAR & 2) == 0) ATT_LOADV(j); } while (0)
    if (wid >= 4) __builtin_amdgcn_s_barrier();
    ATT_SBAR();
    c_segment<DQK, 0, 0, false>(p0, p1, o, qr, ka0, vb0, pa0, pa1, pa2, pa3);
    if constexpr ((VAR & 4) == 0) { ATT_VWAIT(); ATT_WRITEK(1); ATT_WRITEV(0); }
    if (2 < NT) ATT_LOADK_L(2); ATT_LOADV_L(1);
    ATT_SEAM(); ATT_L(0); ATT_SEAM();
    for (int j = 1; j + 1 < NT; j += 2) {
        c_segment<DQK, 1, 0, true>(p0, p1, o, qr, ka0, vb0, pa0, pa1, pa2, pa3);
        if constexpr ((VAR & 4) == 0) { ATT_VWAIT(); ATT_WRITEK(0); ATT_WRITEV(1); }
        ATT_LOADK_L(j + 2); ATT_LOADV_L(j + 1);
        ATT_SEAM(); ATT_L(j); ATT_SEAM();
        c_segment<DQK, 0, 1, true>(p0, p1, o, qr, ka0, vb0, pa0, pa1, pa2, pa3);
        if constexpr ((VAR & 4) == 0) { ATT_VWAIT(); ATT_WRITEK(1); ATT_WRITEV(0); }
        if (j + 3 < NT) ATT_LOADK_L(j + 3); ATT_LOADV_L(j + 2);
        ATT_SEAM(); ATT_L(j + 1); ATT_SEAM();
    }
    c_segment<DQK, 1, 0, true>(p0, p1, o, qr, ka0, vb0, pa0, pa1, pa2, pa3);
    if constexpr ((VAR & 4) == 0) { ATT_VWAIT(); ATT_WRITEV(1); }
    ATT_SEAM(); ATT_L(NT - 1); ATT_SEAM();
    pv_segment<DQK, 1>(o, vb0, pa0, pa1, pa2, pa3);
    ATT_SBAR();
    if (wid < 4) __builtin_amdgcn_s_barrier();
    ATT_SBAR();
    if (U.has_sink) l_reg += __builtin_amdgcn_exp2f(U.sink * 1.4426950408889634f - m_reg * C);
    if (hi == 0) li_l[r32] = l_reg; asm volatile("s_waitcnt lgkmcnt(0)" ::: "memory");
    float rli[16];
#pragma unroll
    for (int r = 0; r < 16; ++r) rli[r] = __builtin_amdgcn_rcpf(li_l[crow(r, hi)]);
    bf16* Ow = U.O + (long)(wid * QBLK) * LDO;
#pragma unroll
    for (int r = 0; r < 16; ++r) { const int orow = crow(r, hi);
#pragma unroll
        for (int d0 = 0; d0 < 4; ++d0) Ow[(long)orow * LDO + d0 * 32 + r32] = (bf16)f2bf(o[d0][r] * rli[r]); }
    __syncthreads();
#undef ATT_TOK
#undef ATT_LOADV
#undef ATT_LOADK
#undef ATT_WRITEV
#undef ATT_WRITEK
#undef ATT_VWAIT
#undef ATT_RESC
#undef ATT_MASK
#undef ATT_SEAM
#undef ATT_L
#undef ATT_LOADK_L
#undef ATT_LOADV_L
}
}

namespace gla {
using att::bf16; using att::bf16x8; using att::s16x4; using att::f32x16; using att::f32x4; using att::u32x4; using att::crow; using att::cvtpk; using att::bf2f; using att::f2bf;
constexpr int ROWB = 144;
constexpr int T_QI = 0, T_KI = 64 * ROWB, T_KIT = 2 * 64 * ROWB, T_V = 3 * 64 * ROWB  , T_BYTES = T_V + 16384  ;
constexpr int OFF_ST = 2 * T_BYTES  , OFF_DEC = OFF_ST + 128 * ROWB  , BYTES = OFF_DEC + 2 * 256;
static_assert(T_V % 16 == 0 && T_BYTES % 16 == 0 && OFF_ST % 16 == 0 && BYTES <= 131072, "gla LDS map");
struct Unit {
    const bf16* P; int ldp;
    const float* wg; const float* bg;
    bf16* og;
    int b, h, dir;
};
__device__ __forceinline__ float log_sigmoid(float z) { return fminf(z, 0.f) - __logf(1.f + __expf(-fabsf(z))); }
template <int CTRL, int ROWMASK> __device__ __forceinline__ float dpp_add(float v) { return v + __int_as_float(__builtin_amdgcn_update_dpp(0, __float_as_int(v), CTRL, ROWMASK, 0xf, false)); }
__device__ __forceinline__ float wave_prefix(float v) {
    v = dpp_add<0x111, 0xf>(v); v = dpp_add<0x112, 0xf>(v); v = dpp_add<0x114, 0xf>(v); v = dpp_add<0x118, 0xf>(v);
    v = dpp_add<0x142, 0xa>(v);
    v = dpp_add<0x143, 0xc>(v);
    return v;
}

__device__ __forceinline__ void gla_unit(const Unit& U, char* lds, const int tid) {
    const int wid = __builtin_amdgcn_readfirstlane(tid >> 6), lane = tid & 63, r32 = lane & 31, hi = lane >> 5;
    const int h = U.h, dir = U.dir;
    for (int i = tid; i < 128 * ROWB / 4; i += 512) ((unsigned*)(lds + OFF_ST))[i] = 0u;
#define GLA_TB(s) ((s) < 4 ? NLAT + U.b * CTX + 64 * (dir ? 3 - (s) : (s)) : U.b * SEQ + 64 * (dir ? 67 - (s) : (s) - 4))
#define GLA_TOK(tb, i) ((long)((tb) + (dir ? 63 - (i) : (i))))
    if (wid < 4) {
        typedef short s16x4v __attribute__((ext_vector_type(4)));
        const int w = wid, pt = tid, t16 = lane & 15, dq = lane >> 4;
        s16x4v wa; f32x4 bias4;
#pragma unroll
        for (int e = 0; e < 4; ++e) { wa[e] = f2bf(U.wg[(4 * dq + e) * 256 + h * 64 + 16 * w + t16]); bias4[e] = U.bg[h * 64 + 16 * w + 4 * dq + e]; }
        s16x4v qr_[4], kr_[4], gr_[4]; bf16x8 vv[4];
#define GLA_LOAD(s) do { const int tb_ = GLA_TB(s); \
    _Pragma("unroll") for (int b4 = 0; b4 < 4; ++b4) { const bf16* row = U.P + GLA_TOK(tb_, 16 * b4 + t16) * U.ldp; \
        qr_[b4] = *reinterpret_cast<const s16x4v*>(row + C_GQ + h * 64 + 16 * w + 4 * dq); kr_[b4] = *reinterpret_cast<const s16x4v*>(row + C_GK + h * 64 + 16 * w + 4 * dq); \
        gr_[b4] = *reinterpret_cast<const s16x4v*>(row + C_GLR + dir * 16 + 4 * dq); } \
    _Pragma("unroll") for (int c_ = 0; c_ < 4; ++c_) { const int ch = pt + 256 * c_; vv[c_] = *reinterpret_cast<const bf16x8*>(U.P + GLA_TOK(tb_, ch >> 4) * U.ldp + C_GV + h * 128 + (ch & 15) * 8); } } while (0)
#define GLA_PREP(buf) do { char* T = lds + (buf) * T_BYTES; \
    f32x4 carry = {0.f, 0.f, 0.f, 0.f}; \
    _Pragma("unroll") for (int b4 = 0; b4 < 4; ++b4) { const int irow = 16 * b4 + t16; \
        f32x4 z = __builtin_amdgcn_mfma_f32_16x16x16bf16_1k(wa, gr_[b4], bias4, 0, 0, 0);            \
        s16x4v qo, ko; \
        _Pragma("unroll") for (int r = 0; r < 4; ++r) { float v = log_sigmoid(z[r]) * (1.f / 16.f); \
            v = dpp_add<0x111, 0xf>(v); v = dpp_add<0x112, 0xf>(v); v = dpp_add<0x114, 0xf>(v); v = dpp_add<0x118, 0xf>(v);     \
            v += carry[r]; carry[r] = __int_as_float(__builtin_amdgcn_ds_swizzle(__float_as_int(v), 0x1F0));                    \
            const short ks = f2bf(bf2f(kr_[b4][r]) * __expf(-v)); \
            qo[r] = f2bf(bf2f(qr_[b4][r]) * 0.125f * __expf(v)); ko[r] = ks; \
            *(short*)(T + T_KIT + (16 * w + 4 * dq + r) * ROWB + irow * 2) = ks; } \
        *(s16x4v*)(T + T_QI + irow * ROWB + (16 * w + 4 * dq) * 2) = qo; *(s16x4v*)(T + T_KI + irow * ROWB + (16 * w + 4 * dq) * 2) = ko; } \
    if (t16 == 0) { f32x4 dv; _Pragma("unroll") for (int r = 0; r < 4; ++r) dv[r] = __expf(carry[r]); *(f32x4*)(lds + OFF_DEC + (buf) * 256 + (16 * w + 4 * dq) * 4) = dv; } \
    _Pragma("unroll") for (int c_ = 0; c_ < 4; ++c_) { const int ch = pt + 256 * c_; *(bf16x8*)(T + T_V + att::v_st(ch >> 4, (ch & 15) * 8)) = vv[c_]; } } while (0)
        GLA_LOAD(0); GLA_PREP(0); GLA_LOAD(1);
        __syncthreads();
        for (int s = 0; s < 68; ++s) {
            if (s + 1 < 68) { GLA_PREP((s + 1) & 1); if (s + 2 < 68) GLA_LOAD(s + 2); }
            __syncthreads();
            __syncthreads();
        }
#undef GLA_LOAD
#undef GLA_PREP
    } else {
        const int m = wid - 4, rh = m & 1, ebp = m >> 1;
        f32x16 S0 = {}, S1 = {};
        __syncthreads();
        for (int s = 0; s < 68; ++s) {
            const int tb = GLA_TB(s); const char* T = lds + (s & 1) * T_BYTES; const float* DEC = (const float*)(lds + OFF_DEC + (s & 1) * 256);
            const int vb = (int)(uintptr_t)(T + T_V) + att::v_rd_base(lane) + (2 * ebp) * 512;
            bf16x8 qf[4];
#pragma unroll
            for (int d0 = 0; d0 < 4; ++d0) qf[d0] = *reinterpret_cast<const bf16x8*>(T + T_QI + (rh * 32 + r32) * ROWB + (d0 * 16 + hi * 8) * 2);
            f32x16 p0 = {}, p1 = {};
#pragma unroll
            for (int d0 = 0; d0 < 4; ++d0) { const int cb = (d0 * 16 + hi * 8) * 2;
                const bf16x8 ka = *reinterpret_cast<const bf16x8*>(T + T_KI + r32 * ROWB + cb), kb = *reinterpret_cast<const bf16x8*>(T + T_KI + (32 + r32) * ROWB + cb);
                p0 = __builtin_amdgcn_mfma_f32_32x32x16_bf16(ka, qf[d0], p0, 0, 0, 0); p1 = __builtin_amdgcn_mfma_f32_32x32x16_bf16(kb, qf[d0], p1, 0, 0, 0); }
            { const int irow = rh * 32 + r32 - dir;
#pragma unroll
              for (int r = 0; r < 16; ++r) { const int mm = crow(r, hi); if (mm > irow) p0[r] = 0.f; if (mm + 32 > irow) p1[r] = 0.f; } }
            bf16x8 pa0, pa1, pa2, pa3;
            ATT_PK4(p0, 0, pa0); ATT_PK4(p0, 8, pa1); ATT_PK4(p1, 0, pa2); ATT_PK4(p1, 8, pa3);
            bf16x8 kf[4];
#pragma unroll
            for (int ks = 0; ks < 4; ++ks) kf[ks] = *reinterpret_cast<const bf16x8*>(T + T_KIT + (rh * 32 + r32) * ROWB + (ks * 16 + hi * 8) * 2);
            float dec[16];
#pragma unroll
            for (int r = 0; r < 16; ++r) dec[r] = DEC[rh * 32 + crow(r, hi)];
#pragma unroll
            for (int eb2 = 0; eb2 < 2; ++eb2) { const int eb = 2 * ebp + eb2;
                f32x16 o = {};
                att::pv_one<0>(o, vb + eb2 * 512, pa0, pa1, pa2, pa3);
#pragma unroll
                for (int d0 = 0; d0 < 4; ++d0) { const bf16x8 sf = *reinterpret_cast<const bf16x8*>(lds + OFF_ST + (eb * 32 + r32) * ROWB + (d0 * 16 + hi * 8) * 2);
                    o = __builtin_amdgcn_mfma_f32_32x32x16_bf16(qf[d0], sf, o, 0, 0, 0); }
#pragma unroll
                for (int r = 0; r < 16; ++r) U.og[GLA_TOK(tb, rh * 32 + crow(r, hi)) * 512 + h * 128 + eb * 32 + r32] = (bf16)f2bf(o[r]);
                if (eb2 == 0) { att::pv_one<0>(S0, vb, kf[0], kf[1], kf[2], kf[3]);
#pragma unroll
                    for (int r = 0; r < 16; ++r) S0[r] *= dec[r]; }
                else { att::pv_one<0>(S1, vb + 512, kf[0], kf[1], kf[2], kf[3]);
#pragma unroll
                    for (int r = 0; r < 16; ++r) S1[r] *= dec[r]; }
            }
            __syncthreads();
#pragma unroll
            for (int g = 0; g < 4; ++g) { uint2 wv; wv.x = cvtpk(S0[4 * g], S0[4 * g + 1]); wv.y = cvtpk(S0[4 * g + 2], S0[4 * g + 3]);
                *(uint2*)(lds + OFF_ST + ((2 * ebp) * 32 + r32) * ROWB + (rh * 32 + 8 * g + 4 * hi) * 2) = wv;
                uint2 wu; wu.x = cvtpk(S1[4 * g], S1[4 * g + 1]); wu.y = cvtpk(S1[4 * g + 2], S1[4 * g + 3]);
                *(uint2*)(lds + OFF_ST + ((2 * ebp + 1) * 32 + r32) * ROWB + (rh * 32 + 8 * g + 4 * hi) * 2) = wu; }
            __syncthreads();
        }
    }
    __syncthreads();
#undef GLA_TB
#undef GLA_TOK
}
}

constexpr size_t MiB = 1u << 20;
constexpr size_t WS_CTL = 0, CTL_BYTES = 1 * MiB;
constexpr size_t WS_SSQ = 1 * MiB;
constexpr size_t MOD_BYTES = (size_t)DEPTH * 9 * NMOD * D_MODEL * 4;
constexpr size_t ZERO_BYTES = 3 * MiB;
static_assert(WS_SSQ + (size_t)DEPTH * 2 * NTOK * 4 <= ZERO_BYTES, "zeroed region");
constexpr size_t WS_TAB = 3 * MiB;
constexpr size_t WS_RSTD = WS_TAB + 64 * 1024;
constexpr size_t WS_W = 4 * MiB;
constexpr size_t W_IN = 0, W_UQKV = W_IN + (size_t)IN_WP * D_MODEL * 2, W_OUT = W_UQKV + (size_t)(UQ_WP + UKV_W) * 512 * 2, W_GU = W_OUT + (size_t)D_MODEL * D_MODEL * 2,
                 W_DOWN = W_GU + (size_t)2 * FFN * D_MODEL * 2, W_LAYER = W_DOWN + (size_t)D_MODEL * FFN * 2;
constexpr size_t WS_H = WS_W + DEPTH * W_LAYER;
constexpr size_t WS_MIX = WS_H + (size_t)NTOK * D_MODEL * 2;
constexpr size_t WS_XC = WS_MIX + (size_t)NTOK * D_MODEL * 2;
constexpr size_t WS_R1 = WS_XC + (size_t)NCTX * D_MODEL * 4;
constexpr size_t WS_P = WS_R1, WS_Q = WS_P + (size_t)NTOK * IN_WP * 2, WS_KV = WS_Q + (size_t)NTOK * UQ_WP * 2, WS_GOF = WS_KV + (size_t)NTOK * UKV_W * 2,
                 WS_GOB = WS_GOF + (size_t)NTOK * 512 * 4, WS_R1_END = WS_GOB + (size_t)NTOK * 512 * 4;
constexpr size_t WS_ACT = WS_R1;
static_assert(WS_ACT + (size_t)NTOK * FFN * 2 <= WS_R1_END, "ACT overlay fits");
constexpr size_t WS_PART = WS_R1_END;
constexpr size_t WS_XS = WS_PART + (size_t)4 * NCTX * D_MODEL * 4;
constexpr size_t WS_MODX = WS_XS + 2 * MiB;
constexpr size_t WS_END = WS_MODX + 2 * MiB;
static_assert(W_LAYER % 256 == 0 && WS_H % 256 == 0 && WS_R1 % 256 == 0 && WS_Q % 256 == 0 && WS_KV % 256 == 0 && WS_GOF % 256 == 0, "alignment");
constexpr int CW_BAR = 4096;
constexpr int CW_PANEL = 32768;
constexpr int CW_QUEUE = 16384;
constexpr int RING_BYTES = 131072, LDSCTL_OFF = RING_BYTES, LDS_BYTES = 147456;

#define GAS __attribute__((address_space(1)))
#define LAS __attribute__((address_space(3)))
typedef unsigned short bf16;
typedef unsigned v4u __attribute__((ext_vector_type(4)));
typedef unsigned v2u __attribute__((ext_vector_type(2)));
typedef float f32x4 __attribute__((ext_vector_type(4)));
#define LDS_WAIT() asm volatile("s_waitcnt lgkmcnt(0)" ::: "memory")
__device__ __forceinline__ unsigned f2bf(float f) { unsigned u = __builtin_bit_cast(unsigned, f); return (u + 0x7fffu + ((u >> 16) & 1u)) >> 16; }
__device__ __forceinline__ unsigned pk2(float lo, float hi) { return f2bf(lo) | (f2bf(hi) << 16); }
__device__ __forceinline__ float bflo(unsigned w) { return __uint_as_float(w << 16); }
__device__ __forceinline__ float bfhi(unsigned w) { return __uint_as_float(w & 0xffff0000u); }
template <int O> __device__ __forceinline__ float swz_xor(float v) { return __int_as_float(__builtin_amdgcn_ds_swizzle(__float_as_int(v), (O << 10) | 0x1f)); }
__device__ __forceinline__ float sum16(float v) { v += swz_xor<1>(v); v += swz_xor<2>(v); v += swz_xor<4>(v); v += swz_xor<8>(v); return v; }
__device__ __forceinline__ float sum32(float v) { v = sum16(v); v += swz_xor<16>(v); return v; }
__device__ __forceinline__ float wave_sum(float v) { v = sum32(v); auto rr = __builtin_amdgcn_permlane32_swap(__float_as_uint(v), __float_as_uint(v), false, false); return __uint_as_float(rr[0]) + __uint_as_float(rr[1]); }

#define XB_TMO      128
#define XB_XCNT(j)  (256  + 64 * (j))
#define XB_XSUB(j)  (1280 + 64 * (j))
#define XB_XGEN(j)  (2304 + 64 * (j))
#define XB_TOP      3328
#define XB_TOPGEN   3392
#define XCD_BAR_WORDS 3456
#define XB_SPIN_CAP (1u << 21)
__device__ __forceinline__ unsigned xb_ld(unsigned* p)              { return __hip_atomic_load(p, __ATOMIC_RELAXED, __HIP_MEMORY_SCOPE_AGENT); }
__device__ __forceinline__ unsigned xb_add(unsigned* p, unsigned v) { return __hip_atomic_fetch_add(p, v, __ATOMIC_RELAXED, __HIP_MEMORY_SCOPE_AGENT); }
__device__ __forceinline__ unsigned xb_xcc_id() { return (unsigned)__builtin_amdgcn_s_getreg((3 << 11) | 20) & 0xFu; }
#define XB_SPIN(cond, bar) do { unsigned _sp = 0; while (cond) { __builtin_amdgcn_s_sleep(1); \
    if ((++_sp & 255u) == 0u) { if (xb_ld(&(bar)[XB_TMO])) break; if (_sp > XB_SPIN_CAP) { atomicAdd(&(bar)[XB_TMO], 1u); break; } } } } while (0)
struct XcdBarrier { unsigned* bar; unsigned x; volatile LAS unsigned* st; };
__device__ __forceinline__ XcdBarrier xcd_barrier_post(unsigned* bar, volatile LAS unsigned* st) {
    XcdBarrier b; b.bar = bar; b.x = xb_xcc_id(); b.st = st;
    if (threadIdx.x == 0) (void)xb_add(&bar[XB_XCNT(b.x)], 1u);
    return b;
}
__device__ __forceinline__ void xcd_barrier_complete(unsigned* bar, unsigned x, unsigned& nloc, unsigned& nx) {
    const unsigned G = gridDim.x * gridDim.y * gridDim.z;
    unsigned sum, cnt, mine, sp = 0u;
    for (;;) {
        sum = 0u; cnt = 0u; mine = 0u;
#pragma unroll
        for (unsigned j = 0; j < 16; ++j) { const unsigned c = xb_ld(&bar[XB_XCNT(j)]); sum += c; cnt += (c > 0u) ? 1u : 0u; mine = (j == x) ? c : mine; }
        if (sum == G) break;
        __builtin_amdgcn_s_sleep(1);
        if ((++sp & 255u) == 0u) { if (xb_ld(&bar[XB_TMO])) break; if (sp > XB_SPIN_CAP) { atomicAdd(&bar[XB_TMO], 1u); break; } }
    }
    nloc = mine > 0u ? mine : 1u; nx = cnt > 0u ? cnt : 1u;
}
__device__ __forceinline__ void xcd_barrier(const XcdBarrier& b) {
    asm volatile("s_waitcnt vmcnt(0)" ::: "memory");
    __syncthreads();
    if (threadIdx.x == 0) {
        unsigned* bar = b.bar;
        const unsigned bx_ = (unsigned)__builtin_amdgcn_readfirstlane((int)xb_xcc_id());
        __builtin_amdgcn_s_waitcnt(0);
        unsigned nloc = b.st[0], nx = b.st[1];
        if (nloc == 0u) { xcd_barrier_complete(bar, bx_, nloc, nx); b.st[0] = nloc; b.st[1] = nx; }
        const unsigned old = xb_add(&bar[XB_XSUB(bx_)], 1u);
        const unsigned gen = old / nloc;
        if (old + 1u == (gen + 1u) * nloc) {
            __builtin_amdgcn_fence(__ATOMIC_RELEASE, "agent");
            asm volatile("s_waitcnt vmcnt(0)" ::: "memory");
            const unsigned og = xb_add(&bar[XB_TOP], 1u);
            const unsigned tg = og / nx;
            if (og + 1u == (tg + 1u) * nx) xb_add(&bar[XB_TOPGEN], 1u);
            else XB_SPIN(xb_ld(&bar[XB_TOPGEN]) == tg, bar);
            __builtin_amdgcn_fence(__ATOMIC_ACQUIRE, "agent");
            xb_add(&bar[XB_XGEN(bx_)], 1u);
            asm volatile("s_waitcnt vmcnt(0)" ::: "memory");
        } else {
            XB_SPIN(xb_ld(&bar[XB_XGEN(bx_)]) == gen, bar);
            __builtin_amdgcn_fence(__ATOMIC_ACQUIRE, "agent");
            asm volatile("s_waitcnt vmcnt(0)" ::: "memory");
        }
    }
    __syncthreads();
}

constexpr int NWAVES = 8;
struct Ptrs {
    const float *x, *c, *ctx, *c_ctx, *w_mod, *b_mod, *g_mix, *g_ffn, *w_in, *g_mla_q, *g_mla_kv, *w_mla_uq, *w_mla_ukv, *swa_sink, *w_gate_f, *b_gate_f, *w_gate_b, *b_gate_b, *g_gla_out,
                *w_out, *w_ffn_gu, *w_ffn_down, *g_final;
    float* out; unsigned char* ws;
};

template <bool INMAP = false>
__device__ __forceinline__ void transpose_item(const float* W, int K, int N, bf16* WT, int drow0, int k0, int n0, const float* kscale, LAS float* scr, int lane) {
    const int kk = lane >> 3, n4 = (lane & 7) * 4;
    f32x4 v[8];
#pragma unroll
    for (int i = 0; i < 8; ++i) v[i] = __builtin_nontemporal_load((const f32x4*)(W + (size_t)(k0 + 8 * i + kk) * N + n0 + n4));
#pragma unroll
    for (int i = 0; i < 8; ++i) { const int k = 8 * i + kk; f32x4 x = v[i]; if (kscale) x = x * kscale[k0 + k];
        scr[k * 33 + n4] = x.x; scr[k * 33 + n4 + 1] = x.y; scr[k * 33 + n4 + 2] = x.z; scr[k * 33 + n4 + 3] = x.w; }
    LDS_WAIT(); asm volatile("" ::: "memory");
    const int c = lane & 7;
#pragma unroll
    for (int j = 0; j < 4; ++j) { const int n = (lane >> 3) + 8 * j; const LAS float* s = scr + (8 * c) * 33 + n;
        v4u o; o.x = pk2(s[0 * 33], s[1 * 33]); o.y = pk2(s[2 * 33], s[3 * 33]); o.z = pk2(s[4 * 33], s[5 * 33]); o.w = pk2(s[6 * 33], s[7 * 33]);
        const int drow = INMAP ? pg8::w_in_row(drow0 + n) : drow0 + n;
        *(GAS v4u*)(WT + (size_t)drow * K + k0 + 8 * c) = o; }
    LDS_WAIT(); asm volatile("" ::: "memory");
}
constexpr int TI_IN = 32 * 123, TI_UQ = 8 * 36, TI_UKV = 8 * 48, TI_OUT = 32 * 64, TI_GU = 32 * 352, TI_DOWN = 88 * 64, TI_LAYER = TI_IN + TI_UQ + TI_UKV + TI_OUT + TI_GU + TI_DOWN, TI_EARLY = TI_IN + TI_UQ + TI_UKV;

__device__ __forceinline__ void sincos_d(double a, double& s, double& c) {
    const double TWO_PI = 6.283185307179586476925287, INV = 0.15915494309189533576888;
    const double k = __builtin_rint(a * INV); const double r = a - k * TWO_PI, r2 = r * r;
    double ts = 1.0, tc = 1.0;
#pragma unroll
    for (int n = 12; n >= 1; --n) { ts = 1.0 - ts * r2 / (double)((2 * n) * (2 * n + 1)); tc = 1.0 - tc * r2 / (double)((2 * n - 1) * (2 * n)); }
    s = r * ts; c = tc;
}

__device__ __forceinline__ void norm_rows(const float* xl, const float* xc, int M, bf16* H, const float* g, const float* modl, int ch_shift, int ch_scale, int gw, int NGW, int lane, const float* part, float* xc_out, int row_begin) {
    for (int row = row_begin + 2 * gw; row < M; row += 2 * NGW) {
        const bool lat = row < NLAT; const int gi = lat ? (row >> 12) : BATCH;
        const float* xr = lat ? xl + (size_t)row * D_MODEL : xc + (size_t)(row - NLAT) * D_MODEL;
        const float* sh = modl + (size_t)gi * (NMOD * D_MODEL) + ch_shift * D_MODEL; const float* sc = modl + (size_t)gi * (NMOD * D_MODEL) + ch_scale * D_MODEL;
        f32x4 v[2][8]; float ss[2] = {0.f, 0.f};
#pragma unroll
        for (int r = 0; r < 2; ++r)
#pragma unroll
            for (int j = 0; j < 8; ++j) v[r][j] = *(const f32x4*)(xr + (size_t)r * D_MODEL + 4 * lane + 256 * j);
        if (!lat && part) {
#pragma unroll
            for (int r = 0; r < 2; ++r) { const float* pr = part + (size_t)(row + r - NLAT) * D_MODEL + 4 * lane; float* xo = xc_out + (size_t)(row + r - NLAT) * D_MODEL + 4 * lane;
#pragma unroll
                for (int j = 0; j < 8; ++j) { const f32x4 p0 = *(const f32x4*)(pr + 256 * j), p1 = *(const f32x4*)(pr + (size_t)NCTX * D_MODEL + 256 * j), p2 = *(const f32x4*)(pr + (size_t)2 * NCTX * D_MODEL + 256 * j), p3 = *(const f32x4*)(pr + (size_t)3 * NCTX * D_MODEL + 256 * j);
                    v[r][j] = v[r][j] + ((p0 + p1) + (p2 + p3)); *(f32x4*)(xo + 256 * j) = v[r][j]; } }
        }
#pragma unroll
        for (int r = 0; r < 2; ++r)
#pragma unroll
            for (int j = 0; j < 8; ++j) ss[r] += (v[r][j].x * v[r][j].x + v[r][j].y * v[r][j].y) + (v[r][j].z * v[r][j].z + v[r][j].w * v[r][j].w);
        const float rstd0 = 1.f / sqrtf(wave_sum(ss[0]) * (1.f / D_MODEL) + EPS), rstd1 = 1.f / sqrtf(wave_sum(ss[1]) * (1.f / D_MODEL) + EPS);
        bf16* hr = H + (size_t)row * D_MODEL;
#pragma unroll
        for (int j = 0; j < 8; ++j) { const int col = 4 * lane + 256 * j; const f32x4 gv = *(const f32x4*)(g + col), sv = *(const f32x4*)(sc + col), hv = *(const f32x4*)(sh + col);
            const f32x4 gs = gv * (sv + 1.f);
            const f32x4 y0 = (v[0][j] * rstd0) * gs + hv, y1 = (v[1][j] * rstd1) * gs + hv;
            v2u o0; o0.x = pk2(y0.x, y0.y); o0.y = pk2(y0.z, y0.w); *(v2u*)(hr + col) = o0;
            v2u o1; o1.x = pk2(y1.x, y1.y); o1.y = pk2(y1.z, y1.w); *(v2u*)(hr + D_MODEL + col) = o1; }
    }
}
#ifndef DUP_G5
#define DUP_G5 1
#endif
#ifndef ACT_TILED
#define ACT_TILED 1
#endif
#ifndef EN_CONV
#define EN_CONV 1
#endif
#ifndef FUSE_NORM
#define FUSE_NORM 1
#endif
#ifndef BURN_MFMA
#define BURN_MFMA 0
#endif
#ifndef WGM_G1
#define WGM_G1 4
#endif
#ifndef WGM_G2
#define WGM_G2 8
#endif
#ifndef WGM_G4
#define WGM_G4 4
#endif
#ifndef REV_G5
#define REV_G5 1
#endif
#ifndef WGM_RES
#define WGM_RES 4
#endif
#ifndef DUP_G5
#define DUP_G5 1
#endif
#ifndef STAG_ON
#define STAG_ON 0
#endif
#ifndef DUP_MLA
#define DUP_MLA 1
#endif
#ifndef DUP_SWA
#define DUP_SWA 1
#endif
#ifndef DUP_P0T
#define DUP_P0T 1
#endif
#ifndef DUP_N1
#define DUP_N1 1
#endif
#ifndef DUP_G1
#define DUP_G1 1
#endif
#ifndef DUP_G2
#define DUP_G2 1
#endif
#ifndef DUP_GLA
#define DUP_GLA 1
#endif
#ifndef DUP_GL2
#define DUP_GL2 1
#endif
#ifndef DUP_N2
#define DUP_N2 1
#endif
#ifndef DUP_G4
#define DUP_G4 1
#endif
#ifndef EN_P0
#define EN_P0 1
#endif
#ifndef EN_N1
#define EN_N1 1
#endif
#ifndef EN_G1
#define EN_G1 1
#endif
#ifndef EN_GL1
#define EN_GL1 1
#endif
#ifndef EN_G2
#define EN_G2 1
#endif
#ifndef EN_MIX
#define EN_MIX 1
#endif
#ifndef EN_GL2
#define EN_GL2 1
#endif
#ifndef HALVE_LAST
#define HALVE_LAST 1
#endif
#ifndef PROBE_ATT
#define PROBE_ATT 0
#endif
#ifndef PROBE_ATT_VAR
#define PROBE_ATT_VAR 0
#endif
#ifndef EN_G3
#define EN_G3 1
#endif
#ifndef EN_N2
#define EN_N2 1
#endif
#ifndef EN_G4
#define EN_G4 1
#endif
#ifndef EN_G5
#define EN_G5 1
#endif
#ifndef EN_GLA
#define EN_GLA 1
#endif
#ifndef EN_MLA
#define EN_MLA 1
#endif
#ifndef EN_SWA
#define EN_SWA 1
#endif
#define CONVERT_ITEM(lc, rr) do { const int cl_ = (lc); int r = (rr); \
            bf16* wl = (bf16*)(ws + WS_W + (size_t)cl_ * W_LAYER); \
            if (r < TI_IN) { const int kb = r / 123, nb = r % 123; transpose_item<true>(AP->w_in + (size_t)cl_ * D_MODEL * IN_W, D_MODEL, IN_W, (bf16*)((char*)wl + W_IN), 32 * nb, 64 * kb, 32 * nb, nullptr, scr, lane); break; } r -= TI_IN; \
            if (r < TI_UQ) { const int kb = r / 36, nb = r % 36; transpose_item(AP->w_mla_uq + (size_t)cl_ * 512 * UQ_W, 512, UQ_W, (bf16*)((char*)wl + W_UQKV), 32 * nb, 64 * kb, 32 * nb, AP->g_mla_q + cl_ * 512, scr, lane); break; } r -= TI_UQ; \
            if (r < TI_UKV) { const int kb = r / 48, nb = r % 48; transpose_item(AP->w_mla_ukv + (size_t)cl_ * 512 * UKV_W, 512, UKV_W, (bf16*)((char*)wl + W_UQKV), UQ_WP + 32 * nb, 64 * kb, 32 * nb, AP->g_mla_kv + cl_ * 512, scr, lane); break; } r -= TI_UKV; \
            if (r < TI_OUT) { const int kb = r / 64, nb = r % 64; transpose_item(AP->w_out + (size_t)cl_ * D_MODEL * D_MODEL, D_MODEL, D_MODEL, (bf16*)((char*)wl + W_OUT), 32 * nb, 64 * kb, 32 * nb, nullptr, scr, lane); break; } r -= TI_OUT; \
            if (r < TI_GU) { const int kb = r / 352, nb = r % 352; const int n0 = 32 * nb; const int j = n0 < FFN ? n0 : n0 - FFN; const int drow = (j >> 7) * 256 + (n0 < FFN ? 0 : 128) + (j & 127); \
                transpose_item(AP->w_ffn_gu + (size_t)cl_ * D_MODEL * 2 * FFN, D_MODEL, 2 * FFN, (bf16*)((char*)wl + W_GU), drow, 64 * kb, n0, nullptr, scr, lane); break; } r -= TI_GU; \
            { const int kb = r / 64, nb = r % 64; transpose_item(AP->w_ffn_down + (size_t)cl_ * FFN * D_MODEL, FFN, D_MODEL, (bf16*)((char*)wl + W_DOWN), 32 * nb, 64 * kb, 32 * nb, nullptr, scr, lane); } \
    } while (0)
__global__ void __launch_bounds__(NWAVES * 64, 2) fwd_kernel(Ptrs A) {
    extern __shared__ __attribute__((aligned(16))) unsigned char lds_raw[];
    LAS unsigned char* lds = (LAS unsigned char*)lds_raw;
    const int G = gridDim.x, bx = blockIdx.x, NGW = G * NWAVES;
    const int vcu = (G % 8 == 0) ? (bx % 8) * (G / 8) + bx / 8 : bx;
#define STAGGER(nunits_, T_) do { if (STAG_ON) { const int r_ = (nunits_) % G; const int lg_ = bx >> 6, lgfree_ = (r_ + 63) >> 6; \
    if (r_ != 0 && lg_ >= lgfree_) { const unsigned long long w_ = (unsigned long long)((lg_ - lgfree_ + 1) * (T_) / (4 - lgfree_ + 1)); const unsigned long long t0_ = __builtin_amdgcn_s_memrealtime(); \
        while (__builtin_amdgcn_s_memrealtime() - t0_ < w_) __builtin_amdgcn_s_sleep(8); } } } while (0)
typedef const __attribute__((address_space(4))) Ptrs* KArgP;
#define PHASE_IDS() int tid = threadIdx.x; asm volatile("" : "+v"(tid)); const int lane = tid & 63, wave = __builtin_amdgcn_readfirstlane(tid >> 6), gw = vcu * NWAVES + wave; (void)lane; (void)gw; \
    KArgP AP = (KArgP)__builtin_amdgcn_kernarg_segment_ptr(); asm volatile("" : "+s"(AP)); \
    unsigned char* const ws = AP->ws; unsigned* const ctl = (unsigned*)(ws + WS_CTL); float* const MOD = (float*)(ws + WS_MODX); float* const SSQ = (float*)(ws + WS_SSQ) + (size_t)l * 2 * NTOK; (void)SSQ; float* const TAB32 = (float*)(ws + WS_TAB); float* const TAB16 = TAB32 + 4096; \
    float* const RSTDQ = (float*)(ws + WS_RSTD); float* const RSTDKV = RSTDQ + NTOK; bf16* const Hb = (bf16*)(ws + WS_H); bf16* const MIX = (bf16*)(ws + WS_MIX); float* const XC = (float*)(ws + WS_XC); \
    bf16* const Pb = (bf16*)(ws + WS_P); bf16* const Qb = (bf16*)(ws + WS_Q); bf16* const KVb = (bf16*)(ws + WS_KV); bf16* const GOF = (bf16*)(ws + WS_GOF); bf16* const GOB = (bf16*)(ws + WS_GOB); bf16* const ACT = (bf16*)(ws + WS_ACT); float* const PART = (float*)(ws + WS_PART); (void)PART; \
    const float* const modl = MOD + (size_t)l * 9 * (NMOD * D_MODEL); const float* const xl_in = (l == 0) ? AP->x : AP->out; const float* const xc_in = (l == 0) ? AP->ctx : XC; \
    const char* const wl = (const char*)(ws + WS_W + (size_t)l * W_LAYER); \
    (void)ctl; (void)MOD; (void)TAB32; (void)TAB16; (void)RSTDQ; (void)RSTDKV; (void)Hb; (void)MIX; (void)XC; (void)Pb; (void)Qb; (void)KVb; (void)GOF; (void)GOB; (void)ACT; (void)modl; (void)xl_in; (void)xc_in; (void)wl
    volatile LAS unsigned* LCTL = (volatile LAS unsigned*)(lds + LDSCTL_OFF);
    for (int u = threadIdx.x; u < (LDS_BYTES - LDSCTL_OFF) / 4; u += NWAVES * 64) LCTL[u] = 0u;
    __syncthreads();
    XcdBarrier bar = xcd_barrier_post((unsigned*)(A.ws + WS_CTL) + CW_BAR, LCTL);
#define GRID_BAR() xcd_barrier(bar)

#if EN_P0
        { const int l = 0; PHASE_IDS(); asm volatile("; PHASE_MARK EN_P0");
    {
        LAS float* sS = (LAS float*)lds;
        LAS float* sR = (LAS float*)(lds + 73728);
        for (int u = tid; u < 9 * D_MODEL; u += 512) { const int i = u >> 11, kx = u & (D_MODEL - 1); const float cv = i < BATCH ? AP->c[i * D_MODEL + kx] : AP->c_ctx[kx]; sS[u] = cv * pg8::fast_sigmoid(cv); }
        __syncthreads();
        for (int it = bx; it < DEPTH * 192; it += G) {
            const int l = it / 192, cchunk = it % 192, kk = lane >> 4, c4 = (lane & 15) * 4;
            f32x4 acc[9];
#pragma unroll
            for (int i = 0; i < 9; ++i) acc[i] = (f32x4){0.f, 0.f, 0.f, 0.f};
            const float* wp = AP->w_mod + ((size_t)l * D_MODEL + wave * 256 + kk) * (NMOD * D_MODEL) + cchunk * 64 + c4;
#pragma unroll 1
            for (int k8 = 0; k8 < 64; k8 += 8) { f32x4 wv[8];
#pragma unroll
                for (int q = 0; q < 8; ++q) wv[q] = __builtin_nontemporal_load((const f32x4*)(wp + (size_t)(4 * (k8 + q)) * (NMOD * D_MODEL)));
#pragma unroll
                for (int q = 0; q < 8; ++q) {
#pragma unroll
                    for (int i = 0; i < 9; ++i) acc[i] += wv[q] * sS[i * D_MODEL + wave * 256 + 4 * (k8 + q) + kk];
                    __builtin_amdgcn_sched_barrier(0); } }
#pragma unroll
            for (int i = 0; i < 9; ++i)
#pragma unroll
                for (int e = 0; e < 4; ++e) { float s = acc[i][e]; s += swz_xor<16>(s); auto rr = __builtin_amdgcn_permlane32_swap(__float_as_uint(s), __float_as_uint(s), false, false); acc[i][e] = __uint_as_float(rr[0]) + __uint_as_float(rr[1]); }
            if (lane < 16) {
#pragma unroll
                for (int i = 0; i < 9; ++i) *(LAS f32x4*)(sR + (wave * 9 + i) * 64 + c4) = acc[i]; }
            __syncthreads();
            for (int u = tid; u < 9 * 64; u += 512) { float s = 0.f;
#pragma unroll
                for (int w8 = 0; w8 < 8; ++w8) s += sR[w8 * 576 + u];
                const int i = u >> 6, col = cchunk * 64 + (u & 63);
                MOD[((size_t)l * 9 + i) * (NMOD * D_MODEL) + col] = s + AP->b_mod[(size_t)l * (NMOD * D_MODEL) + col]; }
            __syncthreads();
        }
        LAS float* scr = (LAS float*)(lds + wave * 16384);
        for (int it = gw; it < TI_LAYER; it += NGW) CONVERT_ITEM(0, it);
        for (int u = bx * 512 + tid; u < DEPTH * (160 * 2048 + 128 * 512) / 8; u += G * 512) {
            const int l = u / ((160 * 2048 + 128 * 512) / 8); const int r = u % ((160 * 2048 + 128 * 512) / 8);
            char* wl = (char*)(ws + WS_W + (size_t)l * W_LAYER);
            v4u z = {0u, 0u, 0u, 0u};
            if (r < 160 * 2048 / 8) *(v4u*)(wl + W_IN + (size_t)IN_W * D_MODEL * 2 + (size_t)r * 16) = z;
            else *(v4u*)(wl + W_UQKV + (size_t)UQ_W * 512 * 2 + (size_t)(r - 160 * 2048 / 8) * 16) = z;
        }
        for (int u = bx * 512 + tid; u < 64 * 32 + 64 * 16; u += G * 512) {
            const bool big = u < 2048; const int v = big ? u : u - 2048; const int half = big ? 32 : 16; const int pos = v / half, i = v % half;
            const double rr = big ? 0.74989420933245582730 : 0.56234132519034908039;
            double f = 1.0; for (int q = 0; q < i; ++q) f *= rr;
            double s, c; sincos_d((double)pos * f, s, c);
            float* T = big ? TAB32 : TAB16; T[v] = (float)c; T[64 * half + v] = (float)s;
        }
    }
        }
#endif
    GRID_BAR();

    for (int l = 0; l < DEPTH; ++l) {
        const bool last = (l == DEPTH - 1);
        const bool fused = FUSE_NORM && (G == 256);
        const int Mres = last ? NLAT : NTOK;

#if EN_N1
        { PHASE_IDS(); asm volatile("; PHASE_MARK EN_N1");
        _Pragma("unroll") for (int rep_ = 0; rep_ < DUP_N1; ++rep_) { if (rep_) GRID_BAR();
        norm_rows(xl_in, xc_in, NTOK, Hb, AP->g_mix + l * D_MODEL, modl, 0, 1, gw, NGW, lane, l > 0 ? PART : nullptr, XC, (fused && l > 0) ? NLAT : 0);
        }
        }
#endif
        GRID_BAR();

#if EN_G1
        { PHASE_IDS(); asm volatile("; PHASE_MARK EN_G1");
        _Pragma("unroll") for (int rep_ = 0; rep_ < DUP_G1; ++rep_) {
        { pg8::Gemm g{Hb, (const bf16*)(wl + W_IN), NTOK, IN_WP, D_MODEL, D_MODEL, 1 << 30, 0, D_MODEL, 0, 0, 0}; pg8::StaticOrder S; S.init(NTOK, IN_WP, G, bx, WGM_G1); S.mode = HALVE_LAST;
          pg8::EpiInProj E{Pb, IN_WP, SSQ, NTOK, TAB32, TAB16, NLAT, SEQ - 1};
          STAGGER((NTOK / 256) * (IN_WP / 256), 4000); pg8::gemm_phase<pg8::EpiInProj, pg8::StaticOrder>(lds, g, S, E, tid);
          if (HALVE_LAST) { S.mode = 2; pg8::gemm_phase<pg8::EpiInProj, pg8::StaticOrder, PG8_ALIGN_DEFAULT, true>(lds, g, S, E, tid); } }
        }
        }
#endif
        GRID_BAR();

#if EN_G2
        { PHASE_IDS(); asm volatile("; PHASE_MARK EN_G2");
        _Pragma("unroll") for (int rep_ = 0; rep_ < DUP_G2; ++rep_) {
        { pg8::Gemm g{Pb, (const bf16*)(wl + W_UQKV), NTOK, UQ_WP + UKV_W, 512, IN_WP, UQ_WP / 256, C_CKV, 512, 0, 0, 0}; pg8::StaticOrder S; S.init(NTOK, UQ_WP + UKV_W, G, bx, WGM_G2);
          pg8::EpiQKV E{Qb, UQ_WP, KVb, UKV_W, SSQ, SSQ + NTOK, UQ_WP / 256};
          STAGGER((NTOK / 256) * ((UQ_WP + UKV_W) / 256), 1000); pg8::gemm_phase<pg8::EpiQKV, pg8::StaticOrder>(lds, g, S, E, tid); }
        }
        }
#endif
        GRID_BAR();

#if EN_MIX
#if EN_GLA
        { PHASE_IDS(); asm volatile("; PHASE_MARK EN_GLA");
        _Pragma("nounroll") for (int rep_ = 0; rep_ < DUP_GLA; ++rep_) {
        if (bx < 64) {
            gla::Unit U; U.P = Pb; U.ldp = IN_WP; U.b = bx >> 3; U.h = (bx >> 1) & 3; U.dir = bx & 1;
            U.wg = (U.dir ? AP->w_gate_b : AP->w_gate_f) + (size_t)l * 16 * 256; U.bg = (U.dir ? AP->b_gate_b : AP->b_gate_f) + (size_t)l * 256; U.og = U.dir ? GOB : GOF;
            gla::gla_unit(U, (char*)lds_raw, tid);
        }
        }
        }
#endif
#if EN_CONV
        if (l + 1 < DEPTH && bx >= 64 && bx < 128) { PHASE_IDS();
            LAS float* scr = (LAS float*)(lds + wave * 16384);
            for (int it = (bx - 64) * NWAVES + wave; it < TI_LAYER; it += 64 * NWAVES) CONVERT_ITEM(l + 1, it);
            __syncthreads();
        }
#endif
#if EN_MLA
        { PHASE_IDS(); asm volatile("; PHASE_MARK EN_MLA");
        {
            const int nitem = last ? 768 : 816; unsigned* head = ctl + CW_QUEUE + (l * 2 + 0) * 64;
            for (;;) {
                if (tid == 0) LCTL[4] = xb_add(head, 1u);
                __syncthreads(); int it = (int)LCTL[4]; __syncthreads();
                if (it >= nitem * DUP_MLA) break;
                if (DUP_MLA > 1) it %= nitem;
                att::Unit U; const bool lat = it < 768; const int bh = lat ? it >> 4 : it - 768, qb = lat ? it & 15 : 0, b = bh / 6, h = bh % 6;
                const long row0 = lat ? (long)b * SEQ + qb * 256 : (long)NLAT + b * CTX;
                U.Q = Qb + row0 * UQ_WP + h * 192;
                U.Kn = KVb + h * 256; U.V = KVb + h * 256 + 128; U.Kr = Pb + C_KR;
                U.t0a = lat ? b * SEQ : NLAT + b * CTX; U.nta = lat ? 64 : 4; U.t0b = NLAT + b * CTX; U.ntb = lat ? 4 : 0;
                U.mask = 0; U.qpos0 = qb * 256; U.kpos0 = 0; U.has_sink = 0; U.sink = 0.f; U.rope = lat ? 1 : 0; U.tab = TAB16;
                U.O = MIX + row0 * D_MODEL + MX_MLA + h * 128;
                att::attn_unit<192, 1, UQ_WP, UKV_W, IN_WP, UKV_W, D_MODEL>(U, (char*)lds_raw, 0.07216878364870322f, tid);
            }
        }
        }
#endif
#if EN_SWA
        { PHASE_IDS(); asm volatile("; PHASE_MARK EN_SWA");
        {
            const int nitem = last ? 768 : 816; unsigned* head = ctl + CW_QUEUE + (l * 2 + 1) * 64;
            for (;;) {
                if (tid == 0) LCTL[4] = xb_add(head, 1u);
                __syncthreads(); int it = (int)LCTL[4]; __syncthreads();
                if (it >= nitem * DUP_SWA) break;
                if (DUP_SWA > 1) it %= nitem;
                att::Unit U; const bool lat = it < 768; const int bh = lat ? it >> 4 : it - 768, qb = lat ? it & 15 : 0, b = bh / 6, hq = bh % 6, kvh = hq / 3;
                const long row0 = lat ? (long)b * SEQ + qb * 256 : (long)NLAT + b * CTX;
                const int ks = lat ? (qb * 256 - 128 < 0 ? 0 : qb * 256 - 128) : 0, ke = lat ? (qb * 256 + 384 > SEQ ? SEQ : qb * 256 + 384) : 0;
                U.Q = Pb + row0 * IN_WP + C_QS + hq * 128;
                U.Kn = Pb + C_KS + kvh * 128; U.V = Pb + C_VS + kvh * 128; U.Kr = nullptr;
                U.t0a = lat ? b * SEQ + ks : NLAT + b * CTX; U.nta = lat ? (ke - ks) / 64 : 4; U.t0b = NLAT + b * CTX; U.ntb = lat ? 4 : 0;
                U.mask = lat ? 1 : 0; U.qpos0 = qb * 256; U.kpos0 = ks; U.has_sink = 1; U.sink = AP->swa_sink[l * 6 + hq]; U.rope = lat ? 1 : 0; U.tab = TAB32;
                U.O = MIX + row0 * D_MODEL + MX_SWA + hq * 128;
                att::attn_unit<128, 2, IN_WP, IN_WP, IN_WP, IN_WP, D_MODEL>(U, (char*)lds_raw, 0.08838834764831845f, tid);
            }
        }
        }
#endif
#if PROBE_ATT
        { PHASE_IDS(); asm volatile("; PHASE_MARK PROBE_ATT");
        {
            const int nitem = last ? 768 : 816; unsigned* head = ctl + CW_QUEUE + 2048 + l * 64;
            for (;;) {
                if (tid == 0) LCTL[4] = xb_add(head, 1u);
                __syncthreads(); int it = (int)LCTL[4]; __syncthreads();
                if (it >= nitem) break;
                att::Unit U; const bool lat = it < 768; const int bh = lat ? it >> 4 : it - 768, qb = lat ? it & 15 : 0, b = bh / 6, h = bh % 6;
                const long row0 = lat ? (long)b * SEQ + qb * 256 : (long)NLAT + b * CTX;
                U.Q = Qb + row0 * UQ_WP + h * 192;
                U.Kn = KVb + h * 256; U.V = KVb + h * 256 + 128; U.Kr = Pb + C_KR;
                U.t0a = lat ? b * SEQ : NLAT + b * CTX; U.nta = lat ? 64 : 4; U.t0b = NLAT + b * CTX; U.ntb = lat ? 4 : 0;
                U.mask = 0; U.qpos0 = qb * 256; U.kpos0 = 0; U.has_sink = 0; U.sink = 0.f; U.rope = lat ? 1 : 0; U.tab = TAB16;
                U.O = (att::bf16*)(ws + WS_PART) + (size_t)(it & 31) * 256 * D_MODEL + h * 128;
                att::attn_unit<192, 1, UQ_WP, UKV_W, IN_WP, UKV_W, D_MODEL, PROBE_ATT_VAR>(U, (char*)lds_raw, 0.07216878364870322f, tid);
            }
        }
        }
#endif
#endif
        GRID_BAR();

#if EN_GL2
        { PHASE_IDS(); asm volatile("; PHASE_MARK EN_GL2");
        _Pragma("unroll") for (int rep_ = 0; rep_ < DUP_GL2; ++rep_) { if (rep_) GRID_BAR();
        for (int row = gw; row < Mres; row += NGW) {
            const v4u fa = *(const v4u*)(GOF + (size_t)row * 512 + lane * 8), fb = *(const v4u*)(GOB + (size_t)row * 512 + lane * 8);
            const f32x4 o0 = {bflo(fa.x) + bflo(fb.x), bfhi(fa.x) + bfhi(fb.x), bflo(fa.y) + bflo(fb.y), bfhi(fa.y) + bfhi(fb.y)};
            const f32x4 o1 = {bflo(fa.z) + bflo(fb.z), bfhi(fa.z) + bfhi(fb.z), bflo(fa.w) + bflo(fb.w), bfhi(fa.w) + bfhi(fb.w)};
            float ss = (o0.x * o0.x + o0.y * o0.y) + (o0.z * o0.z + o0.w * o0.w) + (o1.x * o1.x + o1.y * o1.y) + (o1.z * o1.z + o1.w * o1.w);
            ss = sum16(ss);
            const float rs = 1.f / sqrtf(ss * (1.f / 128.f) + EPS);
            const float* gp = AP->g_gla_out + l * 512 + lane * 8; const f32x4 g0 = *(const f32x4*)gp, g1 = *(const f32x4*)(gp + 4);
            const v4u rw = *(const v4u*)(Pb + (size_t)row * IN_WP + C_GR + lane * 8);
            float r[8] = {bflo(rw.x), bfhi(rw.x), bflo(rw.y), bfhi(rw.y), bflo(rw.z), bfhi(rw.z), bflo(rw.w), bfhi(rw.w)};
            float y[8] = {o0.x * g0.x, o0.y * g0.y, o0.z * g0.z, o0.w * g0.w, o1.x * g1.x, o1.y * g1.y, o1.z * g1.z, o1.w * g1.w};
#pragma unroll
            for (int e = 0; e < 8; ++e) y[e] = y[e] * rs * (r[e] * pg8::fast_sigmoid(r[e]));
            v4u w; w.x = pk2(y[0], y[1]); w.y = pk2(y[2], y[3]); w.z = pk2(y[4], y[5]); w.w = pk2(y[6], y[7]);
            *(v4u*)(MIX + (size_t)row * D_MODEL + MX_GLA + lane * 8) = w;
        }
        }
        }
#endif
        GRID_BAR();

#if EN_G3
        { PHASE_IDS(); asm volatile("; PHASE_MARK EN_G3");
        {
          pg8::Gemm g{MIX, (const bf16*)(wl + W_OUT), NLAT, D_MODEL, D_MODEL, D_MODEL, 1 << 30, 0, D_MODEL, 0, 0, 0}; pg8::StaticOrder S; S.init(NLAT, D_MODEL, G, bx, WGM_RES);
          if (fused) { pg8::EpiResNorm E{xl_in, AP->out, modl + 2 * D_MODEL, NMOD * D_MODEL, Hb, AP->g_ffn + l * D_MODEL, modl + 3 * D_MODEL, modl + 4 * D_MODEL,
                                        (float*)(ws + WS_XS), ctl + CW_PANEL + ((l * 2 + 0) * 128) * 64, ctl + CW_BAR + XB_TMO, lds + LDSCTL_OFF + 2048, 0};
              pg8::gemm_phase<pg8::EpiResNorm, pg8::StaticOrder>(lds, g, S, E, tid); }
          else { pg8::EpiRes E{xl_in, xc_in, AP->out, XC, modl + 2 * D_MODEL, NMOD * D_MODEL, D_MODEL};
              pg8::gemm_phase<pg8::EpiRes, pg8::StaticOrder>(lds, g, S, E, tid); }
          if (!last) { pg8::Gemm g2{MIX + (size_t)NLAT * D_MODEL, (const bf16*)(wl + W_OUT), NCTX, D_MODEL, D_MODEL / 4, D_MODEL, 1 << 30, 0, D_MODEL, D_MODEL / 4, 0, 0}; pg8::SplitKOrder S2; S2.init(NCTX / 256, D_MODEL / 256, 4, G, bx);
              pg8::EpiPart E2{PART, modl + (size_t)BATCH * (NMOD * D_MODEL) + 2 * D_MODEL, NCTX, D_MODEL};
              pg8::gemm_phase<pg8::EpiPart, pg8::SplitKOrder>(lds, g2, S2, E2, tid); } }
        }
#endif
        GRID_BAR();

#if EN_N2
        { PHASE_IDS(); asm volatile("; PHASE_MARK EN_N2");
        _Pragma("unroll") for (int rep_ = 0; rep_ < DUP_N2; ++rep_) { if (rep_) GRID_BAR();
        norm_rows(AP->out, xc_in, Mres, Hb, AP->g_ffn + l * D_MODEL, modl, 3, 4, gw, NGW, lane, last ? nullptr : PART, XC, fused ? NLAT : 0);
        }
        }
#endif
        GRID_BAR();

#if EN_G4
        { PHASE_IDS(); asm volatile("; PHASE_MARK EN_G4");
        _Pragma("unroll") for (int rep_ = 0; rep_ < (DUP_G4 == 3 ? 1 : DUP_G4); ++rep_) {
        { pg8::Gemm g{Hb, (const bf16*)(wl + W_GU), Mres, 2 * FFN, D_MODEL, D_MODEL, 1 << 30, 0, D_MODEL, 0, 0, 0}; pg8::StaticOrder S; S.init(Mres, 2 * FFN, G, bx, WGM_G4); S.mode = HALVE_LAST;
          pg8::EpiSwiglu E{ACT, FFN, ACT_TILED ? NTOK : 0};
          STAGGER((Mres / 256) * (2 * FFN / 256), 4000);
          if (DUP_G4 == 3) { pg8::EpiSum E3{(float*)(ws + WS_MIX)};
              pg8::gemm_phase<pg8::EpiSum, pg8::StaticOrder>(lds, g, S, E3, tid); }
          pg8::gemm_phase<pg8::EpiSwiglu, pg8::StaticOrder>(lds, g, S, E, tid);
          if (HALVE_LAST) { S.mode = 2; pg8::gemm_phase<pg8::EpiSwiglu, pg8::StaticOrder, PG8_ALIGN_DEFAULT, true>(lds, g, S, E, tid); } }
        }
        }
#endif
        GRID_BAR();

#if EN_G5
        { PHASE_IDS(); asm volatile("; PHASE_MARK EN_G5");
        { pg8::Gemm g{ACT, (const bf16*)(wl + W_DOWN), NLAT, D_MODEL, FFN, ACT_TILED ? 64 : FFN, 1 << 30, 0, FFN, 0, ACT_TILED ? (long)NTOK * 128 : 0, 0}; pg8::StaticOrder S; S.init(NLAT, D_MODEL, G, bx, WGM_RES, REV_G5);
          if (fused) { const float* modn = MOD + (size_t)(l + 1) * 9 * (NMOD * D_MODEL);
              pg8::EpiResNorm E{AP->out, AP->out, modl + 5 * D_MODEL, NMOD * D_MODEL, Hb, last ? AP->g_final : AP->g_mix + (l + 1) * D_MODEL, modn, modn + D_MODEL,
                                (float*)(ws + WS_XS) + 128 * 256 * 8, ctl + CW_PANEL + ((l * 2 + 1) * 128) * 64, ctl + CW_BAR + XB_TMO, lds + LDSCTL_OFF + 2048, last ? 1 : 0};
              pg8::gemm_phase<pg8::EpiResNorm, pg8::StaticOrder>(lds, g, S, E, tid); }
          else { pg8::EpiRes E{AP->out, XC, AP->out, XC, modl + 5 * D_MODEL, NMOD * D_MODEL, D_MODEL};
              pg8::gemm_phase<pg8::EpiRes, pg8::StaticOrder>(lds, g, S, E, tid); }
          if (DUP_G5 >= 3) { pg8::StaticOrder S3; S3.init(NLAT, D_MODEL, G, bx, WGM_RES, REV_G5); if (DUP_G5 == 4) S3.pm_mod = 16;
              pg8::EpiSum E3{(float*)(ws + WS_MIX)}; pg8::gemm_phase<pg8::EpiSum, pg8::StaticOrder>(lds, g, S3, E3, tid); }
          if (!last) { pg8::Gemm g2{ACT + (size_t)NLAT * (ACT_TILED ? 64 : FFN), (const bf16*)(wl + W_DOWN), NCTX, D_MODEL, FFN / 4, ACT_TILED ? 64 : FFN, 1 << 30, 0, FFN, FFN / 4, ACT_TILED ? (long)NTOK * 128 : 0, ACT_TILED ? (long)(FFN / 4 / 64) * NTOK * 128 : 0}; pg8::SplitKOrder S2; S2.init(NCTX / 256, D_MODEL / 256, 4, G, bx);
              pg8::EpiPart E2{PART, modl + (size_t)BATCH * (NMOD * D_MODEL) + 5 * D_MODEL, NCTX, D_MODEL};
              pg8::gemm_phase<pg8::EpiPart, pg8::SplitKOrder>(lds, g2, S2, E2, tid); } }
        }
#endif
        GRID_BAR();
    }

#if BURN_MFMA
    {
        typedef short bx8 __attribute__((ext_vector_type(8))); typedef float fx4 __attribute__((ext_vector_type(4)));
        int t_ = threadIdx.x; asm volatile("" : "+v"(t_));
        bx8 a_, b_; for (int e = 0; e < 8; ++e) { a_[e] = (short)(0x3c00 + ((t_ * 7 + e) & 127)); b_[e] = (short)(0x3c00 + ((t_ * 13 + e * 5) & 127)); }
        fx4 c_[8]; for (int i = 0; i < 8; ++i) c_[i] = (fx4){0.f, 0.f, 0.f, 0.f};
#pragma unroll 1
        for (int it = 0; it < BURN_MFMA * 128; ++it) {
#pragma unroll
            for (int i = 0; i < 8; ++i) c_[i] = __builtin_amdgcn_mfma_f32_16x16x32_bf16(a_, b_, c_[i], 0, 0, 0);
        }
        float s_ = 0.f; for (int i = 0; i < 8; ++i) s_ += c_[i][0] + c_[i][1] + c_[i][2] + c_[i][3];
        ((float*)(A.ws + WS_PART))[blockIdx.x * 512 + threadIdx.x] = s_;
    }
#endif
    const int l = 0; PHASE_IDS();
    if (!(FUSE_NORM && G == 256))
    for (int row = gw; row < NLAT; row += NGW) {
        float* xr = AP->out + (size_t)row * D_MODEL;
        f32x4 v[8]; float ss = 0.f;
#pragma unroll
        for (int j = 0; j < 8; ++j) { v[j] = *(const f32x4*)(xr + 4 * lane + 256 * j); ss += (v[j].x * v[j].x + v[j].y * v[j].y) + (v[j].z * v[j].z + v[j].w * v[j].w); }
        const float rstd = 1.f / sqrtf(wave_sum(ss) * (1.f / D_MODEL) + EPS);
#pragma unroll
        for (int j = 0; j < 8; ++j) { const int col = 4 * lane + 256 * j; const f32x4 gv = *(const f32x4*)(AP->g_final + col); *(f32x4*)(xr + col) = (v[j] * rstd) * gv; }
    }
}

extern "C" void kernel_launch(void* const* d_in, const int* in_sizes, int n_in, void* d_out, int out_size, void* d_ws, size_t ws_size, hipStream_t stream) {
    static int grid = 0;
    if (grid == 0) {
        if (n_in != 23 || in_sizes[0] != NLAT * D_MODEL || out_size != NLAT * D_MODEL || ws_size < WS_END) {
            fprintf(stderr, "kernel_launch: unexpected shapes: n_in %d in0 %d out %d ws %zu (need %zu)\n", n_in, n_in > 0 ? in_sizes[0] : -1, out_size, ws_size, (size_t)WS_END); grid = -1; return; }
        int dev = 0, cus = 0, per_cu = 0;
        if (hipGetDevice(&dev) != hipSuccess || hipDeviceGetAttribute(&cus, hipDeviceAttributeMultiprocessorCount, dev) != hipSuccess) { fprintf(stderr, "kernel_launch: device query failed\n"); grid = -1; return; }
        if (hipFuncSetAttribute((const void*)fwd_kernel, hipFuncAttributeMaxDynamicSharedMemorySize, LDS_BYTES) != hipSuccess) { fprintf(stderr, "kernel_launch: hipFuncSetAttribute failed\n"); grid = -1; return; }
        if (hipOccupancyMaxActiveBlocksPerMultiprocessor(&per_cu, (const void*)fwd_kernel, NWAVES * 64, LDS_BYTES) != hipSuccess || per_cu < 1) { fprintf(stderr, "kernel_launch: occupancy query reports %d workgroups per CU\n", per_cu); (void)hipGetLastError(); grid = -1; return; }
        grid = cus;
    }
    if (grid < 0) return;
    if (hipMemsetAsync((char*)d_ws, 0, ZERO_BYTES, stream) != hipSuccess) { fprintf(stderr, "kernel_launch: memset failed\n"); return; }
    Ptrs p{};
    const float** pf = (const float**)&p;
    for (int i = 0; i < 23; ++i) pf[i] = (const float*)d_in[i];
    p.out = (float*)d_out; p.ws = (unsigned char*)d_ws;
    hipLaunchKernelGGL(fwd_kernel, dim3(grid), dim3(NWAVES * 64), LDS_BYTES, stream, p);
    const hipError_t le = hipPeekAtLastError();
    if (le != hipSuccess) fprintf(stderr, "kernel_launch: launch failed: %s\n", hipGetErrorName(le));
}
```

```cpp
#include <hip/hip_runtime.h>
#include <cstdio>
#include <cstdint>
#include <cmath>

constexpr int D_MODEL = 2048, BATCH = 8, SEQ = 4096, DEPTH = 4, CTX = 256;
constexpr int NLAT = BATCH * SEQ;
constexpr int NCTX = BATCH * CTX;
constexpr int NTOK = NLAT + NCTX;
constexpr int IN_W = 3936, IN_WP = 4096;
constexpr int FFN = 5632, NMOD = 6;
constexpr int UQ_W = 1152, UQ_WP = 1280, UKV_W = 1536;
constexpr float EPS = 1e-6f;
constexpr int C_CQ = 0, C_CKV = 512, C_KR = 1024, C_QS = 1088, C_KS = 1856, C_VS = 2112, C_GQ = 2368, C_GK = 2624, C_GV = 2880, C_GLR = 3392, C_GR = 3424;
constexpr int MX_MLA = 0, MX_SWA = 768, MX_GLA = 1536;

namespace pg8 {
#define PG8_LAS __attribute__((address_space(3)))
typedef unsigned short bf16_t;
typedef short bf16x8 __attribute__((ext_vector_type(8)));
typedef float f32x4 __attribute__((ext_vector_type(4)));
typedef unsigned u32x4 __attribute__((ext_vector_type(4)));
constexpr int BM = 256, BK = 64, HALF = 128, HTB = HALF * BK * 2  , STAGE_BYTES = 8 * HTB, NXCD = 8, WGM = 8;

__host__ __device__ __forceinline__ int lds_byte(int r, int c) { const int st = (r >> 4) * 2 + (c >> 5), rr = r & 15, cc = c & 31, ob = rr * 64 + cc * 2; return st * 1024 + (ob ^ (((ob >> 9) & 1) << 5)); }
__host__ __device__ __forceinline__ void stage_rc(int b, int& R, int& C) { const int st = b / 1024, sb = b % 1024, swz = sb ^ (((sb >> 9) & 1) << 5); R = (st >> 1) * 16 + swz / 64; C = (st & 1) * 32 + (swz % 64) / 2; }
__host__ __device__ __forceinline__ int perm32(int rho) { const int n = rho >> 4, i = rho & 15; return 8 * (i >> 2) + 4 * n + (i & 3); }

struct Unit { int pm, pn, ks; int hm = 0; };
struct Gemm { const bf16_t* A; const bf16_t* Bt; int M, N, K, lda, a_split_pn, a_split_off, ldb, ksplit; long kstepA, ksplitA; };

struct StaticOrder {
    int nM, nN, nwg, G, c, wgm, rev, pm_mod = 0, mode = 0;
    __host__ __device__ void init(int M, int N, int G_, int c_, int wgm_ = WGM, int rev_ = 0) { nM = M / BM; nN = N / BM; nwg = nM * nN; G = G_; c = c_; wgm = wgm_; rev = rev_; }
    __host__ __device__ bool next(int i, Unit& u) const {
        long L = (long)i * G + c; u.hm = 0;
        if (mode) { const int full = nwg / G, R = nwg - full * G; const bool split = R > 0 && 2 * R <= G;
            if (mode == 1) { if (split && i >= full) return false; }
            else { if (!split || i > 0 || c >= 2 * R) return false; L = (long)full * G + (c >> 1); u.hm = 1 + (c & 1); } }
        if (L >= nwg) return false;
        int wgid = (int)L; { const int q = nwg / NXCD, r = nwg % NXCD, xcd = wgid % NXCD, off = wgid / NXCD; wgid = (xcd < r ? xcd * (q + 1) : r * (q + 1) + (xcd - r) * q) + off; }
        const int nig = wgm * nN, gid = wgid / nig, fm = gid * wgm, gsz = (nM - fm) < wgm ? (nM - fm) : wgm;
        u.pm = fm + ((wgid % nig) % gsz); u.pn = (wgid % nig) / gsz; u.ks = 0; if (rev) u.pm = nM - 1 - u.pm; if (pm_mod) u.pm %= pm_mod; return true;
    }
    __device__ __forceinline__ void a_ready(const Unit&) const {}
    __device__ __forceinline__ void done(const Unit&) const {}
};

struct SplitKOrder {
    int nM, nN, nS, G, c;
    __host__ __device__ void init(int nM_, int nN_, int nS_, int G_, int c_) { nM = nM_; nN = nN_; nS = nS_; G = G_; c = c_; }
    __host__ __device__ bool next(int i, Unit& u) const { const int L = i * G + c; if (L >= nM * nN * nS) return false; u.ks = L % nS; u.pm = (L / nS) % nM; u.pn = L / (nS * nM); return true; }
    __device__ __forceinline__ void a_ready(const Unit&) const {}
    __device__ __forceinline__ void done(const Unit&) const {}
};

typedef float f32x2_t __attribute__((ext_vector_type(2))); typedef __bf16 bf16x2_t __attribute__((ext_vector_type(2)));
__device__ __forceinline__ unsigned cvt_pk_bf16(float lo, float hi) { f32x2_t v = {lo, hi}; bf16x2_t b = __builtin_convertvector(v, bf16x2_t); return __builtin_bit_cast(unsigned, b); }
typedef float f32x2 __attribute__((ext_vector_type(2)));
#ifndef NT_ACT
#define NT_ACT 0
#endif
typedef unsigned u32x2 __attribute__((ext_vector_type(2)));
__device__ __forceinline__ float fast_sigmoid(float x) { return __builtin_amdgcn_rcpf(1.0f + __builtin_amdgcn_exp2f(-1.4426950408889634f * x)); }
struct EpiStoreBf16 {
    static constexpr bool PERM = true, AFTER_DRAIN = false;
    bf16_t* O; int ldc;
    __device__ __forceinline__ void operator()(const f32x4 (&acc)[2][2][4][2], const Unit& u, int wr, int wc, int fr, int fq) const {
        const int row0 = u.pm * BM + wr * 64 + fr, col0 = u.pn * BM + wc * 32 + 8 * fq;
#pragma unroll
        for (int ai = 0; ai < 2; ++ai)
#pragma unroll
            for (int m = 0; m < 4; ++m) { bf16_t* rowp = O + (size_t)(row0 + ai * HALF + m * 16) * ldc + col0;
#pragma unroll
                for (int bj = 0; bj < 2; ++bj) { const f32x4 v0 = acc[ai][bj][m][0], v1 = acc[ai][bj][m][1];
                    u32x4 w; w.x = cvt_pk_bf16(v0[0], v0[1]); w.y = cvt_pk_bf16(v0[2], v0[3]); w.z = cvt_pk_bf16(v1[0], v1[1]); w.w = cvt_pk_bf16(v1[2], v1[3]);
                    *(u32x4*)(rowp + bj * HALF) = w; } }
    }
};
struct EpiQKV {
    static constexpr bool PERM = true, AFTER_DRAIN = false;
    bf16_t* Oq; int ldq; bf16_t* Okv; int ldkv; const float* rq; const float* rkv; int split;
    __device__ __forceinline__ void operator()(const f32x4 (&acc)[2][2][4][2], const Unit& u, int wr, int wc, int fr, int fq) const {
        const bool first = u.pn < split;
        bf16_t* base = first ? Oq : Okv; const int ld = first ? ldq : ldkv; const float* rs = first ? rq : rkv;
        const int row0 = u.pm * BM + wr * 64 + fr, col0 = (first ? u.pn : u.pn - split) * BM + wc * 32 + 8 * fq;
        float sv[2][4];
#pragma unroll
        for (int ai = 0; ai < 2; ++ai)
#pragma unroll
            for (int m = 0; m < 4; ++m) sv[ai][m] = rs[row0 + ai * HALF + m * 16];
#pragma unroll
        for (int ai = 0; ai < 2; ++ai)
#pragma unroll
            for (int m = 0; m < 4; ++m) { const int row = row0 + ai * HALF + m * 16; const float s = 1.0f / sqrtf(sv[ai][m] * (1.0f / 512.0f) + 1e-6f); bf16_t* rowp = base + (size_t)row * ld + col0;
#pragma unroll
                for (int bj = 0; bj < 2; ++bj) { const f32x4 v0 = acc[ai][bj][m][0] * s, v1 = acc[ai][bj][m][1] * s;
                    u32x4 w; w.x = cvt_pk_bf16(v0[0], v0[1]); w.y = cvt_pk_bf16(v0[2], v0[3]); w.z = cvt_pk_bf16(v1[0], v1[1]); w.w = cvt_pk_bf16(v1[2], v1[3]);
                    *(u32x4*)(rowp + bj * HALF) = w; } }
    }
};
struct EpiRes {
    static constexpr bool PERM = false, AFTER_DRAIN = false;
    const float* base_l; const float* base_c; float* out_l; float* out_c; const float* gate; int gpitch; int ncols;
    __device__ __forceinline__ void operator()(const f32x4 (&acc)[2][2][4][2], const Unit& u, int wr, int wc, int fr, int fq) const {
        const bool lat = u.pm < (NLAT / BM);
        const int gi = lat ? (u.pm >> 4) : BATCH;
        const float* bs = lat ? base_l : base_c; float* os = lat ? out_l : out_c;
        const int row0 = (lat ? u.pm : u.pm - NLAT / BM) * BM + wr * 64 + fr, col0 = u.pn * BM + wc * 32 + 4 * fq;
        f32x4 gv[2][2];
#pragma unroll
        for (int bj = 0; bj < 2; ++bj)
#pragma unroll
            for (int n = 0; n < 2; ++n) gv[bj][n] = *(const f32x4*)(gate + (size_t)gi * gpitch + col0 + bj * HALF + n * 16);
#pragma unroll
        for (int ai = 0; ai < 2; ++ai)
#pragma unroll
            for (int m = 0; m < 4; ++m) { const size_t off = (size_t)(row0 + ai * HALF + m * 16) * ncols + col0;
#pragma unroll
                for (int bj = 0; bj < 2; ++bj)
#pragma unroll
                    for (int n = 0; n < 2; ++n) { const f32x4 b = *(const f32x4*)(bs + off + bj * HALF + n * 16); *(f32x4*)(os + off + bj * HALF + n * 16) = b + gv[bj][n] * acc[ai][bj][m][n]; }
                asm volatile("" ::: "memory"); }
    }
};
struct EpiSwiglu {
    static constexpr bool PERM = true, AFTER_DRAIN = false;
    bf16_t* O; int ldc; int tiled_rows;
    __device__ __forceinline__ void operator()(const f32x4 (&acc)[2][2][4][2], const Unit& u, int wr, int wc, int fr, int fq) const {
        const int row0 = u.pm * BM + (u.hm == 2 ? HALF : 0) + wr * 64 + fr, col0 = u.pn * HALF + wc * 32 + 8 * fq;
#pragma unroll
        for (int ai = 0; ai < 2; ++ai) { if (ai == 1 && u.hm) break;
#pragma unroll
            for (int m = 0; m < 4; ++m) { const int row = row0 + ai * HALF + m * 16;
                bf16_t* rowp = tiled_rows ? O + ((size_t)(col0 >> 6) * tiled_rows + row) * 64 + (col0 & 63) : O + (size_t)row * ldc + col0;
                float r[8];
#pragma unroll
                for (int n = 0; n < 2; ++n)
#pragma unroll
                    for (int i = 0; i < 4; ++i) { const float g = acc[ai][0][m][n][i], up = acc[ai][1][m][n][i]; r[n * 4 + i] = g * fast_sigmoid(g) * up; }
                u32x4 w; w.x = cvt_pk_bf16(r[0], r[1]); w.y = cvt_pk_bf16(r[2], r[3]); w.z = cvt_pk_bf16(r[4], r[5]); w.w = cvt_pk_bf16(r[6], r[7]);
#if NT_ACT
                __builtin_nontemporal_store(w, (u32x4*)rowp);
#else
                *(u32x4*)rowp = w;
#endif
                }
        }
    }
};

struct EpiSum {
    static constexpr bool PERM = false, AFTER_DRAIN = false;
    float* O;
    __device__ __forceinline__ void operator()(const f32x4 (&acc)[2][2][4][2], const Unit& u, int wr, int wc, int fr, int fq) const {
        float s = 0.f;
#pragma unroll
        for (int ai = 0; ai < 2; ++ai)
#pragma unroll
            for (int bj = 0; bj < 2; ++bj)
#pragma unroll
                for (int m = 0; m < 4; ++m)
#pragma unroll
                    for (int n = 0; n < 2; ++n) s += (acc[ai][bj][m][n][0] + acc[ai][bj][m][n][1]) + (acc[ai][bj][m][n][2] + acc[ai][bj][m][n][3]);
        O[(size_t)(u.pm * 8 + u.pn) * 512 + (wr * 4 + wc) * 64 + fq * 16 + fr] = s;
    }
};

struct EpiPart {
    static constexpr bool PERM = false, AFTER_DRAIN = false;
    float* slab; const float* gate; int nrows, ncols;
    __device__ __forceinline__ void operator()(const f32x4 (&acc)[2][2][4][2], const Unit& u, int wr, int wc, int fr, int fq) const {
        const int row0 = u.pm * BM + wr * 64 + fr, col0 = u.pn * BM + wc * 32 + 4 * fq;
        float* os = slab + (size_t)u.ks * nrows * ncols;
        f32x4 gv[2][2];
#pragma unroll
        for (int bj = 0; bj < 2; ++bj)
#pragma unroll
            for (int n = 0; n < 2; ++n) gv[bj][n] = *(const f32x4*)(gate + col0 + bj * HALF + n * 16);
#pragma unroll
        for (int ai = 0; ai < 2; ++ai)
#pragma unroll
            for (int m = 0; m < 4; ++m) { const size_t off = (size_t)(row0 + ai * HALF + m * 16) * ncols + col0;
#pragma unroll
                for (int bj = 0; bj < 2; ++bj)
#pragma unroll
                    for (int n = 0; n < 2; ++n) *(f32x4*)(os + off + bj * HALF + n * 16) = gv[bj][n] * acc[ai][bj][m][n]; }
    }
};

struct EpiResNorm {
    static constexpr bool PERM = false, AFTER_DRAIN = false;
    const float* base_l; float* out_l; const float* gate; int gpitch;
    bf16_t* H;
    const float* gvec; const float* shiftp; const float* scalep;
    float* slots; unsigned* cnt; unsigned* tmo;
    PG8_LAS unsigned char* scr;
    int fin;
    __device__ __forceinline__ void operator()(f32x4 (&acc)[2][2][4][2], const Unit& u, int wr, int wc, int fr, int fq) const {
        const int gi = u.pm >> 4, row0 = u.pm * BM + wr * 64 + fr, col0 = u.pn * BM + wc * 32 + 4 * fq, wid = wr * 4 + wc, lane = fq * 16 + fr, tid = wid * 64 + lane;
        PG8_LAS float* P = (PG8_LAS float*)scr; PG8_LAS float* S = (PG8_LAS float*)(scr + 4096); PG8_LAS unsigned* flag = (PG8_LAS unsigned*)(scr + 5120);
        { f32x4 gv[2][2];
#pragma unroll
          for (int bj = 0; bj < 2; ++bj)
#pragma unroll
              for (int n = 0; n < 2; ++n) gv[bj][n] = *(const f32x4*)(gate + (size_t)gi * gpitch + col0 + bj * HALF + n * 16);
          f32x4 bb[2][2][2];
#define ERN_LOADB(it_, buf_) do { const size_t o_ = (size_t)(row0 + ((it_) >> 2) * HALF + ((it_) & 3) * 16) * 2048 + col0; \
    _Pragma("unroll") for (int bj = 0; bj < 2; ++bj) _Pragma("unroll") for (int n = 0; n < 2; ++n) bb[buf_][bj][n] = *(const f32x4*)(base_l + o_ + bj * HALF + n * 16); } while (0)
          ERN_LOADB(0, 0);
#pragma unroll
          for (int it = 0; it < 8; ++it) { const int ai = it >> 2, m = it & 3; const size_t off = (size_t)(row0 + ai * HALF + m * 16) * 2048 + col0; float ss = 0.f;
                  if (it + 1 < 8) ERN_LOADB(it + 1, (it + 1) & 1);
#pragma unroll
                  for (int bj = 0; bj < 2; ++bj)
#pragma unroll
                      for (int n = 0; n < 2; ++n) { const f32x4 b = bb[it & 1][bj][n]; const f32x4 x = b + gv[bj][n] * acc[ai][bj][m][n]; acc[ai][bj][m][n] = x;
                          if (!fin) *(f32x4*)(out_l + off + bj * HALF + n * 16) = x; ss += (x[0] * x[0] + x[1] * x[1]) + (x[2] * x[2] + x[3] * x[3]); }
                  ss += __int_as_float(__builtin_amdgcn_ds_swizzle(__float_as_int(ss), (16 << 10) | 0x1f));
                  { auto rr = __builtin_amdgcn_permlane32_swap(__float_as_uint(ss), __float_as_uint(ss), false, false); ss = __uint_as_float(rr[0]) + __uint_as_float(rr[1]); }
                  if (fq == 0) P[(ai * HALF + wr * 64 + m * 16 + fr) * 4 + wc] = ss;
                  asm volatile("" ::: "memory"); }
#undef ERN_LOADB
        }
        asm volatile("s_waitcnt lgkmcnt(0)" ::: "memory"); __builtin_amdgcn_s_barrier(); asm volatile("" ::: "memory");
        if (tid < 256) { const f32x4 p = *(const PG8_LAS f32x4*)(P + tid * 4); const float s = (p[0] + p[1]) + (p[2] + p[3]);
            __hip_atomic_store((unsigned*)slots + ((size_t)(u.pm * 256 + tid) * 8 + u.pn), __float_as_uint(s), __ATOMIC_RELAXED, __HIP_MEMORY_SCOPE_AGENT);
            asm volatile("s_waitcnt vmcnt(0)" ::: "memory");
            if (lane == 0) __hip_atomic_fetch_add(cnt + 64 * u.pm, 1u, __ATOMIC_RELAXED, __HIP_MEMORY_SCOPE_AGENT); }
        if (wid == 0) { unsigned dead = 0u, sp = 0u;
            while ((unsigned)__builtin_amdgcn_readfirstlane(__hip_atomic_load(cnt + 64 * u.pm, __ATOMIC_RELAXED, __HIP_MEMORY_SCOPE_AGENT)) < 32u) {
                __builtin_amdgcn_s_sleep(1);
                if ((++sp & 255u) == 0u) { if (__builtin_amdgcn_readfirstlane(__hip_atomic_load(tmo, __ATOMIC_RELAXED, __HIP_MEMORY_SCOPE_AGENT)) != 0u) { dead = 1u; break; }
                    if (sp > (1u << 20)) { if (lane == 0) __hip_atomic_fetch_add(tmo, 1u, __ATOMIC_RELAXED, __HIP_MEMORY_SCOPE_AGENT); dead = 1u; break; } } }
            __builtin_amdgcn_fence(__ATOMIC_ACQUIRE, "agent");
            if (lane == 0) flag[0] = dead; }
        asm volatile("s_waitcnt vmcnt(0) lgkmcnt(0)" ::: "memory"); __builtin_amdgcn_s_barrier(); asm volatile("" ::: "memory");
        if (tid < 256) { const unsigned* sl = (const unsigned*)slots + (size_t)(u.pm * 256 + tid) * 8; float t = 0.f;
#pragma unroll
            for (int q = 0; q < 8; ++q) t += __uint_as_float(__hip_atomic_load(sl + q, __ATOMIC_RELAXED, __HIP_MEMORY_SCOPE_AGENT));
            S[tid] = 1.0f / sqrtf(t * (1.0f / 2048.0f) + 1e-6f); }
        asm volatile("s_waitcnt lgkmcnt(0)" ::: "memory"); __builtin_amdgcn_s_barrier(); asm volatile("" ::: "memory");
        const bool bad = flag[0] != 0u; const float qnan = __builtin_nanf("");
        f32x4 gs[2][2], sh[2][2];
#pragma unroll
        for (int bj = 0; bj < 2; ++bj)
#pragma unroll
            for (int n = 0; n < 2; ++n) { const int c = col0 + bj * HALF + n * 16; const f32x4 g4 = *(const f32x4*)(gvec + c);
                if (fin) { gs[bj][n] = g4; sh[bj][n] = (f32x4){0.f, 0.f, 0.f, 0.f}; }
                else { gs[bj][n] = g4 * (*(const f32x4*)(scalep + (size_t)gi * gpitch + c) + 1.0f); sh[bj][n] = *(const f32x4*)(shiftp + (size_t)gi * gpitch + c); } }
#pragma unroll
        for (int ai = 0; ai < 2; ++ai)
#pragma unroll
            for (int m = 0; m < 4; ++m) { const int r = ai * HALF + wr * 64 + m * 16 + fr; const float rs = bad ? qnan : S[r]; const size_t off = (size_t)(u.pm * BM + r) * 2048 + col0;
#pragma unroll
                for (int bj = 0; bj < 2; ++bj)
#pragma unroll
                    for (int n = 0; n < 2; ++n) { const f32x4 y = (acc[ai][bj][m][n] * rs) * gs[bj][n] + sh[bj][n];
                        if (fin) *(f32x4*)(out_l + off + bj * HALF + n * 16) = y;
                        else { u32x2 w; w.x = cvt_pk_bf16(y[0], y[1]); w.y = cvt_pk_bf16(y[2], y[3]); *(u32x2*)(H + off + bj * HALF + n * 16) = w; } } }
    }
};

__host__ __device__ __forceinline__ int w_in_row(int c) {
    if (c >= 1856 && c < 2112) { const int B = 1856 + ((c - 1856) & ~127), d = (c - 1856) & 127, blk = d >> 6, n = (d & 63) >> 5, i = d & 31; return B + 8 * (blk * 8 + (i >> 2)) + 4 * n + (i & 3); }
    if (c >= 1024 && c < 1088) { const int d = c - 1024, blk = d >> 5, n = (d & 31) >> 4, i = d & 15; return 1024 + 8 * (blk * 4 + (i >> 2)) + 4 * n + (i & 3); }
    return c;
}
struct EpiInProj {
    static constexpr bool PERM = true, AFTER_DRAIN = false;
    bf16_t* O; int ldc; float* ssq; int ssq_rows; const float* tab32; const float* tab16; int nlat, seqmask;
    __device__ __forceinline__ void operator()(const f32x4 (&acc)[2][2][4][2], const Unit& u, int wr, int wc, int fr, int fq) const {
        const int row0 = u.pm * BM + (u.hm == 2 ? HALF : 0) + wr * 64 + fr; const bool stat = u.pn < 4; const bool lat = u.pm * BM < nlat; const int nai = u.hm ? 1 : 2;
#pragma unroll
        for (int bj = 0; bj < 2; ++bj) {
            const int p0 = u.pn * BM + bj * HALF + wc * 32 + 8 * fq;
            const bool inKS = p0 >= 1856 && p0 < 2112, inKR = p0 >= 1024 && p0 < 1088;
            if (inKS || inKR) {
                const int half = inKS ? 32 : 16, base = inKS ? 1856 + ((p0 - 1856) & ~127) : 1024, t = (p0 - base) >> 3, blk = inKS ? (t >> 3) : (t >> 2), i0 = 4 * (inKS ? (t & 7) : (t & 3));
                const float* tb = inKS ? tab32 : tab16; const int c1 = base + blk * 2 * half + i0;
#pragma unroll
                for (int ai = 0; ai < 2; ++ai) if (ai < nai)
#pragma unroll
                    for (int m = 0; m < 4; ++m) { const int row = row0 + ai * HALF + m * 16; f32x4 x1 = acc[ai][bj][m][0], x2 = acc[ai][bj][m][1];
                        if (lat) { const int ns = row & seqmask, pos = blk ? (ns & 63) : (ns >> 6); const f32x4 c = *(const f32x4*)(tb + pos * half + i0), s = *(const f32x4*)(tb + 64 * half + pos * half + i0);
                            const f32x4 y1 = x1 * c - x2 * s, y2 = x2 * c + x1 * s; x1 = y1; x2 = y2; }
                        u32x2 w1, w2; w1.x = cvt_pk_bf16(x1[0], x1[1]); w1.y = cvt_pk_bf16(x1[2], x1[3]); w2.x = cvt_pk_bf16(x2[0], x2[1]); w2.y = cvt_pk_bf16(x2[2], x2[3]);
                        bf16_t* rowp = O + (size_t)row * ldc + c1; *(u32x2*)rowp = w1; *(u32x2*)(rowp + half) = w2; }
            } else {
#pragma unroll
                for (int ai = 0; ai < 2; ++ai) if (ai < nai)
#pragma unroll
                    for (int m = 0; m < 4; ++m) { const f32x4 v0 = acc[ai][bj][m][0], v1 = acc[ai][bj][m][1];
                        u32x4 w; w.x = cvt_pk_bf16(v0[0], v0[1]); w.y = cvt_pk_bf16(v0[2], v0[3]); w.z = cvt_pk_bf16(v1[0], v1[1]); w.w = cvt_pk_bf16(v1[2], v1[3]);
                        *(u32x4*)(O + (size_t)(row0 + ai * HALF + m * 16) * ldc + p0) = w; }
            }
        }
        if (stat) {
#pragma unroll
            for (int ai = 0; ai < 2; ++ai) if (ai < nai)
#pragma unroll
                for (int m = 0; m < 4; ++m) { float ss = 0.f;
#pragma unroll
                    for (int bj = 0; bj < 2; ++bj) { const f32x4 v0 = acc[ai][bj][m][0], v1 = acc[ai][bj][m][1];
                        ss += ((v0[0] * v0[0] + v0[1] * v0[1]) + (v0[2] * v0[2] + v0[3] * v0[3])) + ((v1[0] * v1[0] + v1[1] * v1[1]) + (v1[2] * v1[2] + v1[3] * v1[3])); }
                    ss += __int_as_float(__builtin_amdgcn_ds_swizzle(__float_as_int(ss), (16 << 10) | 0x1f));
                    { auto rr = __builtin_amdgcn_permlane32_swap(__float_as_uint(ss), __float_as_uint(ss), false, false); ss = __uint_as_float(rr[0]) + __uint_as_float(rr[1]); }
                    if (fq == 0) __hip_atomic_fetch_add(ssq + (size_t)(u.pn >> 1) * ssq_rows + row0 + ai * HALF + m * 16, ss, __ATOMIC_RELAXED, __HIP_MEMORY_SCOPE_AGENT); }
        }
    }
};

#ifndef PG8_ALIGN_DEFAULT
#define PG8_ALIGN_DEFAULT true
#endif
__device__ __forceinline__ f32x4 zero_quad() { f32x2 lo, hi; asm volatile("v_mov_b64 %0, 0" : "=v"(lo)); asm volatile("v_mov_b64 %0, 0" : "=v"(hi)); return (f32x4){lo[0], lo[1], hi[0], hi[1]}; }
template <class Epi, class Sched, bool ALIGN_EPI = PG8_ALIGN_DEFAULT, bool HALFM = false>
__device__ __forceinline__ void gemm_phase(PG8_LAS unsigned char* lds, const Gemm g, const Sched& S, const Epi& E, const int tid) {
    const int wid = __builtin_amdgcn_readfirstlane(tid >> 6), lane = tid & 63, wr = wid >> 2, wc = wid & 3, fr = lane & 15, fq = lane >> 4;
    const int K = g.K, nt = K / BK;
    unsigned voffA[2], voffB[2];
#pragma unroll
    for (int i = 0; i < 2; ++i) { int R, C; stage_rc(tid * 16 + i * 8192, R, C); const int Rb = Epi::PERM ? ((R & ~31) + perm32(R & 31)) : R;
        voffA[i] = (unsigned)(R * g.lda + C) * 2u; voffB[i] = (unsigned)(Rb * g.ldb + C) * 2u; }
    const size_t kstep = (size_t)(BK * 2), kstepA = g.kstepA ? (size_t)g.kstepA : kstep;
    const size_t hstepA = (size_t)HALF * g.lda * 2, hstepB = (size_t)HALF * g.ldb * 2;
    const size_t tstepA = 2 * hstepA, tstepB = 2 * hstepB; const size_t hA1 = HALFM ? (size_t)0 : hstepA;
#define PG8_AOFF(u) ((size_t)(u).pm * tstepA + ((HALFM && (u).hm == 2) ? hstepA : (size_t)0) + ((u).pn >= g.a_split_pn ? (size_t)g.a_split_off * 2 : (size_t)0) + (size_t)(u).ks * (g.ksplitA ? (size_t)g.ksplitA : (size_t)g.ksplit * 2))
#define PG8_BOFF(u) ((size_t)(u).pn * tstepB + (size_t)(u).ks * g.ksplit * 2)
    const unsigned ldsw = (unsigned)wid * 1024u;
    const int aoff = lds_byte(wr * 64 + fr, fq * 8), boff = lds_byte(wc * 32 + fr, fq * 8);
#define PG8_SA(b, h) (((b) * 2 + (h)) * HTB)
#define PG8_SB(b, h) ((4 + (b) * 2 + (h)) * HTB)
#define PG8_STAGE(bufoff, gbase, voff) do { _Pragma("unroll") for (int _i = 0; _i < 2; ++_i) \
        __builtin_amdgcn_global_load_lds((const unsigned*)((const char*)(gbase) + (voff)[_i]), (PG8_LAS unsigned*)(lds + (bufoff) + ldsw + _i * 8192), 16, 0, 0); } while (0)
#define PG8_LDA(dst, b, h) do { _Pragma("unroll") for (int m = 0; m < 4; ++m) _Pragma("unroll") for (int k = 0; k < 2; ++k) dst[m][k] = *(const PG8_LAS bf16x8*)(lds + PG8_SA(b, h) + aoff + m * 2048 + k * 1024); } while (0)
#define PG8_LDB(dst, b, h) do { _Pragma("unroll") for (int n = 0; n < 2; ++n) _Pragma("unroll") for (int k = 0; k < 2; ++k) dst[n][k] = *(const PG8_LAS bf16x8*)(lds + PG8_SB(b, h) + boff + n * 2048 + k * 1024); } while (0)
#define PG8_MMA(ai, bj, At, Bt) do { __builtin_amdgcn_s_setprio(1); _Pragma("unroll") for (int m = 0; m < 4; ++m) _Pragma("unroll") for (int n = 0; n < 2; ++n) _Pragma("unroll") for (int k = 0; k < 2; ++k) \
        acc[ai][bj][m][n] = __builtin_amdgcn_mfma_f32_16x16x32_bf16(Bt[n][k], At[m][k], acc[ai][bj][m][n], 0, 0, 0); __builtin_amdgcn_s_setprio(0); } while (0)
#define PG8_WAIT_V(n) asm volatile("s_waitcnt vmcnt(" #n ")" ::: "memory")
#define PG8_WAIT_L(n) asm volatile("s_waitcnt lgkmcnt(" #n ")" ::: "memory")
#define PG8_BAR __builtin_amdgcn_s_barrier()
#define PG8_SCHED __builtin_amdgcn_sched_barrier(0)
    Unit cur, nxt; int ui = 0;
    if (!S.next(0, cur)) return;
    f32x4 acc[2][2][4][2];
#pragma unroll
    for (int a = 0; a < 2; ++a)
#pragma unroll
        for (int b = 0; b < 2; ++b)
#pragma unroll
            for (int m = 0; m < 4; ++m)
#pragma unroll
                for (int n = 0; n < 2; ++n) acc[a][b][m][n] = zero_quad();
    bf16x8 At[4][2], B0[2][2], B1[2][2];
    const char* cA = (const char*)g.A + PG8_AOFF(cur); const char* cB = (const char*)g.Bt + PG8_BOFF(cur);
    S.a_ready(cur);
    {
        PG8_STAGE(PG8_SB(0, 0), cB, voffB); PG8_STAGE(PG8_SB(0, 1), cB + hstepB, voffB); PG8_STAGE(PG8_SA(0, 0), cA, voffA); PG8_STAGE(PG8_SA(0, 1), cA + hA1, voffA);
        if (wr == 1) PG8_BAR;
        PG8_WAIT_V(2); PG8_BAR;
        PG8_STAGE(PG8_SB(1, 0), cB + kstep, voffB); PG8_STAGE(PG8_SA(1, 0), cA + kstepA, voffA); PG8_STAGE(PG8_SB(1, 1), cB + hstepB + kstep, voffB);
        PG8_WAIT_V(6); PG8_BAR;
    }
    for (;;) {
        const bool has_next = S.next(ui + 1, nxt);
        const char* nA = has_next ? (const char*)g.A + PG8_AOFF(nxt) : cA; const char* nB = has_next ? (const char*)g.Bt + PG8_BOFF(nxt) : cB;
        for (int t = 0; t < nt; t += 2) {
            const bool last = (t == nt - 2);
            const char* a1 = cA + (size_t)(t + 1) * kstepA;
            const char* a2 = last ? nA : cA + (size_t)(t + 2) * kstepA; const char* b2 = last ? nB : cB + (size_t)(t + 2) * kstep;
            const char* a3 = a2 + kstepA; const char* b3 = b2 + kstep;
            if (last && has_next) S.a_ready(nxt);
            {
            PG8_LDB(B0, 0, 0); PG8_LDB(B1, 0, 1); PG8_SCHED; PG8_LDA(At, 0, 0); PG8_STAGE(PG8_SA(1, 1), a1 + hA1, voffA);
            PG8_WAIT_V(8); PG8_WAIT_L(0); PG8_BAR; PG8_MMA(0, 0, At, B0); PG8_MMA(0, 1, At, B1); PG8_BAR; PG8_SCHED;
            PG8_LDA(At, 0, 1); PG8_STAGE(PG8_SB(0, 0), b2, voffB); PG8_STAGE(PG8_SB(0, 1), b2 + hstepB, voffB); PG8_STAGE(PG8_SA(0, 0), a2, voffA);
            PG8_WAIT_V(8); PG8_WAIT_L(0); PG8_BAR; if constexpr (!HALFM) { PG8_MMA(1, 0, At, B0); PG8_MMA(1, 1, At, B1); } PG8_BAR; PG8_SCHED;
            PG8_LDB(B0, 1, 0); PG8_LDB(B1, 1, 1); PG8_SCHED; PG8_LDA(At, 1, 0); PG8_STAGE(PG8_SA(0, 1), a2 + hA1, voffA);
            PG8_WAIT_V(8); PG8_WAIT_L(0); PG8_BAR; PG8_MMA(0, 0, At, B0); PG8_MMA(0, 1, At, B1); PG8_BAR; PG8_SCHED;
            PG8_LDA(At, 1, 1); PG8_STAGE(PG8_SB(1, 0), b3, voffB); PG8_STAGE(PG8_SB(1, 1), b3 + hstepB, voffB); PG8_STAGE(PG8_SA(1, 0), a3, voffA);
            PG8_WAIT_V(8); PG8_WAIT_L(0); PG8_BAR; if constexpr (!HALFM) { PG8_MMA(1, 0, At, B0); PG8_MMA(1, 1, At, B1); } PG8_BAR; PG8_SCHED;
            }
        }
        if constexpr (ALIGN_EPI) { if (wr == 0) PG8_BAR; }
        if constexpr (!Epi::AFTER_DRAIN) { E(acc, cur, wr, wc, fr, fq); S.done(cur); }
        if (!has_next) break;
#pragma unroll
        for (int a = 0; a < 2; ++a)
#pragma unroll
            for (int b = 0; b < 2; ++b)
#pragma unroll
                for (int m = 0; m < 4; ++m)
#pragma unroll
                    for (int n = 0; n < 2; ++n) acc[a][b][m][n] = zero_quad();
        cur = nxt; cA = nA; cB = nB; ++ui;
        if constexpr (ALIGN_EPI) { if (wr == 1) PG8_BAR; }
    }
    PG8_WAIT_V(0);
    if constexpr (!ALIGN_EPI) { if (wr == 0) PG8_BAR; }
    PG8_BAR;
    if constexpr (Epi::AFTER_DRAIN) { E.fused(acc, cur, wr, wc, fr, fq, lds, wid, lane); S.done(cur); }
#undef PG8_AOFF
#undef PG8_BOFF
#undef PG8_SA
#undef PG8_SB
#undef PG8_STAGE
#undef PG8_LDA
#undef PG8_LDB
#undef PG8_MMA
#undef PG8_WAIT_V
#undef PG8_WAIT_L
#undef PG8_BAR
#undef PG8_SCHED
}
}
namespace att {
typedef unsigned short bf16;
using bf16x8 = __attribute__((ext_vector_type(8))) short;
using s16x4  = __attribute__((ext_vector_type(4))) short;
using f32x16 = __attribute__((ext_vector_type(16))) float;
using f32x4  = __attribute__((ext_vector_type(4))) float;
using u32x4  = __attribute__((ext_vector_type(4))) unsigned;
constexpr int NW = 8, QBLK = 32, KVBLK = 64, DV = 128;
constexpr float THR = 8.f;
#define ATT_SBAR() __builtin_amdgcn_sched_barrier(0)
__device__ __forceinline__ int crow(int r, int hi) { return (r & 3) + 8 * (r >> 2) + 4 * hi; }
typedef float f32x2_t __attribute__((ext_vector_type(2))); typedef __bf16 bf16x2_t __attribute__((ext_vector_type(2)));
__device__ __forceinline__ unsigned cvtpk(float lo, float hi) { f32x2_t v = {lo, hi}; bf16x2_t b = __builtin_convertvector(v, bf16x2_t); return __builtin_bit_cast(unsigned, b); }
__device__ __forceinline__ float bf2f(short s) { return __uint_as_float(((unsigned)(unsigned short)s) << 16); }
__device__ __forceinline__ short f2bf(float f) { unsigned u = __float_as_uint(f); u += 0x7fffu + ((u >> 16) & 1u); return (short)(u >> 16); }

template <int DQK> struct Cfg {
    static constexpr int KROW = DQK * 2 + 16;
    static constexpr int SHM_V = KVBLK * DV * 2, SHM_K = KVBLK * KROW;
    static constexpr int OFF_V = 0, OFF_K = 2 * SHM_V, OFF_WS = 2 * SHM_V + 2 * SHM_K, BYTES = OFF_WS + NW * 64 * 4;
};

__device__ __forceinline__ void partialSM(f32x16& p0, f32x16& p1, float& m_reg, float& mn, float& alpha, const float C, const float TS) {
    float pmax = p0[0];
#pragma unroll
    for (int r = 1; r < 16; ++r) pmax = fmaxf(pmax, p0[r]);
#pragma unroll
    for (int r = 0; r < 16; ++r) pmax = fmaxf(pmax, p1[r]);
    { auto rr = __builtin_amdgcn_permlane32_swap(__float_as_uint(pmax), __float_as_uint(pmax), false, false);
      pmax = fmaxf(__uint_as_float(rr[0]), __uint_as_float(rr[1])); }
    if (__builtin_expect(__all(pmax - m_reg <= TS), 1)) { mn = m_reg; alpha = 1.f; }
    else { mn = fmaxf(m_reg, pmax); alpha = __builtin_amdgcn_exp2f((m_reg - mn) * C); m_reg = mn; }
    const float mnC = -mn * C;
#pragma unroll
    for (int r = 0; r < 16; ++r) p0[r] = fmaf(p0[r], C, mnC);
#pragma unroll
    for (int r = 0; r < 16; ++r) p1[r] = fmaf(p1[r], C, mnC);
#pragma unroll
    for (int r = 0; r < 16; ++r) p0[r] = __builtin_amdgcn_exp2f(p0[r]);
}
__device__ __forceinline__ void finishSM(f32x16& p0, f32x16& p1, float alpha, float& l_reg, bf16x8& pa0, bf16x8& pa1, bf16x8& pa2, bf16x8& pa3) {
#pragma unroll
    for (int r = 0; r < 16; ++r) p1[r] = __builtin_amdgcn_exp2f(p1[r]);
    float ps = 0;
#pragma unroll
    for (int r = 0; r < 16; ++r) ps += p0[r];
#pragma unroll
    for (int r = 0; r < 16; ++r) ps += p1[r];
    { auto rr = __builtin_amdgcn_permlane32_swap(__float_as_uint(ps), __float_as_uint(ps), false, false);
      ps = __uint_as_float(rr[0]) + __uint_as_float(rr[1]); }
    l_reg = l_reg * alpha + ps;
#define ATT_PK4(P, BASE, OUT) do { unsigned a0 = cvtpk(P[BASE + 0], P[BASE + 1]), a1 = cvtpk(P[BASE + 2], P[BASE + 3]);   \
    unsigned b0 = cvtpk(P[BASE + 4], P[BASE + 5]), b1 = cvtpk(P[BASE + 6], P[BASE + 7]);                              \
    auto r0 = __builtin_amdgcn_permlane32_swap(a0, b0, false, false); auto r1 = __builtin_amdgcn_permlane32_swap(a1, b1, false, false); \
    u32x4 w = {r0[0], r1[0], r0[1], r1[1]}; OUT = *reinterpret_cast<bf16x8*>(&w); } while (0)
    ATT_PK4(p0, 0, pa0); ATT_PK4(p0, 8, pa1); ATT_PK4(p1, 0, pa2); ATT_PK4(p1, 8, pa3);
}
template <int DQK> __device__ __forceinline__ void qkt(f32x16& p0, f32x16& p1, const char* Ks, const bf16x8* qr, int r32, int hi) {
    constexpr int KROW = Cfg<DQK>::KROW;
    p0 = f32x16{}; p1 = f32x16{};
#pragma unroll
    for (int d0 = 0; d0 < DQK / 16; ++d0) { const int cb = (d0 * 16 + hi * 8) * 2;
        const bf16x8 b0 = *reinterpret_cast<const bf16x8*>(Ks + r32 * KROW + cb);
        const bf16x8 b1 = *reinterpret_cast<const bf16x8*>(Ks + (32 + r32) * KROW + cb);
        p0 = __builtin_amdgcn_mfma_f32_32x32x16_bf16(b0, qr[d0], p0, 0, 0, 0);
        p1 = __builtin_amdgcn_mfma_f32_32x32x16_bf16(b1, qr[d0], p1, 0, 0, 0); }
}
__device__ __forceinline__ int v_st(int k, int c) { const int kk = (k & ~0xC) | ((k & 4) << 1) | ((k & 8) >> 1); return ((kk >> 3) * 4 + (c >> 5)) * 512 + ((kk & 7) * 32 + (c & 31)) * 2; }
__device__ __forceinline__ int v_rd_base(int lane) { return ((lane & 3) << 3) | (((lane >> 2) & 3) << 6) | (((lane >> 4) & 1) << 5) | (((lane >> 5) & 1) << 8); }
constexpr int v_rd_off(int d0, int ks, int half) { return d0 * 512 + ks * 4096 + half * 2048; }
template <int OFF> __device__ __forceinline__ s16x4 tr_read(int vb) { s16x4 r; asm volatile("ds_read_b64_tr_b16 %0, %1 offset:%2" : "=&v"(r) : "v"(vb), "i"(OFF) : "memory"); return r; }
template <int D0> __device__ __forceinline__ void pv_one(f32x16& od, int vb, bf16x8 pa0, bf16x8 pa1, bf16x8 pa2, bf16x8 pa3) {
    const s16x4 l0 = tr_read<v_rd_off(D0, 0, 0)>(vb), h0 = tr_read<v_rd_off(D0, 0, 1)>(vb), l1 = tr_read<v_rd_off(D0, 1, 0)>(vb), h1 = tr_read<v_rd_off(D0, 1, 1)>(vb);
    const s16x4 l2 = tr_read<v_rd_off(D0, 2, 0)>(vb), h2 = tr_read<v_rd_off(D0, 2, 1)>(vb), l3 = tr_read<v_rd_off(D0, 3, 0)>(vb), h3 = tr_read<v_rd_off(D0, 3, 1)>(vb);
    asm volatile("s_waitcnt lgkmcnt(0)" ::: "memory"); ATT_SBAR();
#define ATT_PK(L, H) (bf16x8){L[0], L[1], L[2], L[3], H[0], H[1], H[2], H[3]}
    od = __builtin_amdgcn_mfma_f32_32x32x16_bf16(pa0, ATT_PK(l0, h0), od, 0, 0, 0);
    od = __builtin_amdgcn_mfma_f32_32x32x16_bf16(pa1, ATT_PK(l1, h1), od, 0, 0, 0);
    od = __builtin_amdgcn_mfma_f32_32x32x16_bf16(pa2, ATT_PK(l2, h2), od, 0, 0, 0);
    od = __builtin_amdgcn_mfma_f32_32x32x16_bf16(pa3, ATT_PK(l3, h3), od, 0, 0, 0);
}
__device__ __forceinline__ void pv_d0(f32x16* o, int vb, bf16x8 pa0, bf16x8 pa1, bf16x8 pa2, bf16x8 pa3) {
    pv_one<0>(o[0], vb, pa0, pa1, pa2, pa3); pv_one<1>(o[1], vb, pa0, pa1, pa2, pa3); pv_one<2>(o[2], vb, pa0, pa1, pa2, pa3); pv_one<3>(o[3], vb, pa0, pa1, pa2, pa3);
}
template <int OFF> __device__ __forceinline__ bf16x8 k_read(int ka) { bf16x8 r; asm volatile("ds_read_b128 %0, %1 offset:%2" : "=&v"(r) : "v"(ka), "i"(OFF) : "memory"); return r; }
template <int N> __device__ __forceinline__ void lgk_wait() { asm volatile("s_waitcnt lgkmcnt(%0)" :: "n"(N) : "memory"); }
constexpr int CS_LA = 6;
template <int DQK, int KB, int VB, bool PV, int F> __device__ __forceinline__ void cs_read(bf16x8 (&kf)[CS_LA + 1], s16x4 (&vf)[CS_LA + 1][2], const int ka, const int vb) {
    constexpr int KROW = Cfg<DQK>::KROW, KO = KB * Cfg<DQK>::SHM_K, VO = VB * Cfg<DQK>::SHM_V, NMK = DQK / 8, NM = NMK + (PV ? 16 : 0);
    if constexpr (F < NMK) kf[F % (CS_LA + 1)] = k_read<KO + (F & 1) * 32 * KROW + (F / 2) * 32>(ka);
    else if constexpr (F < NM) { constexpr int v = F - NMK;
        vf[F % (CS_LA + 1)][0] = tr_read<VO + v_rd_off(v / 4, v % 4, 0)>(vb); vf[F % (CS_LA + 1)][1] = tr_read<VO + v_rd_off(v / 4, v % 4, 1)>(vb); }
}
template <int DQK, bool PV> constexpr int cs_outstanding(int I) {
    const int NMK = DQK / 8, NM = NMK + (PV ? 16 : 0); int n = 0;
    for (int f = I + 1; f <= I + CS_LA - 1 && f < NM; ++f) n += (f < NMK) ? 1 : 2;
    return n;
}
template <int DQK, int KB, int VB, bool PV, int I> __device__ __forceinline__ void cs_step(f32x16& p0, f32x16& p1, f32x16* o, const bf16x8* qr, bf16x8 (&kf)[CS_LA + 1], s16x4 (&vf)[CS_LA + 1][2], const int ka, const int vb, const bf16x8 (&pa)[4]) {
    constexpr int NMK = DQK / 8, NM = NMK + (PV ? 16 : 0);
    if constexpr (I < NM) {
        lgk_wait<cs_outstanding<DQK, PV>(I)>(); ATT_SBAR();
        if constexpr (I < NMK) { if constexpr ((I & 1) == 0) p0 = __builtin_amdgcn_mfma_f32_32x32x16_bf16(kf[I % (CS_LA + 1)], qr[I / 2], p0, 0, 0, 0); else p1 = __builtin_amdgcn_mfma_f32_32x32x16_bf16(kf[I % (CS_LA + 1)], qr[I / 2], p1, 0, 0, 0); }
        else { constexpr int v = I - NMK; o[v / 4] = __builtin_amdgcn_mfma_f32_32x32x16_bf16(pa[v % 4], ATT_PK(vf[I % (CS_LA + 1)][0], vf[I % (CS_LA + 1)][1]), o[v / 4], 0, 0, 0); }
        ATT_SBAR();
        cs_read<DQK, KB, VB, PV, I + CS_LA>(kf, vf, ka, vb);
    }
}
template <int DQK, int KB, int VB, bool PV>
__device__ __forceinline__ void c_segment(f32x16& p0, f32x16& p1, f32x16* o, const bf16x8* qr, const int ka, const int vb, const bf16x8 pa0, const bf16x8 pa1, const bf16x8 pa2, const bf16x8 pa3) {
    bf16x8 kf[CS_LA + 1]; s16x4 vf[CS_LA + 1][2]; const bf16x8 pa[4] = {pa0, pa1, pa2, pa3};
    __builtin_amdgcn_s_setprio(1);
    cs_read<DQK, KB, VB, PV, 0>(kf, vf, ka, vb); cs_read<DQK, KB, VB, PV, 1>(kf, vf, ka, vb); cs_read<DQK, KB, VB, PV, 2>(kf, vf, ka, vb); cs_read<DQK, KB, VB, PV, 3>(kf, vf, ka, vb);
    if constexpr (CS_LA > 4) cs_read<DQK, KB, VB, PV, 4>(kf, vf, ka, vb); if constexpr (CS_LA > 5) cs_read<DQK, KB, VB, PV, 5>(kf, vf, ka, vb); if constexpr (CS_LA > 6) cs_read<DQK, KB, VB, PV, 6>(kf, vf, ka, vb); if constexpr (CS_LA > 7) cs_read<DQK, KB, VB, PV, 7>(kf, vf, ka, vb);
    p0 = f32x16{}; p1 = f32x16{};
#define CS_S(i) cs_step<DQK, KB, VB, PV, i>(p0, p1, o, qr, kf, vf, ka, vb, pa)
    CS_S(0); CS_S(1); CS_S(2); CS_S(3); CS_S(4); CS_S(5); CS_S(6); CS_S(7); CS_S(8); CS_S(9); CS_S(10); CS_S(11); CS_S(12); CS_S(13); CS_S(14); CS_S(15); CS_S(16); CS_S(17); CS_S(18); CS_S(19);
    CS_S(20); CS_S(21); CS_S(22); CS_S(23); CS_S(24); CS_S(25); CS_S(26); CS_S(27); CS_S(28); CS_S(29); CS_S(30); CS_S(31); CS_S(32); CS_S(33); CS_S(34); CS_S(35); CS_S(36); CS_S(37); CS_S(38); CS_S(39);
#undef CS_S
    __builtin_amdgcn_s_setprio(0);
}
template <int DQK, int VB>
__device__ __forceinline__ void pv_segment(f32x16* o, const int vb, const bf16x8 pa0, const bf16x8 pa1, const bf16x8 pa2, const bf16x8 pa3) {
    constexpr int VO = VB * Cfg<DQK>::SHM_V;
    s16x4 vf[CS_LA + 1][2]; const bf16x8 pa[4] = {pa0, pa1, pa2, pa3};
#define PV_RD(v) do { if constexpr ((v) < 16) { vf[(v) % (CS_LA + 1)][0] = tr_read<VO + v_rd_off((v) / 4, (v) % 4, 0)>(vb); vf[(v) % (CS_LA + 1)][1] = tr_read<VO + v_rd_off((v) / 4, (v) % 4, 1)>(vb); } } while (0)
#define PV_S(v) do { lgk_wait<2 * (((v) + CS_LA - 1 < 16 ? (v) + CS_LA - 1 : 15) - (v))>(); ATT_SBAR(); \
    o[(v) / 4] = __builtin_amdgcn_mfma_f32_32x32x16_bf16(pa[(v) % 4], ATT_PK(vf[(v) % (CS_LA + 1)][0], vf[(v) % (CS_LA + 1)][1]), o[(v) / 4], 0, 0, 0); ATT_SBAR(); PV_RD((v) + CS_LA); } while (0)
    PV_RD(0); PV_RD(1); PV_RD(2); PV_RD(3); if constexpr (CS_LA > 4) PV_RD(4); if constexpr (CS_LA > 5) PV_RD(5); if constexpr (CS_LA > 6) PV_RD(6); if constexpr (CS_LA > 7) PV_RD(7);
    PV_S(0); PV_S(1); PV_S(2); PV_S(3); PV_S(4); PV_S(5); PV_S(6); PV_S(7); PV_S(8); PV_S(9); PV_S(10); PV_S(11); PV_S(12); PV_S(13); PV_S(14); PV_S(15);
#undef PV_RD
#undef PV_S
}
__device__ __forceinline__ void rope_pair(bf16x8& a, bf16x8& b, const float* cs, const float* sn) {
    const f32x4 c0 = *(const f32x4*)cs, c1 = *(const f32x4*)(cs + 4), s0 = *(const f32x4*)sn, s1 = *(const f32x4*)(sn + 4);
#pragma unroll
    for (int e = 0; e < 8; ++e) { const float c = e < 4 ? c0[e & 3] : c1[e & 3], s = e < 4 ? s0[e & 3] : s1[e & 3]; const float x1 = bf2f(a[e]), x2 = bf2f(b[e]);
        a[e] = f2bf(x1 * c - x2 * s); b[e] = f2bf(x2 * c + x1 * s); }
}

struct Unit {
    const bf16* Q;
    const bf16* Kn;
    const bf16* Kr;
    const bf16* V;
    int t0a, nta, t0b, ntb;
    int mask;
    int qpos0, kpos0;
    int has_sink; float sink;
    int rope;
    const float* tab;
    bf16* O;
};

template <int DQK, int SDEPTH, int LDQ, int LDKN, int LDKR, int LDV, int LDO, int VAR = 0>
__device__ __forceinline__ void attn_unit(const Unit& U, char* lds, const float scale, const int tid) {
    using C_ = Cfg<DQK>;
    constexpr int KROW = C_::KROW, SHM_V = C_::SHM_V, SHM_K = C_::SHM_K, ND = DQK / 16;
    const float C = scale * 1.4426950408889634f, TS = THR / scale;
    const int wid = __builtin_amdgcn_readfirstlane(tid >> 6), lane = tid & 63, r32 = lane & 31, hi = lane >> 5;
    char* V_lds = lds + C_::OFF_V; char* K_lds = lds + C_::OFF_K;
    float* ws = (float*)(lds + C_::OFF_WS) + wid * 64; float* li_l = ws; float* al_l = ws + 32;
    float m_reg = -1e30f, l_reg = 0; f32x16 o[4] = {}; bf16x8 qr[ND];
    const int sr = tid >> 4, sc = (tid & 15) * 8, vst0 = v_st(sr, sc), vst1 = v_st(32 + sr, sc);
    const int kr_r = tid >> 3, kr_c = (tid & 7) * 8;
    const int vb0 = (int)(uintptr_t)V_lds + v_rd_base(lane), ka0 = (int)(uintptr_t)K_lds + r32 * KROW + hi * 16;
    bf16x8 vs0, vs1, ks0, ks1, kx;
    const int NT = U.nta + U.ntb;
#define ATT_TOK(j) ((j) < U.nta ? U.t0a + (j) * KVBLK : U.t0b + ((j) - U.nta) * KVBLK)
    const unsigned offV = (unsigned)(sr * LDV + sc) * 2u, offK = (unsigned)(sr * LDKN + sc) * 2u, offR = (unsigned)(kr_r * LDKR + kr_c) * 2u;
#define ATT_LOADV(j) do { const long tk = ATT_TOK(j); const char* vb_ = (const char*)(U.V + tk * LDV); \
    vs0 = *reinterpret_cast<const bf16x8*>(vb_ + offV); vs1 = *reinterpret_cast<const bf16x8*>(vb_ + (size_t)(32 * LDV * 2) + offV); } while (0)
#define ATT_LOADK(j) do { const long tk = ATT_TOK(j); const char* kb_ = (const char*)(U.Kn + tk * LDKN); \
    ks0 = *reinterpret_cast<const bf16x8*>(kb_ + offK); ks1 = *reinterpret_cast<const bf16x8*>(kb_ + (size_t)(32 * LDKN * 2) + offK); \
    if constexpr (DQK == 192) { const char* rb_ = (const char*)(U.Kr + tk * LDKR); kx = *reinterpret_cast<const bf16x8*>(rb_ + offR); } } while (0)
#define ATT_WRITEV(b) do { *(bf16x8*)(V_lds + (b) * SHM_V + vst0) = vs0; *(bf16x8*)(V_lds + (b) * SHM_V + vst1) = vs1; } while (0)
#define ATT_WRITEK(b) do { *(bf16x8*)(K_lds + (b) * SHM_K + sr * KROW + sc * 2) = ks0; *(bf16x8*)(K_lds + (b) * SHM_K + (32 + sr) * KROW + sc * 2) = ks1; \
    if constexpr (DQK == 192) *(bf16x8*)(K_lds + (b) * SHM_K + kr_r * KROW + (128 + kr_c) * 2) = kx; } while (0)
#define ATT_VWAIT() asm volatile("s_waitcnt vmcnt(0)" ::: "memory")
#define ATT_RESC(a) do { if (__any((a) < 1.f)) { if (hi == 0) al_l[r32] = (a); asm volatile("s_waitcnt lgkmcnt(0)" ::: "memory"); \
    _Pragma("unroll") for (int d = 0; d < 4; ++d) _Pragma("unroll") for (int r = 0; r < 16; ++r) o[d][r] *= al_l[crow(r, hi)]; } } while (0)
    const int qpos = U.qpos0 + wid * QBLK + r32;
#define ATT_MASK(P0, P1, j) do { if (U.mask && (j) < U.nta) { const int kb = U.kpos0 + (j) * KVBLK + 4 * hi - qpos; \
    _Pragma("unroll") for (int r = 0; r < 16; ++r) { const int dk = kb + (r & 3) + 8 * (r >> 2); \
        if (dk > 128 || dk < -128) P0[r] = -INFINITY; if (dk + 32 > 128 || dk + 32 < -128) P1[r] = -INFINITY; } } } while (0)
#define ATT_SEAM() do { ATT_SBAR(); __syncthreads(); ATT_SBAR(); } while (0)
#define ATT_L(j) do { if constexpr ((VAR & 1) != 0) { ATT_PK4(p0, 0, pa0); ATT_PK4(p0, 8, pa1); ATT_PK4(p1, 0, pa2); ATT_PK4(p1, 8, pa3); } else { \
    ATT_MASK(p0, p1, j); partialSM(p0, p1, m_reg, mn, al, C, TS); finishSM(p0, p1, al, l_reg, pa0, pa1, pa2, pa3); ATT_RESC(al); } } while (0)
    ATT_LOADK(0); ATT_LOADV(0);
    const bf16* Qw = U.Q + (long)(wid * QBLK + r32) * LDQ + hi * 8;
#pragma unroll
    for (int d0 = 0; d0 < ND; ++d0) qr[d0] = *reinterpret_cast<const bf16x8*>(Qw + d0 * 16);
    if (U.rope) {
        const int n = U.qpos0 + wid * QBLK + r32, prow = n >> 6, pcol = n & 63;
        if constexpr (DQK == 128) {
            const float* cr = U.tab + prow * 32 + hi * 8; const float* cc = U.tab + pcol * 32 + hi * 8;
            rope_pair(qr[0], qr[2], cr, cr + 2048); rope_pair(qr[1], qr[3], cr + 16, cr + 16 + 2048);
            rope_pair(qr[4], qr[6], cc, cc + 2048); rope_pair(qr[5], qr[7], cc + 16, cc + 16 + 2048);
        } else {
            const float* cr = U.tab + prow * 16 + hi * 8; const float* cc = U.tab + pcol * 16 + hi * 8;
            rope_pair(qr[8], qr[9], cr, cr + 1024); rope_pair(qr[10], qr[11], cc, cc + 1024);
        }
    }
    f32x16 p0, p1; float mn, al; bf16x8 pa0, pa1, pa2, pa3;
    ATT_VWAIT(); ATT_WRITEK(0); ATT_LOADK(1);
    ATT_SEAM();
#define ATT_LOADK_L(j) do { if constexpr ((VAR & 2) == 0) ATT_LOADK(j); } while (0)
#define ATT_LOADV_L(j) do { if constexpr ((VAR & 2) == 0) ATT_LOADV(j); } while (0)
    if (wid >= 4) __builtin_amdgcn_s_barrier();
    ATT_SBAR();
    c_segment<DQK, 0, 0, false>(p0, p1, o, qr, ka0, vb0, pa0, pa1, pa2, pa3);
    if constexpr ((VAR & 4) == 0) { ATT_VWAIT(); ATT_WRITEK(1); ATT_WRITEV(0); }
    if (2 < NT) ATT_LOADK_L(2); ATT_LOADV_L(1);
    ATT_SEAM(); ATT_L(0); ATT_SEAM();
    for (int j = 1; j + 1 < NT; j += 2) {
        c_segment<DQK, 1, 0, true>(p0, p1, o, qr, ka0, vb0, pa0, pa1, pa2, pa3);
        if constexpr ((VAR & 4) == 0) { ATT_VWAIT(); ATT_WRITEK(0); ATT_WRITEV(1); }
        ATT_LOADK_L(j + 2); ATT_LOADV_L(j + 1);
        ATT_SEAM(); ATT_L(j); ATT_SEAM();
        c_segment<DQK, 0, 1, true>(p0, p1, o, qr, ka0, vb0, pa0, pa1, pa2, pa3);
        if constexpr ((VAR & 4) == 0) { ATT_VWAIT(); ATT_WRITEK(1); ATT_WRITEV(0); }
        if (j + 3 < NT) ATT_LOADK_L(j + 3); ATT_LOADV_L(j + 2);
        ATT_SEAM(); ATT_L(j + 1); ATT_SEAM();
    }
    c_segment<DQK, 1, 0, true>(p0, p1, o, qr, ka0, vb0, pa0, pa1, pa2, pa3);
    if constexpr ((VAR & 4) == 0) { ATT_VWAIT(); ATT_WRITEV(1); }
    ATT_SEAM(); ATT_L(NT - 1); ATT_SEAM();
    pv_segment<DQK, 1>(o, vb0, pa0, pa1, pa2, pa3);
    ATT_SBAR();
    if (wid < 4) __builtin_amdgcn_s_barrier();
    ATT_SBAR();
    if (U.has_sink) l_reg += __builtin_amdgcn_exp2f(U.sink * 1.4426950408889634f - m_reg * C);
    if (hi == 0) li_l[r32] = l_reg; asm volatile("s_waitcnt lgkmcnt(0)" ::: "memory");
    float rli[16];
#pragma unroll
    for (int r = 0; r < 16; ++r) rli[r] = __builtin_amdgcn_rcpf(li_l[crow(r, hi)]);
    bf16* Ow = U.O + (long)(wid * QBLK) * LDO;
#pragma unroll
    for (int r = 0; r < 16; ++r) { const int orow = crow(r, hi);
#pragma unroll
        for (int d0 = 0; d0 < 4; ++d0) Ow[(long)orow * LDO + d0 * 32 + r32] = (bf16)cvtpk(o[d0][r] * rli[r], 0.f); }
    __syncthreads();
#undef ATT_TOK
#undef ATT_LOADV
#undef ATT_LOADK
#undef ATT_WRITEV
#undef ATT_WRITEK
#undef ATT_VWAIT
#undef ATT_RESC
#undef ATT_MASK
#undef ATT_SEAM
#undef ATT_L
#undef ATT_LOADK_L
#undef ATT_LOADV_L
}
}

namespace gla {
using att::bf16; using att::bf16x8; using att::s16x4; using att::f32x16; using att::f32x4; using att::u32x4; using att::crow; using att::cvtpk; using att::bf2f; using att::f2bf;
constexpr int ROWB = 144;
constexpr int T_QI = 0, T_KI = 64 * ROWB, T_KIT = 2 * 64 * ROWB, T_V = 3 * 64 * ROWB  , T_BYTES = T_V + 16384  ;
constexpr int OFF_ST = 2 * T_BYTES  , OFF_DEC = OFF_ST + 128 * ROWB  , BYTES = OFF_DEC + 2 * 256;
static_assert(T_V % 16 == 0 && T_BYTES % 16 == 0 && OFF_ST % 16 == 0 && BYTES <= 131072, "gla LDS map");
struct Unit {
    const bf16* P; int ldp;
    const float* wg; const float* bg;
    bf16* og;
    int b, h, dir;
};
__device__ __forceinline__ float log_sigmoid(float z) { return fminf(z, 0.f) - __logf(1.f + __expf(-fabsf(z))); }
template <int CTRL, int ROWMASK> __device__ __forceinline__ float dpp_add(float v) { return v + __int_as_float(__builtin_amdgcn_update_dpp(0, __float_as_int(v), CTRL, ROWMASK, 0xf, false)); }
__device__ __forceinline__ float wave_prefix(float v) {
    v = dpp_add<0x111, 0xf>(v); v = dpp_add<0x112, 0xf>(v); v = dpp_add<0x114, 0xf>(v); v = dpp_add<0x118, 0xf>(v);
    v = dpp_add<0x142, 0xa>(v);
    v = dpp_add<0x143, 0xc>(v);
    return v;
}

__device__ __forceinline__ void gla_unit(const Unit& U, char* lds, const int tid) {
    const int wid = __builtin_amdgcn_readfirstlane(tid >> 6), lane = tid & 63, r32 = lane & 31, hi = lane >> 5;
    const int h = U.h, dir = U.dir;
    for (int i = tid; i < 128 * ROWB / 4; i += 512) ((unsigned*)(lds + OFF_ST))[i] = 0u;
#define GLA_TB(s) ((s) < 4 ? NLAT + U.b * CTX + 64 * (dir ? 3 - (s) : (s)) : U.b * SEQ + 64 * (dir ? 67 - (s) : (s) - 4))
#define GLA_TOK(tb, i) ((long)((tb) + (dir ? 63 - (i) : (i))))
    if (wid < 4) {
        typedef short s16x4v __attribute__((ext_vector_type(4)));
        const int w = wid, pt = tid, t16 = lane & 15, dq = lane >> 4;
        s16x4v wa; f32x4 bias4;
#pragma unroll
        for (int e = 0; e < 4; ++e) { wa[e] = f2bf(U.wg[(4 * dq + e) * 256 + h * 64 + 16 * w + t16]); bias4[e] = U.bg[h * 64 + 16 * w + 4 * dq + e]; }
        s16x4v qr_[4], kr_[4], gr_[4]; bf16x8 vv[4];
#define GLA_LOAD(s) do { const int tb_ = GLA_TB(s); \
    _Pragma("unroll") for (int b4 = 0; b4 < 4; ++b4) { const bf16* row = U.P + GLA_TOK(tb_, 16 * b4 + t16) * U.ldp; \
        qr_[b4] = *reinterpret_cast<const s16x4v*>(row + C_GQ + h * 64 + 16 * w + 4 * dq); kr_[b4] = *reinterpret_cast<const s16x4v*>(row + C_GK + h * 64 + 16 * w + 4 * dq); \
        gr_[b4] = *reinterpret_cast<const s16x4v*>(row + C_GLR + dir * 16 + 4 * dq); } \
    _Pragma("unroll") for (int c_ = 0; c_ < 4; ++c_) { const int ch = pt + 256 * c_; vv[c_] = *reinterpret_cast<const bf16x8*>(U.P + GLA_TOK(tb_, ch >> 4) * U.ldp + C_GV + h * 128 + (ch & 15) * 8); } } while (0)
#define GLA_PREP(buf) do { char* T = lds + (buf) * T_BYTES; \
    f32x4 carry = {0.f, 0.f, 0.f, 0.f}; \
    _Pragma("unroll") for (int b4 = 0; b4 < 4; ++b4) { const int irow = 16 * b4 + t16; \
        f32x4 z = __builtin_amdgcn_mfma_f32_16x16x16bf16_1k(wa, gr_[b4], bias4, 0, 0, 0);            \
        s16x4v qo, ko; \
        _Pragma("unroll") for (int r = 0; r < 4; ++r) { float v = log_sigmoid(z[r]) * (1.f / 16.f); \
            v = dpp_add<0x111, 0xf>(v); v = dpp_add<0x112, 0xf>(v); v = dpp_add<0x114, 0xf>(v); v = dpp_add<0x118, 0xf>(v);     \
            v += carry[r]; carry[r] = __int_as_float(__builtin_amdgcn_ds_swizzle(__float_as_int(v), 0x1F0));                    \
            const short ks = f2bf(bf2f(kr_[b4][r]) * __expf(-v)); \
            qo[r] = f2bf(bf2f(qr_[b4][r]) * 0.125f * __expf(v)); ko[r] = ks; \
            *(short*)(T + T_KIT + (16 * w + 4 * dq + r) * ROWB + irow * 2) = ks; } \
        *(s16x4v*)(T + T_QI + irow * ROWB + (16 * w + 4 * dq) * 2) = qo; *(s16x4v*)(T + T_KI + irow * ROWB + (16 * w + 4 * dq) * 2) = ko; } \
    if (t16 == 0) { f32x4 dv; _Pragma("unroll") for (int r = 0; r < 4; ++r) dv[r] = __expf(carry[r]); *(f32x4*)(lds + OFF_DEC + (buf) * 256 + (16 * w + 4 * dq) * 4) = dv; } \
    _Pragma("unroll") for (int c_ = 0; c_ < 4; ++c_) { const int ch = pt + 256 * c_; *(bf16x8*)(T + T_V + att::v_st(ch >> 4, (ch & 15) * 8)) = vv[c_]; } } while (0)
        GLA_LOAD(0); GLA_PREP(0); GLA_LOAD(1);
        __syncthreads();
        for (int s = 0; s < 68; ++s) {
            if (s + 1 < 68) { GLA_PREP((s + 1) & 1); if (s + 2 < 68) GLA_LOAD(s + 2); }
            __syncthreads();
            __syncthreads();
        }
#undef GLA_LOAD
#undef GLA_PREP
    } else {
        const int m = wid - 4, rh = m & 1, ebp = m >> 1;
        f32x16 S0 = {}, S1 = {};
        __syncthreads();
        for (int s = 0; s < 68; ++s) {
            const int tb = GLA_TB(s); const char* T = lds + (s & 1) * T_BYTES; const float* DEC = (const float*)(lds + OFF_DEC + (s & 1) * 256);
            const int vb = (int)(uintptr_t)(T + T_V) + att::v_rd_base(lane) + (2 * ebp) * 512;
            bf16x8 qf[4];
#pragma unroll
            for (int d0 = 0; d0 < 4; ++d0) qf[d0] = *reinterpret_cast<const bf16x8*>(T + T_QI + (rh * 32 + r32) * ROWB + (d0 * 16 + hi * 8) * 2);
            f32x16 p0 = {}, p1 = {};
#pragma unroll
            for (int d0 = 0; d0 < 4; ++d0) { const int cb = (d0 * 16 + hi * 8) * 2;
                const bf16x8 ka = *reinterpret_cast<const bf16x8*>(T + T_KI + r32 * ROWB + cb), kb = *reinterpret_cast<const bf16x8*>(T + T_KI + (32 + r32) * ROWB + cb);
                p0 = __builtin_amdgcn_mfma_f32_32x32x16_bf16(ka, qf[d0], p0, 0, 0, 0); p1 = __builtin_amdgcn_mfma_f32_32x32x16_bf16(kb, qf[d0], p1, 0, 0, 0); }
            { const int irow = rh * 32 + r32 - dir;
#pragma unroll
              for (int r = 0; r < 16; ++r) { const int mm = crow(r, hi); if (mm > irow) p0[r] = 0.f; if (mm + 32 > irow) p1[r] = 0.f; } }
            bf16x8 pa0, pa1, pa2, pa3;
            ATT_PK4(p0, 0, pa0); ATT_PK4(p0, 8, pa1); ATT_PK4(p1, 0, pa2); ATT_PK4(p1, 8, pa3);
            bf16x8 kf[4];
#pragma unroll
            for (int ks = 0; ks < 4; ++ks) kf[ks] = *reinterpret_cast<const bf16x8*>(T + T_KIT + (rh * 32 + r32) * ROWB + (ks * 16 + hi * 8) * 2);
            float dec[16];
#pragma unroll
            for (int r = 0; r < 16; ++r) dec[r] = DEC[rh * 32 + crow(r, hi)];
#pragma unroll
            for (int eb2 = 0; eb2 < 2; ++eb2) { const int eb = 2 * ebp + eb2;
                f32x16 o = {};
                att::pv_one<0>(o, vb + eb2 * 512, pa0, pa1, pa2, pa3);
#pragma unroll
                for (int d0 = 0; d0 < 4; ++d0) { const bf16x8 sf = *reinterpret_cast<const bf16x8*>(lds + OFF_ST + (eb * 32 + r32) * ROWB + (d0 * 16 + hi * 8) * 2);
                    o = __builtin_amdgcn_mfma_f32_32x32x16_bf16(qf[d0], sf, o, 0, 0, 0); }
#pragma unroll
                for (int r = 0; r < 16; ++r) U.og[GLA_TOK(tb, rh * 32 + crow(r, hi)) * 512 + h * 128 + eb * 32 + r32] = (bf16)f2bf(o[r]);
                if (eb2 == 0) { att::pv_one<0>(S0, vb, kf[0], kf[1], kf[2], kf[3]);
#pragma unroll
                    for (int r = 0; r < 16; ++r) S0[r] *= dec[r]; }
                else { att::pv_one<0>(S1, vb + 512, kf[0], kf[1], kf[2], kf[3]);
#pragma unroll
                    for (int r = 0; r < 16; ++r) S1[r] *= dec[r]; }
            }
            __syncthreads();
#pragma unroll
            for (int g = 0; g < 4; ++g) { uint2 wv; wv.x = cvtpk(S0[4 * g], S0[4 * g + 1]); wv.y = cvtpk(S0[4 * g + 2], S0[4 * g + 3]);
                *(uint2*)(lds + OFF_ST + ((2 * ebp) * 32 + r32) * ROWB + (rh * 32 + 8 * g + 4 * hi) * 2) = wv;
                uint2 wu; wu.x = cvtpk(S1[4 * g], S1[4 * g + 1]); wu.y = cvtpk(S1[4 * g + 2], S1[4 * g + 3]);
                *(uint2*)(lds + OFF_ST + ((2 * ebp + 1) * 32 + r32) * ROWB + (rh * 32 + 8 * g + 4 * hi) * 2) = wu; }
            __syncthreads();
        }
    }
    __syncthreads();
#undef GLA_TB
#undef GLA_TOK
}
}

constexpr size_t MiB = 1u << 20;
constexpr size_t WS_CTL = 0, CTL_BYTES = 1 * MiB;
constexpr size_t WS_SSQ = 1 * MiB;
constexpr size_t MOD_BYTES = (size_t)DEPTH * 9 * NMOD * D_MODEL * 4;
constexpr size_t ZERO_BYTES = 3 * MiB;
static_assert(WS_SSQ + (size_t)DEPTH * 2 * NTOK * 4 <= ZERO_BYTES, "zeroed region");
constexpr size_t WS_TAB = 3 * MiB;
constexpr size_t WS_RSTD = WS_TAB + 64 * 1024;
constexpr size_t WS_W = 4 * MiB;
constexpr size_t W_IN = 0, W_UQKV = W_IN + (size_t)IN_WP * D_MODEL * 2, W_OUT = W_UQKV + (size_t)(UQ_WP + UKV_W) * 512 * 2, W_GU = W_OUT + (size_t)D_MODEL * D_MODEL * 2,
                 W_DOWN = W_GU + (size_t)2 * FFN * D_MODEL * 2, W_LAYER = W_DOWN + (size_t)D_MODEL * FFN * 2;
constexpr size_t WS_H = WS_W + DEPTH * W_LAYER;
constexpr size_t WS_MIX = WS_H + (size_t)NTOK * D_MODEL * 2;
constexpr size_t WS_XC = WS_MIX + (size_t)NTOK * D_MODEL * 2;
constexpr size_t WS_R1 = WS_XC + (size_t)NCTX * D_MODEL * 4;
constexpr size_t WS_P = WS_R1, WS_Q = WS_P + (size_t)NTOK * IN_WP * 2, WS_KV = WS_Q + (size_t)NTOK * UQ_WP * 2, WS_GOF = WS_KV + (size_t)NTOK * UKV_W * 2,
                 WS_GOB = WS_GOF + (size_t)NTOK * 512 * 4, WS_R1_END = WS_GOB + (size_t)NTOK * 512 * 4;
constexpr size_t WS_ACT = WS_R1;
static_assert(WS_ACT + (size_t)NTOK * FFN * 2 <= WS_R1_END, "ACT overlay fits");
constexpr size_t WS_PART = WS_R1_END;
constexpr size_t WS_XS = WS_PART + (size_t)4 * NCTX * D_MODEL * 4;
constexpr size_t WS_MODX = WS_XS + 2 * MiB;
constexpr size_t WS_END = WS_MODX + 2 * MiB;
static_assert(W_LAYER % 256 == 0 && WS_H % 256 == 0 && WS_R1 % 256 == 0 && WS_Q % 256 == 0 && WS_KV % 256 == 0 && WS_GOF % 256 == 0, "alignment");
constexpr int CW_BAR = 4096;
constexpr int CW_PANEL = 32768;
constexpr int CW_QUEUE = 16384;
constexpr int RING_BYTES = 131072, LDSCTL_OFF = RING_BYTES, LDS_BYTES = 147456;

#define GAS __attribute__((address_space(1)))
#define LAS __attribute__((address_space(3)))
typedef unsigned short bf16;
typedef unsigned v4u __attribute__((ext_vector_type(4)));
typedef unsigned v2u __attribute__((ext_vector_type(2)));
typedef float f32x4 __attribute__((ext_vector_type(4)));
#define LDS_WAIT() asm volatile("s_waitcnt lgkmcnt(0)" ::: "memory")
__device__ __forceinline__ unsigned f2bf(float f) { unsigned u = __builtin_bit_cast(unsigned, f); return (u + 0x7fffu + ((u >> 16) & 1u)) >> 16; }
__device__ __forceinline__ unsigned pk2(float lo, float hi) { return f2bf(lo) | (f2bf(hi) << 16); }
__device__ __forceinline__ float bflo(unsigned w) { return __uint_as_float(w << 16); }
__device__ __forceinline__ float bfhi(unsigned w) { return __uint_as_float(w & 0xffff0000u); }
template <int O> __device__ __forceinline__ float swz_xor(float v) { return __int_as_float(__builtin_amdgcn_ds_swizzle(__float_as_int(v), (O << 10) | 0x1f)); }
__device__ __forceinline__ float sum16(float v) { v += swz_xor<1>(v); v += swz_xor<2>(v); v += swz_xor<4>(v); v += swz_xor<8>(v); return v; }
__device__ __forceinline__ float sum32(float v) { v = sum16(v); v += swz_xor<16>(v); return v; }
__device__ __forceinline__ float wave_sum(float v) { v = sum32(v); auto rr = __builtin_amdgcn_permlane32_swap(__float_as_uint(v), __float_as_uint(v), false, false); return __uint_as_float(rr[0]) + __uint_as_float(rr[1]); }

#define XB_TMO      128
#define XB_XCNT(j)  (256  + 64 * (j))
#define XB_XSUB(j)  (1280 + 64 * (j))
#define XB_XGEN(j)  (2304 + 64 * (j))
#define XB_TOP      3328
#define XB_TOPGEN   3392
#define XCD_BAR_WORDS 3456
#define XB_SPIN_CAP (1u << 21)
__device__ __forceinline__ unsigned xb_ld(unsigned* p)              { return __hip_atomic_load(p, __ATOMIC_RELAXED, __HIP_MEMORY_SCOPE_AGENT); }
__device__ __forceinline__ unsigned xb_add(unsigned* p, unsigned v) { return __hip_atomic_fetch_add(p, v, __ATOMIC_RELAXED, __HIP_MEMORY_SCOPE_AGENT); }
__device__ __forceinline__ unsigned xb_xcc_id() { return (unsigned)__builtin_amdgcn_s_getreg((3 << 11) | 20) & 0xFu; }
#define XB_SPIN(cond, bar) do { unsigned _sp = 0; while (cond) { __builtin_amdgcn_s_sleep(1); \
    if ((++_sp & 255u) == 0u) { if (xb_ld(&(bar)[XB_TMO])) break; if (_sp > XB_SPIN_CAP) { atomicAdd(&(bar)[XB_TMO], 1u); break; } } } } while (0)
struct XcdBarrier { unsigned* bar; unsigned x; volatile LAS unsigned* st; };
__device__ __forceinline__ XcdBarrier xcd_barrier_post(unsigned* bar, volatile LAS unsigned* st) {
    XcdBarrier b; b.bar = bar; b.x = xb_xcc_id(); b.st = st;
    if (threadIdx.x == 0) (void)xb_add(&bar[XB_XCNT(b.x)], 1u);
    return b;
}
__device__ __forceinline__ void xcd_barrier_complete(unsigned* bar, unsigned x, unsigned& nloc, unsigned& nx) {
    const unsigned G = gridDim.x * gridDim.y * gridDim.z;
    unsigned sum, cnt, mine, sp = 0u;
    for (;;) {
        sum = 0u; cnt = 0u; mine = 0u;
#pragma unroll
        for (unsigned j = 0; j < 16; ++j) { const unsigned c = xb_ld(&bar[XB_XCNT(j)]); sum += c; cnt += (c > 0u) ? 1u : 0u; mine = (j == x) ? c : mine; }
        if (sum == G) break;
        __builtin_amdgcn_s_sleep(1);
        if ((++sp & 255u) == 0u) { if (xb_ld(&bar[XB_TMO])) break; if (sp > XB_SPIN_CAP) { atomicAdd(&bar[XB_TMO], 1u); break; } }
    }
    nloc = mine > 0u ? mine : 1u; nx = cnt > 0u ? cnt : 1u;
}
__device__ __forceinline__ void xcd_barrier(const XcdBarrier& b) {
    asm volatile("s_waitcnt vmcnt(0)" ::: "memory");
    __syncthreads();
    if (threadIdx.x == 0) {
        unsigned* bar = b.bar;
        const unsigned bx_ = (unsigned)__builtin_amdgcn_readfirstlane((int)xb_xcc_id());
        __builtin_amdgcn_s_waitcnt(0);
        unsigned nloc = b.st[0], nx = b.st[1];
        if (nloc == 0u) { xcd_barrier_complete(bar, bx_, nloc, nx); b.st[0] = nloc; b.st[1] = nx; }
        const unsigned old = xb_add(&bar[XB_XSUB(bx_)], 1u);
        const unsigned gen = old / nloc;
        if (old + 1u == (gen + 1u) * nloc) {
            __builtin_amdgcn_fence(__ATOMIC_RELEASE, "agent");
            asm volatile("s_waitcnt vmcnt(0)" ::: "memory");
            const unsigned og = xb_add(&bar[XB_TOP], 1u);
            const unsigned tg = og / nx;
            if (og + 1u == (tg + 1u) * nx) xb_add(&bar[XB_TOPGEN], 1u);
            else XB_SPIN(xb_ld(&bar[XB_TOPGEN]) == tg, bar);
            __builtin_amdgcn_fence(__ATOMIC_ACQUIRE, "agent");
            xb_add(&bar[XB_XGEN(bx_)], 1u);
            asm volatile("s_waitcnt vmcnt(0)" ::: "memory");
        } else {
            XB_SPIN(xb_ld(&bar[XB_XGEN(bx_)]) == gen, bar);
            __builtin_amdgcn_fence(__ATOMIC_ACQUIRE, "agent");
            asm volatile("s_waitcnt vmcnt(0)" ::: "memory");
        }
    }
    __syncthreads();
}

constexpr int NWAVES = 8;
struct Ptrs {
    const float *x, *c, *ctx, *c_ctx, *w_mod, *b_mod, *g_mix, *g_ffn, *w_in, *g_mla_q, *g_mla_kv, *w_mla_uq, *w_mla_ukv, *swa_sink, *w_gate_f, *b_gate_f, *w_gate_b, *b_gate_b, *g_gla_out,
                *w_out, *w_ffn_gu, *w_ffn_down, *g_final;
    float* out; unsigned char* ws;
};

template <bool INMAP = false>
__device__ __forceinline__ void transpose_item(const float* W, int K, int N, bf16* WT, int drow0, int k0, int n0, const float* kscale, LAS float* scr, int lane) {
    const int kk = lane >> 3, n4 = (lane & 7) * 4;
    f32x4 v[8];
#pragma unroll
    for (int i = 0; i < 8; ++i) v[i] = __builtin_nontemporal_load((const f32x4*)(W + (size_t)(k0 + 8 * i + kk) * N + n0 + n4));
#pragma unroll
    for (int i = 0; i < 8; ++i) { const int k = 8 * i + kk; f32x4 x = v[i]; if (kscale) x = x * kscale[k0 + k];
        scr[k * 33 + n4] = x.x; scr[k * 33 + n4 + 1] = x.y; scr[k * 33 + n4 + 2] = x.z; scr[k * 33 + n4 + 3] = x.w; }
    LDS_WAIT(); asm volatile("" ::: "memory");
    const int c = lane & 7;
#pragma unroll
    for (int j = 0; j < 4; ++j) { const int n = (lane >> 3) + 8 * j; const LAS float* s = scr + (8 * c) * 33 + n;
        v4u o; o.x = pk2(s[0 * 33], s[1 * 33]); o.y = pk2(s[2 * 33], s[3 * 33]); o.z = pk2(s[4 * 33], s[5 * 33]); o.w = pk2(s[6 * 33], s[7 * 33]);
        const int drow = INMAP ? pg8::w_in_row(drow0 + n) : drow0 + n;
        *(GAS v4u*)(WT + (size_t)drow * K + k0 + 8 * c) = o; }
    LDS_WAIT(); asm volatile("" ::: "memory");
}
constexpr int TI_IN = 32 * 123, TI_UQ = 8 * 36, TI_UKV = 8 * 48, TI_OUT = 32 * 64, TI_GU = 32 * 352, TI_DOWN = 88 * 64, TI_LAYER = TI_IN + TI_UQ + TI_UKV + TI_OUT + TI_GU + TI_DOWN, TI_EARLY = TI_IN + TI_UQ + TI_UKV;

__device__ __forceinline__ void sincos_d(double a, double& s, double& c) {
    const double TWO_PI = 6.283185307179586476925287, INV = 0.15915494309189533576888;
    const double k = __builtin_rint(a * INV); const double r = a - k * TWO_PI, r2 = r * r;
    double ts = 1.0, tc = 1.0;
#pragma unroll
    for (int n = 12; n >= 1; --n) { ts = 1.0 - ts * r2 / (double)((2 * n) * (2 * n + 1)); tc = 1.0 - tc * r2 / (double)((2 * n - 1) * (2 * n)); }
    s = r * ts; c = tc;
}

__device__ __forceinline__ void norm_rows(const float* xl, const float* xc, int M, bf16* H, const float* g, const float* modl, int ch_shift, int ch_scale, int gw, int NGW, int lane, const float* part, float* xc_out, int row_begin) {
    for (int row = row_begin + 2 * gw; row < M; row += 2 * NGW) {
        const bool lat = row < NLAT; const int gi = lat ? (row >> 12) : BATCH;
        const float* xr = lat ? xl + (size_t)row * D_MODEL : xc + (size_t)(row - NLAT) * D_MODEL;
        const float* sh = modl + (size_t)gi * (NMOD * D_MODEL) + ch_shift * D_MODEL; const float* sc = modl + (size_t)gi * (NMOD * D_MODEL) + ch_scale * D_MODEL;
        f32x4 v[2][8]; float ss[2] = {0.f, 0.f};
#pragma unroll
        for (int r = 0; r < 2; ++r)
#pragma unroll
            for (int j = 0; j < 8; ++j) v[r][j] = *(const f32x4*)(xr + (size_t)r * D_MODEL + 4 * lane + 256 * j);
        if (!lat && part) {
#pragma unroll
            for (int r = 0; r < 2; ++r) { const float* pr = part + (size_t)(row + r - NLAT) * D_MODEL + 4 * lane; float* xo = xc_out + (size_t)(row + r - NLAT) * D_MODEL + 4 * lane;
#pragma unroll
                for (int j = 0; j < 8; ++j) { const f32x4 p0 = *(const f32x4*)(pr + 256 * j), p1 = *(const f32x4*)(pr + (size_t)NCTX * D_MODEL + 256 * j), p2 = *(const f32x4*)(pr + (size_t)2 * NCTX * D_MODEL + 256 * j), p3 = *(const f32x4*)(pr + (size_t)3 * NCTX * D_MODEL + 256 * j);
                    v[r][j] = v[r][j] + ((p0 + p1) + (p2 + p3)); *(f32x4*)(xo + 256 * j) = v[r][j]; } }
        }
#pragma unroll
        for (int r = 0; r < 2; ++r)
#pragma unroll
            for (int j = 0; j < 8; ++j) ss[r] += (v[r][j].x * v[r][j].x + v[r][j].y * v[r][j].y) + (v[r][j].z * v[r][j].z + v[r][j].w * v[r][j].w);
        const float rstd0 = 1.f / sqrtf(wave_sum(ss[0]) * (1.f / D_MODEL) + EPS), rstd1 = 1.f / sqrtf(wave_sum(ss[1]) * (1.f / D_MODEL) + EPS);
        bf16* hr = H + (size_t)row * D_MODEL;
#pragma unroll
        for (int j = 0; j < 8; ++j) { const int col = 4 * lane + 256 * j; const f32x4 gv = *(const f32x4*)(g + col), sv = *(const f32x4*)(sc + col), hv = *(const f32x4*)(sh + col);
            const f32x4 gs = gv * (sv + 1.f);
            const f32x4 y0 = (v[0][j] * rstd0) * gs + hv, y1 = (v[1][j] * rstd1) * gs + hv;
            v2u o0; o0.x = pk2(y0.x, y0.y); o0.y = pk2(y0.z, y0.w); *(v2u*)(hr + col) = o0;
            v2u o1; o1.x = pk2(y1.x, y1.y); o1.y = pk2(y1.z, y1.w); *(v2u*)(hr + D_MODEL + col) = o1; }
    }
}
#ifndef DUP_G5
#define DUP_G5 1
#endif
#ifndef ACT_TILED
#define ACT_TILED 1
#endif
#ifndef EN_CONV
#define EN_CONV 1
#endif
#ifndef FUSE_NORM
#define FUSE_NORM 1
#endif
#ifndef BURN_MFMA
#define BURN_MFMA 0
#endif
#ifndef WGM_G1
#define WGM_G1 4
#endif
#ifndef WGM_G2
#define WGM_G2 8
#endif
#ifndef WGM_G4
#define WGM_G4 4
#endif
#ifndef REV_G5
#define REV_G5 1
#endif
#ifndef WGM_RES
#define WGM_RES 4
#endif
#ifndef DUP_G5
#define DUP_G5 1
#endif
#ifndef STAG_ON
#define STAG_ON 0
#endif
#ifndef DUP_MLA
#define DUP_MLA 1
#endif
#ifndef DUP_SWA
#define DUP_SWA 1
#endif
#ifndef DUP_P0T
#define DUP_P0T 1
#endif
#ifndef DUP_N1
#define DUP_N1 1
#endif
#ifndef DUP_G1
#define DUP_G1 1
#endif
#ifndef DUP_G2
#define DUP_G2 1
#endif
#ifndef DUP_GLA
#define DUP_GLA 1
#endif
#ifndef DUP_GL2
#define DUP_GL2 1
#endif
#ifndef DUP_N2
#define DUP_N2 1
#endif
#ifndef DUP_G4
#define DUP_G4 1
#endif
#ifndef EN_P0
#define EN_P0 1
#endif
#ifndef EN_N1
#define EN_N1 1
#endif
#ifndef EN_G1
#define EN_G1 1
#endif
#ifndef EN_GL1
#define EN_GL1 1
#endif
#ifndef EN_G2
#define EN_G2 1
#endif
#ifndef EN_MIX
#define EN_MIX 1
#endif
#ifndef EN_GL2
#define EN_GL2 1
#endif
#ifndef HALVE_LAST
#define HALVE_LAST 1
#endif
#ifndef PROBE_ATT
#define PROBE_ATT 0
#endif
#ifndef PROBE_ATT_VAR
#define PROBE_ATT_VAR 0
#endif
#ifndef EN_G3
#define EN_G3 1
#endif
#ifndef EN_N2
#define EN_N2 1
#endif
#ifndef EN_G4
#define EN_G4 1
#endif
#ifndef EN_G5
#define EN_G5 1
#endif
#ifndef EN_GLA
#define EN_GLA 1
#endif
#ifndef EN_MLA
#define EN_MLA 1
#endif
#ifndef EN_SWA
#define EN_SWA 1
#endif
#define CONVERT_ITEM(lc, rr) do { const int cl_ = (lc); int r = (rr); \
            bf16* wl = (bf16*)(ws + WS_W + (size_t)cl_ * W_LAYER); \
            if (r < TI_IN) { const int kb = r / 123, nb = r % 123; transpose_item<true>(AP->w_in + (size_t)cl_ * D_MODEL * IN_W, D_MODEL, IN_W, (bf16*)((char*)wl + W_IN), 32 * nb, 64 * kb, 32 * nb, nullptr, scr, lane); break; } r -= TI_IN; \
            if (r < TI_UQ) { const int kb = r / 36, nb = r % 36; transpose_item(AP->w_mla_uq + (size_t)cl_ * 512 * UQ_W, 512, UQ_W, (bf16*)((char*)wl + W_UQKV), 32 * nb, 64 * kb, 32 * nb, AP->g_mla_q + cl_ * 512, scr, lane); break; } r -= TI_UQ; \
            if (r < TI_UKV) { const int kb = r / 48, nb = r % 48; transpose_item(AP->w_mla_ukv + (size_t)cl_ * 512 * UKV_W, 512, UKV_W, (bf16*)((char*)wl + W_UQKV), UQ_WP + 32 * nb, 64 * kb, 32 * nb, AP->g_mla_kv + cl_ * 512, scr, lane); break; } r -= TI_UKV; \
            if (r < TI_OUT) { const int kb = r / 64, nb = r % 64; transpose_item(AP->w_out + (size_t)cl_ * D_MODEL * D_MODEL, D_MODEL, D_MODEL, (bf16*)((char*)wl + W_OUT), 32 * nb, 64 * kb, 32 * nb, nullptr, scr, lane); break; } r -= TI_OUT; \
            if (r < TI_GU) { const int kb = r / 352, nb = r % 352; const int n0 = 32 * nb; const int j = n0 < FFN ? n0 : n0 - FFN; const int drow = (j >> 7) * 256 + (n0 < FFN ? 0 : 128) + (j & 127); \
                transpose_item(AP->w_ffn_gu + (size_t)cl_ * D_MODEL * 2 * FFN, D_MODEL, 2 * FFN, (bf16*)((char*)wl + W_GU), drow, 64 * kb, n0, nullptr, scr, lane); break; } r -= TI_GU; \
            { const int kb = r / 64, nb = r % 64; transpose_item(AP->w_ffn_down + (size_t)cl_ * FFN * D_MODEL, FFN, D_MODEL, (bf16*)((char*)wl + W_DOWN), 32 * nb, 64 * kb, 32 * nb, nullptr, scr, lane); } \
    } while (0)
__global__ void __launch_bounds__(NWAVES * 64, 2) fwd_kernel(Ptrs A) {
    extern __shared__ __attribute__((aligned(16))) unsigned char lds_raw[];
    LAS unsigned char* lds = (LAS unsigned char*)lds_raw;
    const int G = gridDim.x, bx = blockIdx.x, NGW = G * NWAVES;
    const int vcu = (G % 8 == 0) ? (bx % 8) * (G / 8) + bx / 8 : bx;
#define STAGGER(nunits_, T_) do { if (STAG_ON) { const int r_ = (nunits_) % G; const int lg_ = bx >> 6, lgfree_ = (r_ + 63) >> 6; \
    if (r_ != 0 && lg_ >= lgfree_) { const unsigned long long w_ = (unsigned long long)((lg_ - lgfree_ + 1) * (T_) / (4 - lgfree_ + 1)); const unsigned long long t0_ = __builtin_amdgcn_s_memrealtime(); \
        while (__builtin_amdgcn_s_memrealtime() - t0_ < w_) __builtin_amdgcn_s_sleep(8); } } } while (0)
typedef const __attribute__((address_space(4))) Ptrs* KArgP;
#define PHASE_IDS() int tid = threadIdx.x; asm volatile("" : "+v"(tid)); const int lane = tid & 63, wave = __builtin_amdgcn_readfirstlane(tid >> 6), gw = vcu * NWAVES + wave; (void)lane; (void)gw; \
    KArgP AP = (KArgP)__builtin_amdgcn_kernarg_segment_ptr(); asm volatile("" : "+s"(AP)); \
    unsigned char* const ws = AP->ws; unsigned* const ctl = (unsigned*)(ws + WS_CTL); float* const MOD = (float*)(ws + WS_MODX); float* const SSQ = (float*)(ws + WS_SSQ) + (size_t)l * 2 * NTOK; (void)SSQ; float* const TAB32 = (float*)(ws + WS_TAB); float* const TAB16 = TAB32 + 4096; \
    float* const RSTDQ = (float*)(ws + WS_RSTD); float* const RSTDKV = RSTDQ + NTOK; bf16* const Hb = (bf16*)(ws + WS_H); bf16* const MIX = (bf16*)(ws + WS_MIX); float* const XC = (float*)(ws + WS_XC); \
    bf16* const Pb = (bf16*)(ws + WS_P); bf16* const Qb = (bf16*)(ws + WS_Q); bf16* const KVb = (bf16*)(ws + WS_KV); bf16* const GOF = (bf16*)(ws + WS_GOF); bf16* const GOB = (bf16*)(ws + WS_GOB); bf16* const ACT = (bf16*)(ws + WS_ACT); float* const PART = (float*)(ws + WS_PART); (void)PART; \
    const float* const modl = MOD + (size_t)l * 9 * (NMOD * D_MODEL); const float* const xl_in = (l == 0) ? AP->x : AP->out; const float* const xc_in = (l == 0) ? AP->ctx : XC; \
    const char* const wl = (const char*)(ws + WS_W + (size_t)l * W_LAYER); \
    (void)ctl; (void)MOD; (void)TAB32; (void)TAB16; (void)RSTDQ; (void)RSTDKV; (void)Hb; (void)MIX; (void)XC; (void)Pb; (void)Qb; (void)KVb; (void)GOF; (void)GOB; (void)ACT; (void)modl; (void)xl_in; (void)xc_in; (void)wl
    volatile LAS unsigned* LCTL = (volatile LAS unsigned*)(lds + LDSCTL_OFF);
    for (int u = threadIdx.x; u < (LDS_BYTES - LDSCTL_OFF) / 4; u += NWAVES * 64) LCTL[u] = 0u;
    __syncthreads();
    XcdBarrier bar = xcd_barrier_post((unsigned*)(A.ws + WS_CTL) + CW_BAR, LCTL);
#define GRID_BAR() xcd_barrier(bar)

#if EN_P0
        { const int l = 0; PHASE_IDS(); asm volatile("; PHASE_MARK EN_P0");
    {
        LAS float* sS = (LAS float*)lds;
        LAS float* sR = (LAS float*)(lds + 73728);
        for (int u = tid; u < 9 * D_MODEL; u += 512) { const int i = u >> 11, kx = u & (D_MODEL - 1); const float cv = i < BATCH ? AP->c[i * D_MODEL + kx] : AP->c_ctx[kx]; sS[u] = cv * pg8::fast_sigmoid(cv); }
        __syncthreads();
        for (int it = bx; it < DEPTH * 192; it += G) {
            const int l = it / 192, cchunk = it % 192, kk = lane >> 4, c4 = (lane & 15) * 4;
            f32x4 acc[9];
#pragma unroll
            for (int i = 0; i < 9; ++i) acc[i] = (f32x4){0.f, 0.f, 0.f, 0.f};
            const float* wp = AP->w_mod + ((size_t)l * D_MODEL + wave * 256 + kk) * (NMOD * D_MODEL) + cchunk * 64 + c4;
#pragma unroll 1
            for (int k8 = 0; k8 < 64; k8 += 8) { f32x4 wv[8];
#pragma unroll
                for (int q = 0; q < 8; ++q) wv[q] = __builtin_nontemporal_load((const f32x4*)(wp + (size_t)(4 * (k8 + q)) * (NMOD * D_MODEL)));
#pragma unroll
                for (int q = 0; q < 8; ++q) {
#pragma unroll
                    for (int i = 0; i < 9; ++i) acc[i] += wv[q] * sS[i * D_MODEL + wave * 256 + 4 * (k8 + q) + kk];
                    __builtin_amdgcn_sched_barrier(0); } }
#pragma unroll
            for (int i = 0; i < 9; ++i)
#pragma unroll
                for (int e = 0; e < 4; ++e) { float s = acc[i][e]; s += swz_xor<16>(s); auto rr = __builtin_amdgcn_permlane32_swap(__float_as_uint(s), __float_as_uint(s), false, false); acc[i][e] = __uint_as_float(rr[0]) + __uint_as_float(rr[1]); }
            if (lane < 16) {
#pragma unroll
                for (int i = 0; i < 9; ++i) *(LAS f32x4*)(sR + (wave * 9 + i) * 64 + c4) = acc[i]; }
            __syncthreads();
            for (int u = tid; u < 9 * 64; u += 512) { float s = 0.f;
#pragma unroll
                for (int w8 = 0; w8 < 8; ++w8) s += sR[w8 * 576 + u];
                const int i = u >> 6, col = cchunk * 64 + (u & 63);
                MOD[((size_t)l * 9 + i) * (NMOD * D_MODEL) + col] = s + AP->b_mod[(size_t)l * (NMOD * D_MODEL) + col]; }
            __syncthreads();
        }
        LAS float* scr = (LAS float*)(lds + wave * 16384);
        for (int it = gw; it < TI_LAYER; it += NGW) CONVERT_ITEM(0, it);
        for (int u = bx * 512 + tid; u < DEPTH * (160 * 2048 + 128 * 512) / 8; u += G * 512) {
            const int l = u / ((160 * 2048 + 128 * 512) / 8); const int r = u % ((160 * 2048 + 128 * 512) / 8);
            char* wl = (char*)(ws + WS_W + (size_t)l * W_LAYER);
            v4u z = {0u, 0u, 0u, 0u};
            if (r < 160 * 2048 / 8) *(v4u*)(wl + W_IN + (size_t)IN_W * D_MODEL * 2 + (size_t)r * 16) = z;
            else *(v4u*)(wl + W_UQKV + (size_t)UQ_W * 512 * 2 + (size_t)(r - 160 * 2048 / 8) * 16) = z;
        }
        for (int u = bx * 512 + tid; u < 64 * 32 + 64 * 16; u += G * 512) {
            const bool big = u < 2048; const int v = big ? u : u - 2048; const int half = big ? 32 : 16; const int pos = v / half, i = v % half;
            const double rr = big ? 0.74989420933245582730 : 0.56234132519034908039;
            double f = 1.0; for (int q = 0; q < i; ++q) f *= rr;
            double s, c; sincos_d((double)pos * f, s, c);
            float* T = big ? TAB32 : TAB16; T[v] = (float)c; T[64 * half + v] = (float)s;
        }
    }
        }
#endif
    GRID_BAR();

    for (int l = 0; l < DEPTH; ++l) {
        const bool last = (l == DEPTH - 1);
        const bool fused = FUSE_NORM && (G == 256);
        const int Mres = last ? NLAT : NTOK;

#if EN_N1
        { PHASE_IDS(); asm volatile("; PHASE_MARK EN_N1");
        _Pragma("unroll") for (int rep_ = 0; rep_ < DUP_N1; ++rep_) { if (rep_) GRID_BAR();
        norm_rows(xl_in, xc_in, NTOK, Hb, AP->g_mix + l * D_MODEL, modl, 0, 1, gw, NGW, lane, l > 0 ? PART : nullptr, XC, (fused && l > 0) ? NLAT : 0);
        }
        }
#endif
        GRID_BAR();

#if EN_G1
        { PHASE_IDS(); asm volatile("; PHASE_MARK EN_G1");
        _Pragma("unroll") for (int rep_ = 0; rep_ < DUP_G1; ++rep_) {
        { pg8::Gemm g{Hb, (const bf16*)(wl + W_IN), NTOK, IN_WP, D_MODEL, D_MODEL, 1 << 30, 0, D_MODEL, 0, 0, 0}; pg8::StaticOrder S; S.init(NTOK, IN_WP, G, bx, WGM_G1); S.mode = HALVE_LAST;
          pg8::EpiInProj E{Pb, IN_WP, SSQ, NTOK, TAB32, TAB16, NLAT, SEQ - 1};
          STAGGER((NTOK / 256) * (IN_WP / 256), 4000); pg8::gemm_phase<pg8::EpiInProj, pg8::StaticOrder>(lds, g, S, E, tid);
          if (HALVE_LAST) { S.mode = 2; pg8::gemm_phase<pg8::EpiInProj, pg8::StaticOrder, PG8_ALIGN_DEFAULT, true>(lds, g, S, E, tid); } }
        }
        }
#endif
        GRID_BAR();

#if EN_G2
        { PHASE_IDS(); asm volatile("; PHASE_MARK EN_G2");
        _Pragma("unroll") for (int rep_ = 0; rep_ < DUP_G2; ++rep_) {
        { pg8::Gemm g{Pb, (const bf16*)(wl + W_UQKV), NTOK, UQ_WP + UKV_W, 512, IN_WP, UQ_WP / 256, C_CKV, 512, 0, 0, 0}; pg8::StaticOrder S; S.init(NTOK, UQ_WP + UKV_W, G, bx, WGM_G2);
          pg8::EpiQKV E{Qb, UQ_WP, KVb, UKV_W, SSQ, SSQ + NTOK, UQ_WP / 256};
          STAGGER((NTOK / 256) * ((UQ_WP + UKV_W) / 256), 1000); pg8::gemm_phase<pg8::EpiQKV, pg8::StaticOrder>(lds, g, S, E, tid); }
        }
        }
#endif
        GRID_BAR();

#if EN_MIX
#if EN_GLA
        { PHASE_IDS(); asm volatile("; PHASE_MARK EN_GLA");
        _Pragma("nounroll") for (int rep_ = 0; rep_ < DUP_GLA; ++rep_) {
        if (bx < 64) {
            gla::Unit U; U.P = Pb; U.ldp = IN_WP; U.b = bx >> 3; U.h = (bx >> 1) & 3; U.dir = bx & 1;
            U.wg = (U.dir ? AP->w_gate_b : AP->w_gate_f) + (size_t)l * 16 * 256; U.bg = (U.dir ? AP->b_gate_b : AP->b_gate_f) + (size_t)l * 256; U.og = U.dir ? GOB : GOF;
            gla::gla_unit(U, (char*)lds_raw, tid);
        }
        }
        }
#endif
#if EN_CONV
        if (l + 1 < DEPTH && bx >= 64 && bx < 128) { PHASE_IDS();
            LAS float* scr = (LAS float*)(lds + wave * 16384);
            for (int it = (bx - 64) * NWAVES + wave; it < TI_LAYER; it += 64 * NWAVES) CONVERT_ITEM(l + 1, it);
            __syncthreads();
        }
#endif
#if EN_MLA
        { PHASE_IDS(); asm volatile("; PHASE_MARK EN_MLA");
        {
            const int nitem = last ? 768 : 816; unsigned* head = ctl + CW_QUEUE + (l * 2 + 0) * 64;
            for (;;) {
                if (tid == 0) LCTL[4] = xb_add(head, 1u);
                __syncthreads(); int it = (int)LCTL[4]; __syncthreads();
                if (it >= nitem * DUP_MLA) break;
                if (DUP_MLA > 1) it %= nitem;
                att::Unit U; const bool lat = it < 768; const int bh = lat ? it >> 4 : it - 768, qb = lat ? it & 15 : 0, b = bh / 6, h = bh % 6;
                const long row0 = lat ? (long)b * SEQ + qb * 256 : (long)NLAT + b * CTX;
                U.Q = Qb + row0 * UQ_WP + h * 192;
                U.Kn = KVb + h * 256; U.V = KVb + h * 256 + 128; U.Kr = Pb + C_KR;
                U.t0a = lat ? b * SEQ : NLAT + b * CTX; U.nta = lat ? 64 : 4; U.t0b = NLAT + b * CTX; U.ntb = lat ? 4 : 0;
                U.mask = 0; U.qpos0 = qb * 256; U.kpos0 = 0; U.has_sink = 0; U.sink = 0.f; U.rope = lat ? 1 : 0; U.tab = TAB16;
                U.O = MIX + row0 * D_MODEL + MX_MLA + h * 128;
                att::attn_unit<192, 1, UQ_WP, UKV_W, IN_WP, UKV_W, D_MODEL>(U, (char*)lds_raw, 0.07216878364870322f, tid);
            }
        }
        }
#endif
#if EN_SWA
        { PHASE_IDS(); asm volatile("; PHASE_MARK EN_SWA");
        {
            const int nitem = last ? 768 : 816; unsigned* head = ctl + CW_QUEUE + (l * 2 + 1) * 64;
            for (;;) {
                if (tid == 0) LCTL[4] = xb_add(head, 1u);
                __syncthreads(); int it = (int)LCTL[4]; __syncthreads();
                if (it >= nitem * DUP_SWA) break;
                if (DUP_SWA > 1) it %= nitem;
                att::Unit U; const bool lat = it < 768; const int bh = lat ? it >> 4 : it - 768, qb = lat ? it & 15 : 0, b = bh / 6, hq = bh % 6, kvh = hq / 3;
                const long row0 = lat ? (long)b * SEQ + qb * 256 : (long)NLAT + b * CTX;
                const int ks = lat ? (qb * 256 - 128 < 0 ? 0 : qb * 256 - 128) : 0, ke = lat ? (qb * 256 + 384 > SEQ ? SEQ : qb * 256 + 384) : 0;
                U.Q = Pb + row0 * IN_WP + C_QS + hq * 128;
                U.Kn = Pb + C_KS + kvh * 128; U.V = Pb + C_VS + kvh * 128; U.Kr = nullptr;
                U.t0a = lat ? b * SEQ + ks : NLAT + b * CTX; U.nta = lat ? (ke - ks) / 64 : 4; U.t0b = NLAT + b * CTX; U.ntb = lat ? 4 : 0;
                U.mask = lat ? 1 : 0; U.qpos0 = qb * 256; U.kpos0 = ks; U.has_sink = 1; U.sink = AP->swa_sink[l * 6 + hq]; U.rope = lat ? 1 : 0; U.tab = TAB32;
                U.O = MIX + row0 * D_MODEL + MX_SWA + hq * 128;
                att::attn_unit<128, 2, IN_WP, IN_WP, IN_WP, IN_WP, D_MODEL>(U, (char*)lds_raw, 0.08838834764831845f, tid);
            }
        }
        }
#endif
#if PROBE_ATT
        { PHASE_IDS(); asm volatile("; PHASE_MARK PROBE_ATT");
        {
            const int nitem = last ? 768 : 816; unsigned* head = ctl + CW_QUEUE + 2048 + l * 64;
            for (;;) {
                if (tid == 0) LCTL[4] = xb_add(head, 1u);
                __syncthreads(); int it = (int)LCTL[4]; __syncthreads();
                if (it >= nitem) break;
                att::Unit U; const bool lat = it < 768; const int bh = lat ? it >> 4 : it - 768, qb = lat ? it & 15 : 0, b = bh / 6, h = bh % 6;
                const long row0 = lat ? (long)b * SEQ + qb * 256 : (long)NLAT + b * CTX;
                U.Q = Qb + row0 * UQ_WP + h * 192;
                U.Kn = KVb + h * 256; U.V = KVb + h * 256 + 128; U.Kr = Pb + C_KR;
                U.t0a = lat ? b * SEQ : NLAT + b * CTX; U.nta = lat ? 64 : 4; U.t0b = NLAT + b * CTX; U.ntb = lat ? 4 : 0;
                U.mask = 0; U.qpos0 = qb * 256; U.kpos0 = 0; U.has_sink = 0; U.sink = 0.f; U.rope = lat ? 1 : 0; U.tab = TAB16;
                U.O = (att::bf16*)(ws + WS_PART) + (size_t)(it & 31) * 256 * D_MODEL + h * 128;
                att::attn_unit<192, 1, UQ_WP, UKV_W, IN_WP, UKV_W, D_MODEL, PROBE_ATT_VAR>(U, (char*)lds_raw, 0.07216878364870322f, tid);
            }
        }
        }
#endif
#endif
        GRID_BAR();

#if EN_GL2
        { PHASE_IDS(); asm volatile("; PHASE_MARK EN_GL2");
        _Pragma("unroll") for (int rep_ = 0; rep_ < DUP_GL2; ++rep_) { if (rep_) GRID_BAR();
        for (int row = gw; row < Mres; row += NGW) {
            const v4u fa = *(const v4u*)(GOF + (size_t)row * 512 + lane * 8), fb = *(const v4u*)(GOB + (size_t)row * 512 + lane * 8);
            const f32x4 o0 = {bflo(fa.x) + bflo(fb.x), bfhi(fa.x) + bfhi(fb.x), bflo(fa.y) + bflo(fb.y), bfhi(fa.y) + bfhi(fb.y)};
            const f32x4 o1 = {bflo(fa.z) + bflo(fb.z), bfhi(fa.z) + bfhi(fb.z), bflo(fa.w) + bflo(fb.w), bfhi(fa.w) + bfhi(fb.w)};
            float ss = (o0.x * o0.x + o0.y * o0.y) + (o0.z * o0.z + o0.w * o0.w) + (o1.x * o1.x + o1.y * o1.y) + (o1.z * o1.z + o1.w * o1.w);
            ss = sum16(ss);
            const float rs = 1.f / sqrtf(ss * (1.f / 128.f) + EPS);
            const float* gp = AP->g_gla_out + l * 512 + lane * 8; const f32x4 g0 = *(const f32x4*)gp, g1 = *(const f32x4*)(gp + 4);
            const v4u rw = *(const v4u*)(Pb + (size_t)row * IN_WP + C_GR + lane * 8);
            float r[8] = {bflo(rw.x), bfhi(rw.x), bflo(rw.y), bfhi(rw.y), bflo(rw.z), bfhi(rw.z), bflo(rw.w), bfhi(rw.w)};
            float y[8] = {o0.x * g0.x, o0.y * g0.y, o0.z * g0.z, o0.w * g0.w, o1.x * g1.x, o1.y * g1.y, o1.z * g1.z, o1.w * g1.w};
#pragma unroll
            for (int e = 0; e < 8; ++e) y[e] = y[e] * rs * (r[e] * pg8::fast_sigmoid(r[e]));
            v4u w; w.x = pk2(y[0], y[1]); w.y = pk2(y[2], y[3]); w.z = pk2(y[4], y[5]); w.w = pk2(y[6], y[7]);
            *(v4u*)(MIX + (size_t)row * D_MODEL + MX_GLA + lane * 8) = w;
        }
        }
        }
#endif
        GRID_BAR();

#if EN_G3
        { PHASE_IDS(); asm volatile("; PHASE_MARK EN_G3");
        {
          pg8::Gemm g{MIX, (const bf16*)(wl + W_OUT), NLAT, D_MODEL, D_MODEL, D_MODEL, 1 << 30, 0, D_MODEL, 0, 0, 0}; pg8::StaticOrder S; S.init(NLAT, D_MODEL, G, bx, WGM_RES);
          if (fused) { pg8::EpiResNorm E{xl_in, AP->out, modl + 2 * D_MODEL, NMOD * D_MODEL, Hb, AP->g_ffn + l * D_MODEL, modl + 3 * D_MODEL, modl + 4 * D_MODEL,
                                        (float*)(ws + WS_XS), ctl + CW_PANEL + ((l * 2 + 0) * 128) * 64, ctl + CW_BAR + XB_TMO, lds + LDSCTL_OFF + 2048, 0};
              pg8::gemm_phase<pg8::EpiResNorm, pg8::StaticOrder>(lds, g, S, E, tid); }
          else { pg8::EpiRes E{xl_in, xc_in, AP->out, XC, modl + 2 * D_MODEL, NMOD * D_MODEL, D_MODEL};
              pg8::gemm_phase<pg8::EpiRes, pg8::StaticOrder>(lds, g, S, E, tid); }
          if (!last) { pg8::Gemm g2{MIX + (size_t)NLAT * D_MODEL, (const bf16*)(wl + W_OUT), NCTX, D_MODEL, D_MODEL / 4, D_MODEL, 1 << 30, 0, D_MODEL, D_MODEL / 4, 0, 0}; pg8::SplitKOrder S2; S2.init(NCTX / 256, D_MODEL / 256, 4, G, bx);
              pg8::EpiPart E2{PART, modl + (size_t)BATCH * (NMOD * D_MODEL) + 2 * D_MODEL, NCTX, D_MODEL};
              pg8::gemm_phase<pg8::EpiPart, pg8::SplitKOrder>(lds, g2, S2, E2, tid); } }
        }
#endif
        GRID_BAR();

#if EN_N2
        { PHASE_IDS(); asm volatile("; PHASE_MARK EN_N2");
        _Pragma("unroll") for (int rep_ = 0; rep_ < DUP_N2; ++rep_) { if (rep_) GRID_BAR();
        norm_rows(AP->out, xc_in, Mres, Hb, AP->g_ffn + l * D_MODEL, modl, 3, 4, gw, NGW, lane, last ? nullptr : PART, XC, fused ? NLAT : 0);
        }
        }
#endif
        GRID_BAR();

#if EN_G4
        { PHASE_IDS(); asm volatile("; PHASE_MARK EN_G4");
        _Pragma("unroll") for (int rep_ = 0; rep_ < (DUP_G4 == 3 ? 1 : DUP_G4); ++rep_) {
        { pg8::Gemm g{Hb, (const bf16*)(wl + W_GU), Mres, 2 * FFN, D_MODEL, D_MODEL, 1 << 30, 0, D_MODEL, 0, 0, 0}; pg8::StaticOrder S; S.init(Mres, 2 * FFN, G, bx, WGM_G4); S.mode = HALVE_LAST;
          pg8::EpiSwiglu E{ACT, FFN, ACT_TILED ? NTOK : 0};
          STAGGER((Mres / 256) * (2 * FFN / 256), 4000);
          if (DUP_G4 == 3) { pg8::EpiSum E3{(float*)(ws + WS_MIX)};
              pg8::gemm_phase<pg8::EpiSum, pg8::StaticOrder>(lds, g, S, E3, tid); }
          pg8::gemm_phase<pg8::EpiSwiglu, pg8::StaticOrder>(lds, g, S, E, tid);
          if (HALVE_LAST) { S.mode = 2; pg8::gemm_phase<pg8::EpiSwiglu, pg8::StaticOrder, PG8_ALIGN_DEFAULT, true>(lds, g, S, E, tid); } }
        }
        }
#endif
        GRID_BAR();

#if EN_G5
        { PHASE_IDS(); asm volatile("; PHASE_MARK EN_G5");
        { pg8::Gemm g{ACT, (const bf16*)(wl + W_DOWN), NLAT, D_MODEL, FFN, ACT_TILED ? 64 : FFN, 1 << 30, 0, FFN, 0, ACT_TILED ? (long)NTOK * 128 : 0, 0}; pg8::StaticOrder S; S.init(NLAT, D_MODEL, G, bx, WGM_RES, REV_G5);
          if (fused) { const float* modn = MOD + (size_t)(l + 1) * 9 * (NMOD * D_MODEL);
              pg8::EpiResNorm E{AP->out, AP->out, modl + 5 * D_MODEL, NMOD * D_MODEL, Hb, last ? AP->g_final : AP->g_mix + (l + 1) * D_MODEL, modn, modn + D_MODEL,
                                (float*)(ws + WS_XS) + 128 * 256 * 8, ctl + CW_PANEL + ((l * 2 + 1) * 128) * 64, ctl + CW_BAR + XB_TMO, lds + LDSCTL_OFF + 2048, last ? 1 : 0};
              pg8::gemm_phase<pg8::EpiResNorm, pg8::StaticOrder>(lds, g, S, E, tid); }
          else { pg8::EpiRes E{AP->out, XC, AP->out, XC, modl + 5 * D_MODEL, NMOD * D_MODEL, D_MODEL};
              pg8::gemm_phase<pg8::EpiRes, pg8::StaticOrder>(lds, g, S, E, tid); }
          if (DUP_G5 >= 3) { pg8::StaticOrder S3; S3.init(NLAT, D_MODEL, G, bx, WGM_RES, REV_G5); if (DUP_G5 == 4) S3.pm_mod = 16;
              pg8::EpiSum E3{(float*)(ws + WS_MIX)}; pg8::gemm_phase<pg8::EpiSum, pg8::StaticOrder>(lds, g, S3, E3, tid); }
          if (!last) { pg8::Gemm g2{ACT + (size_t)NLAT * (ACT_TILED ? 64 : FFN), (const bf16*)(wl + W_DOWN), NCTX, D_MODEL, FFN / 4, ACT_TILED ? 64 : FFN, 1 << 30, 0, FFN, FFN / 4, ACT_TILED ? (long)NTOK * 128 : 0, ACT_TILED ? (long)(FFN / 4 / 64) * NTOK * 128 : 0}; pg8::SplitKOrder S2; S2.init(NCTX / 256, D_MODEL / 256, 4, G, bx);
              pg8::EpiPart E2{PART, modl + (size_t)BATCH * (NMOD * D_MODEL) + 5 * D_MODEL, NCTX, D_MODEL};
              pg8::gemm_phase<pg8::EpiPart, pg8::SplitKOrder>(lds, g2, S2, E2, tid); } }
        }
#endif
        GRID_BAR();
    }

#if BURN_MFMA
    {
        typedef short bx8 __attribute__((ext_vector_type(8))); typedef float fx4 __attribute__((ext_vector_type(4)));
        int t_ = threadIdx.x; asm volatile("" : "+v"(t_));
        bx8 a_, b_; for (int e = 0; e < 8; ++e) { a_[e] = (short)(0x3c00 + ((t_ * 7 + e) & 127)); b_[e] = (short)(0x3c00 + ((t_ * 13 + e * 5) & 127)); }
        fx4 c_[8]; for (int i = 0; i < 8; ++i) c_[i] = (fx4){0.f, 0.f, 0.f, 0.f};
#pragma unroll 1
        for (int it = 0; it < BURN_MFMA * 128; ++it) {
#pragma unroll
            for (int i = 0; i < 8; ++i) c_[i] = __builtin_amdgcn_mfma_f32_16x16x32_bf16(a_, b_, c_[i], 0, 0, 0);
        }
        float s_ = 0.f; for (int i = 0; i < 8; ++i) s_ += c_[i][0] + c_[i][1] + c_[i][2] + c_[i][3];
        ((float*)(A.ws + WS_PART))[blockIdx.x * 512 + threadIdx.x] = s_;
    }
#endif
    const int l = 0; PHASE_IDS();
    if (!(FUSE_NORM && G == 256))
    for (int row = gw; row < NLAT; row += NGW) {
        float* xr = AP->out + (size_t)row * D_MODEL;
        f32x4 v[8]; float ss = 0.f;
#pragma unroll
        for (int j = 0; j < 8; ++j) { v[j] = *(const f32x4*)(xr + 4 * lane + 256 * j); ss += (v[j].x * v[j].x + v[j].y * v[j].y) + (v[j].z * v[j].z + v[j].w * v[j].w); }
        const float rstd = 1.f / sqrtf(wave_sum(ss) * (1.f / D_MODEL) + EPS);
#pragma unroll
        for (int j = 0; j < 8; ++j) { const int col = 4 * lane + 256 * j; const f32x4 gv = *(const f32x4*)(AP->g_final + col); *(f32x4*)(xr + col) = (v[j] * rstd) * gv; }
    }
}

extern "C" void kernel_launch(void* const* d_in, const int* in_sizes, int n_in, void* d_out, int out_size, void* d_ws, size_t ws_size, hipStream_t stream) {
    static int grid = 0;
    if (grid == 0) {
        if (n_in != 23 || in_sizes[0] != NLAT * D_MODEL || out_size != NLAT * D_MODEL || ws_size < WS_END) {
            fprintf(stderr, "kernel_launch: unexpected shapes: n_in %d in0 %d out %d ws %zu (need %zu)\n", n_in, n_in > 0 ? in_sizes[0] : -1, out_size, ws_size, (size_t)WS_END); grid = -1; return; }
        int dev = 0, cus = 0, per_cu = 0;
        if (hipGetDevice(&dev) != hipSuccess || hipDeviceGetAttribute(&cus, hipDeviceAttributeMultiprocessorCount, dev) != hipSuccess) { fprintf(stderr, "kernel_launch: device query failed\n"); grid = -1; return; }
        if (hipFuncSetAttribute((const void*)fwd_kernel, hipFuncAttributeMaxDynamicSharedMemorySize, LDS_BYTES) != hipSuccess) { fprintf(stderr, "kernel_launch: hipFuncSetAttribute failed\n"); grid = -1; return; }
        if (hipOccupancyMaxActiveBlocksPerMultiprocessor(&per_cu, (const void*)fwd_kernel, NWAVES * 64, LDS_BYTES) != hipSuccess || per_cu < 1) { fprintf(stderr, "kernel_launch: occupancy query reports %d workgroups per CU\n", per_cu); (void)hipGetLastError(); grid = -1; return; }
        grid = cus;
    }
    if (grid < 0) return;
    if (hipMemsetAsync((char*)d_ws, 0, ZERO_BYTES, stream) != hipSuccess) { fprintf(stderr, "kernel_launch: memset failed\n"); return; }
    Ptrs p{};
    const float** pf = (const float**)&p;
    for (int i = 0; i < 23; ++i) pf[i] = (const float*)d_in[i];
    p.out = (float*)d_out; p.ws = (unsigned char*)d_ws;
    hipLaunchKernelGGL(fwd_kernel, dim3(grid), dim3(NWAVES * 64), LDS_BYTES, stream, p);
    const hipError_t le = hipPeekAtLastError();
    if (le != hipSuccess) fprintf(stderr, "kernel_launch: launch failed: %s\n", hipGetErrorName(le));
}
```

```cpp
#include <hip/hip_runtime.h>
#include <cstdio>
#include <cstdint>
#include <cmath>

constexpr int D_MODEL = 2048, BATCH = 8, SEQ = 4096, DEPTH = 4, CTX = 256;
constexpr int NLAT = BATCH * SEQ;
constexpr int NCTX = BATCH * CTX;
constexpr int NTOK = NLAT + NCTX;
constexpr int IN_W = 3936, IN_WP = 4096;
constexpr int FFN = 5632, NMOD = 6;
constexpr int UQ_W = 1152, UQ_WP = 1280, UKV_W = 1536;
constexpr float EPS = 1e-6f;
constexpr int C_CQ = 0, C_CKV = 512, C_KR = 1024, C_QS = 1088, C_KS = 1856, C_VS = 2112, C_GQ = 2368, C_GK = 2624, C_GV = 2880, C_GLR = 3392, C_GR = 3424;
constexpr int MX_MLA = 0, MX_SWA = 768, MX_GLA = 1536;

namespace pg8 {
#define PG8_LAS __attribute__((address_space(3)))
typedef unsigned short bf16_t;
typedef short bf16x8 __attribute__((ext_vector_type(8)));
typedef float f32x4 __attribute__((ext_vector_type(4)));
typedef unsigned u32x4 __attribute__((ext_vector_type(4)));
constexpr int BM = 256, BK = 64, HALF = 128, HTB = HALF * BK * 2  , STAGE_BYTES = 8 * HTB, NXCD = 8, WGM = 8;

__host__ __device__ __forceinline__ int lds_byte(int r, int c) { const int st = (r >> 4) * 2 + (c >> 5), rr = r & 15, cc = c & 31, ob = rr * 64 + cc * 2; return st * 1024 + (ob ^ (((ob >> 9) & 1) << 5)); }
__host__ __device__ __forceinline__ void stage_rc(int b, int& R, int& C) { const int st = b / 1024, sb = b % 1024, swz = sb ^ (((sb >> 9) & 1) << 5); R = (st >> 1) * 16 + swz / 64; C = (st & 1) * 32 + (swz % 64) / 2; }
__host__ __device__ __forceinline__ int perm32(int rho) { const int n = rho >> 4, i = rho & 15; return 8 * (i >> 2) + 4 * n + (i & 3); }

struct Unit { int pm, pn, ks; int hm = 0; };
struct Gemm { const bf16_t* A; const bf16_t* Bt; int M, N, K, lda, a_split_pn, a_split_off, ldb, ksplit; long kstepA, ksplitA; };

struct StaticOrder {
    int nM, nN, nwg, G, c, wgm, rev, pm_mod = 0, mode = 0;
    __host__ __device__ void init(int M, int N, int G_, int c_, int wgm_ = WGM, int rev_ = 0) { nM = M / BM; nN = N / BM; nwg = nM * nN; G = G_; c = c_; wgm = wgm_; rev = rev_; }
    __host__ __device__ bool next(int i, Unit& u) const {
        long L = (long)i * G + c; u.hm = 0;
        if (mode) { const int full = nwg / G, R = nwg - full * G; const bool split = R > 0 && 2 * R <= G;
            if (mode == 1) { if (split && i >= full) return false; }
            else { if (!split || i > 0 || c >= 2 * R) return false; L = (long)full * G + (c >> 1); u.hm = 1 + (c & 1); } }
        if (L >= nwg) return false;
        int wgid = (int)L; { const int q = nwg / NXCD, r = nwg % NXCD, xcd = wgid % NXCD, off = wgid / NXCD; wgid = (xcd < r ? xcd * (q + 1) : r * (q + 1) + (xcd - r) * q) + off; }
        const int nig = wgm * nN, gid = wgid / nig, fm = gid * wgm, gsz = (nM - fm) < wgm ? (nM - fm) : wgm;
        u.pm = fm + ((wgid % nig) % gsz); u.pn = (wgid % nig) / gsz; u.ks = 0; if (rev) u.pm = nM - 1 - u.pm; if (pm_mod) u.pm %= pm_mod; return true;
    }
    __device__ __forceinline__ void a_ready(const Unit&) const {}
    __device__ __forceinline__ void done(const Unit&) const {}
};

struct SplitKOrder {
    int nM, nN, nS, G, c;
    __host__ __device__ void init(int nM_, int nN_, int nS_, int G_, int c_) { nM = nM_; nN = nN_; nS = nS_; G = G_; c = c_; }
    __host__ __device__ bool next(int i, Unit& u) const { const int L = i * G + c; if (L >= nM * nN * nS) return false; u.ks = L % nS; u.pm = (L / nS) % nM; u.pn = L / (nS * nM); return true; }
    __device__ __forceinline__ void a_ready(const Unit&) const {}
    __device__ __forceinline__ void done(const Unit&) const {}
};

typedef float f32x2_t __attribute__((ext_vector_type(2))); typedef __bf16 bf16x2_t __attribute__((ext_vector_type(2)));
__device__ __forceinline__ unsigned cvt_pk_bf16(float lo, float hi) { f32x2_t v = {lo, hi}; bf16x2_t b = __builtin_convertvector(v, bf16x2_t); return __builtin_bit_cast(unsigned, b); }
typedef float f32x2 __attribute__((ext_vector_type(2)));
#ifndef NT_ACT
#define NT_ACT 0
#endif
typedef unsigned u32x2 __attribute__((ext_vector_type(2)));
__device__ __forceinline__ float fast_sigmoid(float x) { return __builtin_amdgcn_rcpf(1.0f + __builtin_amdgcn_exp2f(-1.4426950408889634f * x)); }
struct EpiStoreBf16 {
    static constexpr bool PERM = true, AFTER_DRAIN = false;
    bf16_t* O; int ldc;
    __device__ __forceinline__ void operator()(const f32x4 (&acc)[2][2][4][2], const Unit& u, int wr, int wc, int fr, int fq) const {
        const int row0 = u.pm * BM + wr * 64 + fr, col0 = u.pn * BM + wc * 32 + 8 * fq;
#pragma unroll
        for (int ai = 0; ai < 2; ++ai)
#pragma unroll
            for (int m = 0; m < 4; ++m) { bf16_t* rowp = O + (size_t)(row0 + ai * HALF + m * 16) * ldc + col0;
#pragma unroll
                for (int bj = 0; bj < 2; ++bj) { const f32x4 v0 = acc[ai][bj][m][0], v1 = acc[ai][bj][m][1];
                    u32x4 w; w.x = cvt_pk_bf16(v0[0], v0[1]); w.y = cvt_pk_bf16(v0[2], v0[3]); w.z = cvt_pk_bf16(v1[0], v1[1]); w.w = cvt_pk_bf16(v1[2], v1[3]);
                    *(u32x4*)(rowp + bj * HALF) = w; } }
    }
};
struct EpiQKV {
    static constexpr bool PERM = true, AFTER_DRAIN = false;
    bf16_t* Oq; int ldq; bf16_t* Okv; int ldkv; const float* rq; const float* rkv; int split;
    __device__ __forceinline__ void operator()(const f32x4 (&acc)[2][2][4][2], const Unit& u, int wr, int wc, int fr, int fq) const {
        const bool first = u.pn < split;
        bf16_t* base = first ? Oq : Okv; const int ld = first ? ldq : ldkv; const float* rs = first ? rq : rkv;
        const int row0 = u.pm * BM + wr * 64 + fr, col0 = (first ? u.pn : u.pn - split) * BM + wc * 32 + 8 * fq;
        float sv[2][4];
#pragma unroll
        for (int ai = 0; ai < 2; ++ai)
#pragma unroll
            for (int m = 0; m < 4; ++m) sv[ai][m] = rs[row0 + ai * HALF + m * 16];
#pragma unroll
        for (int ai = 0; ai < 2; ++ai)
#pragma unroll
            for (int m = 0; m < 4; ++m) { const int row = row0 + ai * HALF + m * 16; const float s = __builtin_amdgcn_rsqf(sv[ai][m] * (1.0f / 512.0f) + 1e-6f); bf16_t* rowp = base + (size_t)row * ld + col0;
#pragma unroll
                for (int bj = 0; bj < 2; ++bj) { const f32x4 v0 = acc[ai][bj][m][0] * s, v1 = acc[ai][bj][m][1] * s;
                    u32x4 w; w.x = cvt_pk_bf16(v0[0], v0[1]); w.y = cvt_pk_bf16(v0[2], v0[3]); w.z = cvt_pk_bf16(v1[0], v1[1]); w.w = cvt_pk_bf16(v1[2], v1[3]);
                    *(u32x4*)(rowp + bj * HALF) = w; } }
    }
};
struct EpiRes {
    static constexpr bool PERM = false, AFTER_DRAIN = false;
    const float* base_l; const float* base_c; float* out_l; float* out_c; const float* gate; int gpitch; int ncols;
    __device__ __forceinline__ void operator()(const f32x4 (&acc)[2][2][4][2], const Unit& u, int wr, int wc, int fr, int fq) const {
        const bool lat = u.pm < (NLAT / BM);
        const int gi = lat ? (u.pm >> 4) : BATCH;
        const float* bs = lat ? base_l : base_c; float* os = lat ? out_l : out_c;
        const int row0 = (lat ? u.pm : u.pm - NLAT / BM) * BM + wr * 64 + fr, col0 = u.pn * BM + wc * 32 + 4 * fq;
        f32x4 gv[2][2];
#pragma unroll
        for (int bj = 0; bj < 2; ++bj)
#pragma unroll
            for (int n = 0; n < 2; ++n) gv[bj][n] = *(const f32x4*)(gate + (size_t)gi * gpitch + col0 + bj * HALF + n * 16);
#pragma unroll
        for (int ai = 0; ai < 2; ++ai)
#pragma unroll
            for (int m = 0; m < 4; ++m) { const size_t off = (size_t)(row0 + ai * HALF + m * 16) * ncols + col0;
#pragma unroll
                for (int bj = 0; bj < 2; ++bj)
#pragma unroll
                    for (int n = 0; n < 2; ++n) { const f32x4 b = *(const f32x4*)(bs + off + bj * HALF + n * 16); *(f32x4*)(os + off + bj * HALF + n * 16) = b + gv[bj][n] * acc[ai][bj][m][n]; }
                asm volatile("" ::: "memory"); }
    }
};
struct EpiSwiglu {
    static constexpr bool PERM = true, AFTER_DRAIN = false;
    bf16_t* O; int ldc; int tiled_rows;
    __device__ __forceinline__ void operator()(const f32x4 (&acc)[2][2][4][2], const Unit& u, int wr, int wc, int fr, int fq) const {
        const int row0 = u.pm * BM + (u.hm == 2 ? HALF : 0) + wr * 64 + fr, col0 = u.pn * HALF + wc * 32 + 8 * fq;
#pragma unroll
        for (int ai = 0; ai < 2; ++ai) { if (ai == 1 && u.hm) break;
#pragma unroll
            for (int m = 0; m < 4; ++m) { const int row = row0 + ai * HALF + m * 16;
                bf16_t* rowp = tiled_rows ? O + ((size_t)(col0 >> 6) * tiled_rows + row) * 64 + (col0 & 63) : O + (size_t)row * ldc + col0;
                float r[8];
#pragma unroll
                for (int n = 0; n < 2; ++n)
#pragma unroll
                    for (int i = 0; i < 4; ++i) { const float g = acc[ai][0][m][n][i], up = acc[ai][1][m][n][i]; r[n * 4 + i] = g * fast_sigmoid(g) * up; }
                u32x4 w; w.x = cvt_pk_bf16(r[0], r[1]); w.y = cvt_pk_bf16(r[2], r[3]); w.z = cvt_pk_bf16(r[4], r[5]); w.w = cvt_pk_bf16(r[6], r[7]);
#if NT_ACT
                __builtin_nontemporal_store(w, (u32x4*)rowp);
#else
                *(u32x4*)rowp = w;
#endif
                }
        }
    }
};

struct EpiSum {
    static constexpr bool PERM = false, AFTER_DRAIN = false;
    float* O;
    __device__ __forceinline__ void operator()(const f32x4 (&acc)[2][2][4][2], const Unit& u, int wr, int wc, int fr, int fq) const {
        float s = 0.f;
#pragma unroll
        for (int ai = 0; ai < 2; ++ai)
#pragma unroll
            for (int bj = 0; bj < 2; ++bj)
#pragma unroll
                for (int m = 0; m < 4; ++m)
#pragma unroll
                    for (int n = 0; n < 2; ++n) s += (acc[ai][bj][m][n][0] + acc[ai][bj][m][n][1]) + (acc[ai][bj][m][n][2] + acc[ai][bj][m][n][3]);
        O[(size_t)(u.pm * 8 + u.pn) * 512 + (wr * 4 + wc) * 64 + fq * 16 + fr] = s;
    }
};

struct EpiPart {
    static constexpr bool PERM = false, AFTER_DRAIN = false;
    float* slab; const float* gate; int nrows, ncols;
    __device__ __forceinline__ void operator()(const f32x4 (&acc)[2][2][4][2], const Unit& u, int wr, int wc, int fr, int fq) const {
        const int row0 = u.pm * BM + wr * 64 + fr, col0 = u.pn * BM + wc * 32 + 4 * fq;
        float* os = slab + (size_t)u.ks * nrows * ncols;
        f32x4 gv[2][2];
#pragma unroll
        for (int bj = 0; bj < 2; ++bj)
#pragma unroll
            for (int n = 0; n < 2; ++n) gv[bj][n] = *(const f32x4*)(gate + col0 + bj * HALF + n * 16);
#pragma unroll
        for (int ai = 0; ai < 2; ++ai)
#pragma unroll
            for (int m = 0; m < 4; ++m) { const size_t off = (size_t)(row0 + ai * HALF + m * 16) * ncols + col0;
#pragma unroll
                for (int bj = 0; bj < 2; ++bj)
#pragma unroll
                    for (int n = 0; n < 2; ++n) *(f32x4*)(os + off + bj * HALF + n * 16) = gv[bj][n] * acc[ai][bj][m][n]; }
    }
};

struct EpiResNorm {
    static constexpr bool PERM = false, AFTER_DRAIN = false;
    const float* base_l; float* out_l; const float* gate; int gpitch;
    bf16_t* H;
    const float* gvec; const float* shiftp; const float* scalep;
    float* slots; unsigned* cnt; unsigned* tmo;
    PG8_LAS unsigned char* scr;
    int fin;
    __device__ __forceinline__ void operator()(f32x4 (&acc)[2][2][4][2], const Unit& u, int wr, int wc, int fr, int fq) const {
        const int gi = u.pm >> 4, row0 = u.pm * BM + wr * 64 + fr, col0 = u.pn * BM + wc * 32 + 4 * fq, wid = wr * 4 + wc, lane = fq * 16 + fr, tid = wid * 64 + lane;
        PG8_LAS float* P = (PG8_LAS float*)scr; PG8_LAS float* S = (PG8_LAS float*)(scr + 4096); PG8_LAS unsigned* flag = (PG8_LAS unsigned*)(scr + 5120);
        { f32x4 gv[2][2];
#pragma unroll
          for (int bj = 0; bj < 2; ++bj)
#pragma unroll
              for (int n = 0; n < 2; ++n) gv[bj][n] = *(const f32x4*)(gate + (size_t)gi * gpitch + col0 + bj * HALF + n * 16);
          f32x4 bb[2][2][2];
#define ERN_LOADB(it_, buf_) do { const size_t o_ = (size_t)(row0 + ((it_) >> 2) * HALF + ((it_) & 3) * 16) * 2048 + col0; \
    _Pragma("unroll") for (int bj = 0; bj < 2; ++bj) _Pragma("unroll") for (int n = 0; n < 2; ++n) bb[buf_][bj][n] = *(const f32x4*)(base_l + o_ + bj * HALF + n * 16); } while (0)
          ERN_LOADB(0, 0);
#pragma unroll
          for (int it = 0; it < 8; ++it) { const int ai = it >> 2, m = it & 3; const size_t off = (size_t)(row0 + ai * HALF + m * 16) * 2048 + col0; float ss = 0.f;
                  if (it + 1 < 8) ERN_LOADB(it + 1, (it + 1) & 1);
#pragma unroll
                  for (int bj = 0; bj < 2; ++bj)
#pragma unroll
                      for (int n = 0; n < 2; ++n) { const f32x4 b = bb[it & 1][bj][n]; const f32x4 x = b + gv[bj][n] * acc[ai][bj][m][n]; acc[ai][bj][m][n] = x;
                          if (!fin) *(f32x4*)(out_l + off + bj * HALF + n * 16) = x; ss += (x[0] * x[0] + x[1] * x[1]) + (x[2] * x[2] + x[3] * x[3]); }
                  ss += __int_as_float(__builtin_amdgcn_ds_swizzle(__float_as_int(ss), (16 << 10) | 0x1f));
                  { auto rr = __builtin_amdgcn_permlane32_swap(__float_as_uint(ss), __float_as_uint(ss), false, false); ss = __uint_as_float(rr[0]) + __uint_as_float(rr[1]); }
                  if (fq == 0) P[(ai * HALF + wr * 64 + m * 16 + fr) * 4 + wc] = ss;
                  asm volatile("" ::: "memory"); }
#undef ERN_LOADB
        }
        asm volatile("s_waitcnt lgkmcnt(0)" ::: "memory"); __builtin_amdgcn_s_barrier(); asm volatile("" ::: "memory");
        if (tid < 256) { const f32x4 p = *(const PG8_LAS f32x4*)(P + tid * 4); const float s = (p[0] + p[1]) + (p[2] + p[3]);
            __hip_atomic_store((unsigned*)slots + ((size_t)(u.pm * 256 + tid) * 8 + u.pn), __float_as_uint(s), __ATOMIC_RELAXED, __HIP_MEMORY_SCOPE_AGENT);
            asm volatile("s_waitcnt vmcnt(0)" ::: "memory");
            if (lane == 0) __hip_atomic_fetch_add(cnt + 64 * u.pm, 1u, __ATOMIC_RELAXED, __HIP_MEMORY_SCOPE_AGENT); }
        if (wid == 0) { unsigned dead = 0u, sp = 0u;
            while ((unsigned)__builtin_amdgcn_readfirstlane(__hip_atomic_load(cnt + 64 * u.pm, __ATOMIC_RELAXED, __HIP_MEMORY_SCOPE_AGENT)) < 32u) {
                __builtin_amdgcn_s_sleep(1);
                if ((++sp & 255u) == 0u) { if (__builtin_amdgcn_readfirstlane(__hip_atomic_load(tmo, __ATOMIC_RELAXED, __HIP_MEMORY_SCOPE_AGENT)) != 0u) { dead = 1u; break; }
                    if (sp > (1u << 20)) { if (lane == 0) __hip_atomic_fetch_add(tmo, 1u, __ATOMIC_RELAXED, __HIP_MEMORY_SCOPE_AGENT); dead = 1u; break; } } }
            __builtin_amdgcn_fence(__ATOMIC_ACQUIRE, "agent");
            if (lane == 0) flag[0] = dead; }
        asm volatile("s_waitcnt vmcnt(0) lgkmcnt(0)" ::: "memory"); __builtin_amdgcn_s_barrier(); asm volatile("" ::: "memory");
        if (tid < 256) { const unsigned* sl = (const unsigned*)slots + (size_t)(u.pm * 256 + tid) * 8; float t = 0.f;
#pragma unroll
            for (int q = 0; q < 8; ++q) t += __uint_as_float(__hip_atomic_load(sl + q, __ATOMIC_RELAXED, __HIP_MEMORY_SCOPE_AGENT));
            S[tid] = __builtin_amdgcn_rsqf(t * (1.0f / 2048.0f) + 1e-6f); }
        asm volatile("s_waitcnt lgkmcnt(0)" ::: "memory"); __builtin_amdgcn_s_barrier(); asm volatile("" ::: "memory");
        const bool bad = flag[0] != 0u; const float qnan = __builtin_nanf("");
        f32x4 gs[2][2], sh[2][2];
#pragma unroll
        for (int bj = 0; bj < 2; ++bj)
#pragma unroll
            for (int n = 0; n < 2; ++n) { const int c = col0 + bj * HALF + n * 16; const f32x4 g4 = *(const f32x4*)(gvec + c);
                if (fin) { gs[bj][n] = g4; sh[bj][n] = (f32x4){0.f, 0.f, 0.f, 0.f}; }
                else { gs[bj][n] = g4 * (*(const f32x4*)(scalep + (size_t)gi * gpitch + c) + 1.0f); sh[bj][n] = *(const f32x4*)(shiftp + (size_t)gi * gpitch + c); } }
#pragma unroll
        for (int ai = 0; ai < 2; ++ai)
#pragma unroll
            for (int m = 0; m < 4; ++m) { const int r = ai * HALF + wr * 64 + m * 16 + fr; const float rs = bad ? qnan : S[r]; const size_t off = (size_t)(u.pm * BM + r) * 2048 + col0;
#pragma unroll
                for (int bj = 0; bj < 2; ++bj)
#pragma unroll
                    for (int n = 0; n < 2; ++n) { const f32x4 y = (acc[ai][bj][m][n] * rs) * gs[bj][n] + sh[bj][n];
                        if (fin) *(f32x4*)(out_l + off + bj * HALF + n * 16) = y;
                        else { u32x2 w; w.x = cvt_pk_bf16(y[0], y[1]); w.y = cvt_pk_bf16(y[2], y[3]); *(u32x2*)(H + off + bj * HALF + n * 16) = w; } } }
    }
};

__host__ __device__ __forceinline__ int w_in_row(int c) {
    if (c >= 1856 && c < 2112) { const int B = 1856 + ((c - 1856) & ~127), d = (c - 1856) & 127, blk = d >> 6, n = (d & 63) >> 5, i = d & 31; return B + 8 * (blk * 8 + (i >> 2)) + 4 * n + (i & 3); }
    if (c >= 1024 && c < 1088) { const int d = c - 1024, blk = d >> 5, n = (d & 31) >> 4, i = d & 15; return 1024 + 8 * (blk * 4 + (i >> 2)) + 4 * n + (i & 3); }
    return c;
}
struct EpiInProj {
    static constexpr bool PERM = true, AFTER_DRAIN = false;
    bf16_t* O; int ldc; float* ssq; int ssq_rows; const float* tab32; const float* tab16; int nlat, seqmask;
    __device__ __forceinline__ void operator()(const f32x4 (&acc)[2][2][4][2], const Unit& u, int wr, int wc, int fr, int fq) const {
        const int row0 = u.pm * BM + (u.hm == 2 ? HALF : 0) + wr * 64 + fr; const bool stat = u.pn < 4; const bool lat = u.pm * BM < nlat; const int nai = u.hm ? 1 : 2;
#pragma unroll
        for (int bj = 0; bj < 2; ++bj) {
            const int p0 = u.pn * BM + bj * HALF + wc * 32 + 8 * fq;
            const bool inKS = p0 >= 1856 && p0 < 2112, inKR = p0 >= 1024 && p0 < 1088;
            if (inKS || inKR) {
                const int half = inKS ? 32 : 16, base = inKS ? 1856 + ((p0 - 1856) & ~127) : 1024, t = (p0 - base) >> 3, blk = inKS ? (t >> 3) : (t >> 2), i0 = 4 * (inKS ? (t & 7) : (t & 3));
                const float* tb = inKS ? tab32 : tab16; const int c1 = base + blk * 2 * half + i0;
#pragma unroll
                for (int ai = 0; ai < 2; ++ai) if (ai < nai)
#pragma unroll
                    for (int m = 0; m < 4; ++m) { const int row = row0 + ai * HALF + m * 16; f32x4 x1 = acc[ai][bj][m][0], x2 = acc[ai][bj][m][1];
                        if (lat) { const int ns = row & seqmask, pos = blk ? (ns & 63) : (ns >> 6); const f32x4 c = *(const f32x4*)(tb + pos * half + i0), s = *(const f32x4*)(tb + 64 * half + pos * half + i0);
                            const f32x4 y1 = x1 * c - x2 * s, y2 = x2 * c + x1 * s; x1 = y1; x2 = y2; }
                        u32x2 w1, w2; w1.x = cvt_pk_bf16(x1[0], x1[1]); w1.y = cvt_pk_bf16(x1[2], x1[3]); w2.x = cvt_pk_bf16(x2[0], x2[1]); w2.y = cvt_pk_bf16(x2[2], x2[3]);
                        bf16_t* rowp = O + (size_t)row * ldc + c1; *(u32x2*)rowp = w1; *(u32x2*)(rowp + half) = w2; }
            } else {
#pragma unroll
                for (int ai = 0; ai < 2; ++ai) if (ai < nai)
#pragma unroll
                    for (int m = 0; m < 4; ++m) { const f32x4 v0 = acc[ai][bj][m][0], v1 = acc[ai][bj][m][1];
                        u32x4 w; w.x = cvt_pk_bf16(v0[0], v0[1]); w.y = cvt_pk_bf16(v0[2], v0[3]); w.z = cvt_pk_bf16(v1[0], v1[1]); w.w = cvt_pk_bf16(v1[2], v1[3]);
                        *(u32x4*)(O + (size_t)(row0 + ai * HALF + m * 16) * ldc + p0) = w; }
            }
        }
        if (stat) {
#pragma unroll
            for (int ai = 0; ai < 2; ++ai) if (ai < nai)
#pragma unroll
                for (int m = 0; m < 4; ++m) { float ss = 0.f;
#pragma unroll
                    for (int bj = 0; bj < 2; ++bj) { const f32x4 v0 = acc[ai][bj][m][0], v1 = acc[ai][bj][m][1];
                        ss += ((v0[0] * v0[0] + v0[1] * v0[1]) + (v0[2] * v0[2] + v0[3] * v0[3])) + ((v1[0] * v1[0] + v1[1] * v1[1]) + (v1[2] * v1[2] + v1[3] * v1[3])); }
                    ss += __int_as_float(__builtin_amdgcn_ds_swizzle(__float_as_int(ss), (16 << 10) | 0x1f));
                    { auto rr = __builtin_amdgcn_permlane32_swap(__float_as_uint(ss), __float_as_uint(ss), false, false); ss = __uint_as_float(rr[0]) + __uint_as_float(rr[1]); }
                    if (fq == 0) __hip_atomic_fetch_add(ssq + (size_t)(u.pn >> 1) * ssq_rows + row0 + ai * HALF + m * 16, ss, __ATOMIC_RELAXED, __HIP_MEMORY_SCOPE_AGENT); }
        }
    }
};

#ifndef PG8_ALIGN_DEFAULT
#define PG8_ALIGN_DEFAULT true
#endif
__device__ __forceinline__ f32x4 zero_quad() { f32x2 lo, hi; asm volatile("v_mov_b64 %0, 0" : "=v"(lo)); asm volatile("v_mov_b64 %0, 0" : "=v"(hi)); return (f32x4){lo[0], lo[1], hi[0], hi[1]}; }
template <class Epi, class Sched, bool ALIGN_EPI = PG8_ALIGN_DEFAULT, bool HALFM = false>
__device__ __forceinline__ void gemm_phase(PG8_LAS unsigned char* lds, const Gemm g, const Sched& S, const Epi& E, const int tid) {
    const int wid = __builtin_amdgcn_readfirstlane(tid >> 6), lane = tid & 63, wr = wid >> 2, wc = wid & 3, fr = lane & 15, fq = lane >> 4;
    const int K = g.K, nt = K / BK;
    unsigned voffA[2], voffB[2];
#pragma unroll
    for (int i = 0; i < 2; ++i) { int R, C; stage_rc(tid * 16 + i * 8192, R, C); const int Rb = Epi::PERM ? ((R & ~31) + perm32(R & 31)) : R;
        voffA[i] = (unsigned)(R * g.lda + C) * 2u; voffB[i] = (unsigned)(Rb * g.ldb + C) * 2u; }
    const size_t kstep = (size_t)(BK * 2), kstepA = g.kstepA ? (size_t)g.kstepA : kstep;
    const size_t hstepA = (size_t)HALF * g.lda * 2, hstepB = (size_t)HALF * g.ldb * 2;
    const size_t tstepA = 2 * hstepA, tstepB = 2 * hstepB; const size_t hA1 = HALFM ? (size_t)0 : hstepA;
#define PG8_AOFF(u) ((size_t)(u).pm * tstepA + ((HALFM && (u).hm == 2) ? hstepA : (size_t)0) + ((u).pn >= g.a_split_pn ? (size_t)g.a_split_off * 2 : (size_t)0) + (size_t)(u).ks * (g.ksplitA ? (size_t)g.ksplitA : (size_t)g.ksplit * 2))
#define PG8_BOFF(u) ((size_t)(u).pn * tstepB + (size_t)(u).ks * g.ksplit * 2)
    const unsigned ldsw = (unsigned)wid * 1024u;
    const int aoff = lds_byte(wr * 64 + fr, fq * 8), boff = lds_byte(wc * 32 + fr, fq * 8);
#define PG8_SA(b, h) (((b) * 2 + (h)) * HTB)
#define PG8_SB(b, h) ((4 + (b) * 2 + (h)) * HTB)
#define PG8_STAGE(bufoff, gbase, voff) do { _Pragma("unroll") for (int _i = 0; _i < 2; ++_i) \
        __builtin_amdgcn_global_load_lds((const unsigned*)((const char*)(gbase) + (voff)[_i]), (PG8_LAS unsigned*)(lds + (bufoff) + ldsw + _i * 8192), 16, 0, 0); } while (0)
#define PG8_LDA(dst, b, h) do { _Pragma("unroll") for (int m = 0; m < 4; ++m) _Pragma("unroll") for (int k = 0; k < 2; ++k) dst[m][k] = *(const PG8_LAS bf16x8*)(lds + PG8_SA(b, h) + aoff + m * 2048 + k * 1024); } while (0)
#define PG8_LDB(dst, b, h) do { _Pragma("unroll") for (int n = 0; n < 2; ++n) _Pragma("unroll") for (int k = 0; k < 2; ++k) dst[n][k] = *(const PG8_LAS bf16x8*)(lds + PG8_SB(b, h) + boff + n * 2048 + k * 1024); } while (0)
#define PG8_MMA(ai, bj, At, Bt) do { __builtin_amdgcn_s_setprio(1); _Pragma("unroll") for (int m = 0; m < 4; ++m) _Pragma("unroll") for (int n = 0; n < 2; ++n) _Pragma("unroll") for (int k = 0; k < 2; ++k) \
        acc[ai][bj][m][n] = __builtin_amdgcn_mfma_f32_16x16x32_bf16(Bt[n][k], At[m][k], acc[ai][bj][m][n], 0, 0, 0); __builtin_amdgcn_s_setprio(0); } while (0)
#define PG8_WAIT_V(n) asm volatile("s_waitcnt vmcnt(" #n ")" ::: "memory")
#define PG8_WAIT_L(n) asm volatile("s_waitcnt lgkmcnt(" #n ")" ::: "memory")
#define PG8_BAR __builtin_amdgcn_s_barrier()
#define PG8_SCHED __builtin_amdgcn_sched_barrier(0)
    Unit cur, nxt; int ui = 0;
    if (!S.next(0, cur)) return;
    f32x4 acc[2][2][4][2];
#pragma unroll
    for (int a = 0; a < 2; ++a)
#pragma unroll
        for (int b = 0; b < 2; ++b)
#pragma unroll
            for (int m = 0; m < 4; ++m)
#pragma unroll
                for (int n = 0; n < 2; ++n) acc[a][b][m][n] = zero_quad();
    bf16x8 At[4][2], B0[2][2], B1[2][2];
    const char* cA = (const char*)g.A + PG8_AOFF(cur); const char* cB = (const char*)g.Bt + PG8_BOFF(cur);
    S.a_ready(cur);
    {
        PG8_STAGE(PG8_SB(0, 0), cB, voffB); PG8_STAGE(PG8_SB(0, 1), cB + hstepB, voffB); PG8_STAGE(PG8_SA(0, 0), cA, voffA); PG8_STAGE(PG8_SA(0, 1), cA + hA1, voffA);
        if (wr == 1) PG8_BAR;
        PG8_WAIT_V(2); PG8_BAR;
        PG8_STAGE(PG8_SB(1, 0), cB + kstep, voffB); PG8_STAGE(PG8_SA(1, 0), cA + kstepA, voffA); PG8_STAGE(PG8_SB(1, 1), cB + hstepB + kstep, voffB);
        PG8_WAIT_V(6); PG8_BAR;
    }
    for (;;) {
        const bool has_next = S.next(ui + 1, nxt);
        const char* nA = has_next ? (const char*)g.A + PG8_AOFF(nxt) : cA; const char* nB = has_next ? (const char*)g.Bt + PG8_BOFF(nxt) : cB;
        for (int t = 0; t < nt; t += 2) {
            const bool last = (t == nt - 2);
            const char* a1 = cA + (size_t)(t + 1) * kstepA;
            const char* a2 = last ? nA : cA + (size_t)(t + 2) * kstepA; const char* b2 = last ? nB : cB + (size_t)(t + 2) * kstep;
            const char* a3 = a2 + kstepA; const char* b3 = b2 + kstep;
            if (last && has_next) S.a_ready(nxt);
            {
            PG8_LDB(B0, 0, 0); PG8_LDB(B1, 0, 1); PG8_SCHED; PG8_LDA(At, 0, 0); PG8_STAGE(PG8_SA(1, 1), a1 + hA1, voffA);
            PG8_WAIT_V(8); PG8_WAIT_L(0); PG8_BAR; PG8_MMA(0, 0, At, B0); PG8_MMA(0, 1, At, B1); PG8_BAR; PG8_SCHED;
            PG8_LDA(At, 0, 1); PG8_STAGE(PG8_SB(0, 0), b2, voffB); PG8_STAGE(PG8_SB(0, 1), b2 + hstepB, voffB); PG8_STAGE(PG8_SA(0, 0), a2, voffA);
            PG8_WAIT_V(8); PG8_WAIT_L(0); PG8_BAR; if constexpr (!HALFM) { PG8_MMA(1, 0, At, B0); PG8_MMA(1, 1, At, B1); } PG8_BAR; PG8_SCHED;
            PG8_LDB(B0, 1, 0); PG8_LDB(B1, 1, 1); PG8_SCHED; PG8_LDA(At, 1, 0); PG8_STAGE(PG8_SA(0, 1), a2 + hA1, voffA);
            PG8_WAIT_V(8); PG8_WAIT_L(0); PG8_BAR; PG8_MMA(0, 0, At, B0); PG8_MMA(0, 1, At, B1); PG8_BAR; PG8_SCHED;
            PG8_LDA(At, 1, 1); PG8_STAGE(PG8_SB(1, 0), b3, voffB); PG8_STAGE(PG8_SB(1, 1), b3 + hstepB, voffB); PG8_STAGE(PG8_SA(1, 0), a3, voffA);
            PG8_WAIT_V(8); PG8_WAIT_L(0); PG8_BAR; if constexpr (!HALFM) { PG8_MMA(1, 0, At, B0); PG8_MMA(1, 1, At, B1); } PG8_BAR; PG8_SCHED;
            }
        }
        if constexpr (ALIGN_EPI) { if (wr == 0) PG8_BAR; }
        if constexpr (!Epi::AFTER_DRAIN) { E(acc, cur, wr, wc, fr, fq); S.done(cur); }
        if (!has_next) break;
#pragma unroll
        for (int a = 0; a < 2; ++a)
#pragma unroll
            for (int b = 0; b < 2; ++b)
#pragma unroll
                for (int m = 0; m < 4; ++m)
#pragma unroll
                    for (int n = 0; n < 2; ++n) acc[a][b][m][n] = zero_quad();
        cur = nxt; cA = nA; cB = nB; ++ui;
        if constexpr (ALIGN_EPI) { if (wr == 1) PG8_BAR; }
    }
    PG8_WAIT_V(0);
    if constexpr (!ALIGN_EPI) { if (wr == 0) PG8_BAR; }
    PG8_BAR;
    if constexpr (Epi::AFTER_DRAIN) { E.fused(acc, cur, wr, wc, fr, fq, lds, wid, lane); S.done(cur); }
#undef PG8_AOFF
#undef PG8_BOFF
#undef PG8_SA
#undef PG8_SB
#undef PG8_STAGE
#undef PG8_LDA
#undef PG8_LDB
#undef PG8_MMA
#undef PG8_WAIT_V
#undef PG8_WAIT_L
#undef PG8_BAR
#undef PG8_SCHED
}
}
namespace att {
typedef unsigned short bf16;
using bf16x8 = __attribute__((ext_vector_type(8))) short;
using s16x4  = __attribute__((ext_vector_type(4))) short;
using f32x16 = __attribute__((ext_vector_type(16))) float;
using f32x4  = __attribute__((ext_vector_type(4))) float;
using u32x4  = __attribute__((ext_vector_type(4))) unsigned;
constexpr int NW = 8, QBLK = 32, KVBLK = 64, DV = 128;
constexpr float THR = 8.f;
#define ATT_SBAR() __builtin_amdgcn_sched_barrier(0)
__device__ __forceinline__ int crow(int r, int hi) { return (r & 3) + 8 * (r >> 2) + 4 * hi; }
typedef float f32x2_t __attribute__((ext_vector_type(2))); typedef __bf16 bf16x2_t __attribute__((ext_vector_type(2)));
__device__ __forceinline__ unsigned cvtpk(float lo, float hi) { f32x2_t v = {lo, hi}; bf16x2_t b = __builtin_convertvector(v, bf16x2_t); return __builtin_bit_cast(unsigned, b); }
__device__ __forceinline__ float bf2f(short s) { return __uint_as_float(((unsigned)(unsigned short)s) << 16); }
__device__ __forceinline__ short f2bf(float f) { unsigned u = __float_as_uint(f); u += 0x7fffu + ((u >> 16) & 1u); return (short)(u >> 16); }

template <int DQK> struct Cfg {
    static constexpr int KROW = DQK * 2 + 16;
    static constexpr int SHM_V = KVBLK * DV * 2, SHM_K = KVBLK * KROW;
    static constexpr int OFF_V = 0, OFF_K = 2 * SHM_V, OFF_WS = 2 * SHM_V + 2 * SHM_K, BYTES = OFF_WS + NW * 64 * 4;
};

__device__ __forceinline__ void partialSM(f32x16& p0, f32x16& p1, float& m_reg, float& mn, float& alpha, const float C, const float TS) {
    float pmax = p0[0];
#pragma unroll
    for (int r = 1; r < 16; ++r) pmax = fmaxf(pmax, p0[r]);
#pragma unroll
    for (int r = 0; r < 16; ++r) pmax = fmaxf(pmax, p1[r]);
    { auto rr = __builtin_amdgcn_permlane32_swap(__float_as_uint(pmax), __float_as_uint(pmax), false, false);
      pmax = fmaxf(__uint_as_float(rr[0]), __uint_as_float(rr[1])); }
    if (__builtin_expect(__all(pmax - m_reg <= TS), 1)) { mn = m_reg; alpha = 1.f; }
    else { mn = fmaxf(m_reg, pmax); alpha = __builtin_amdgcn_exp2f((m_reg - mn) * C); m_reg = mn; }
    const float mnC = -mn * C;
#pragma unroll
    for (int r = 0; r < 16; ++r) p0[r] = fmaf(p0[r], C, mnC);
#pragma unroll
    for (int r = 0; r < 16; ++r) p1[r] = fmaf(p1[r], C, mnC);
#pragma unroll
    for (int r = 0; r < 16; ++r) p0[r] = __builtin_amdgcn_exp2f(p0[r]);
}
__device__ __forceinline__ void finishSM(f32x16& p0, f32x16& p1, float alpha, float& l_reg, bf16x8& pa0, bf16x8& pa1, bf16x8& pa2, bf16x8& pa3) {
#pragma unroll
    for (int r = 0; r < 16; ++r) p1[r] = __builtin_amdgcn_exp2f(p1[r]);
    float ps = 0;
#pragma unroll
    for (int r = 0; r < 16; ++r) ps += p0[r];
#pragma unroll
    for (int r = 0; r < 16; ++r) ps += p1[r];
    { auto rr = __builtin_amdgcn_permlane32_swap(__float_as_uint(ps), __float_as_uint(ps), false, false);
      ps = __uint_as_float(rr[0]) + __uint_as_float(rr[1]); }
    l_reg = l_reg * alpha + ps;
#define ATT_PK4(P, BASE, OUT) do { unsigned a0 = cvtpk(P[BASE + 0], P[BASE + 1]), a1 = cvtpk(P[BASE + 2], P[BASE + 3]);   \
    unsigned b0 = cvtpk(P[BASE + 4], P[BASE + 5]), b1 = cvtpk(P[BASE + 6], P[BASE + 7]);                              \
    auto r0 = __builtin_amdgcn_permlane32_swap(a0, b0, false, false); auto r1 = __builtin_amdgcn_permlane32_swap(a1, b1, false, false); \
    u32x4 w = {r0[0], r1[0], r0[1], r1[1]}; OUT = *reinterpret_cast<bf16x8*>(&w); } while (0)
    ATT_PK4(p0, 0, pa0); ATT_PK4(p0, 8, pa1); ATT_PK4(p1, 0, pa2); ATT_PK4(p1, 8, pa3);
}
template <int DQK> __device__ __forceinline__ void qkt(f32x16& p0, f32x16& p1, const char* Ks, const bf16x8* qr, int r32, int hi) {
    constexpr int KROW = Cfg<DQK>::KROW;
    p0 = f32x16{}; p1 = f32x16{};
#pragma unroll
    for (int d0 = 0; d0 < DQK / 16; ++d0) { const int cb = (d0 * 16 + hi * 8) * 2;
        const bf16x8 b0 = *reinterpret_cast<const bf16x8*>(Ks + r32 * KROW + cb);
        const bf16x8 b1 = *reinterpret_cast<const bf16x8*>(Ks + (32 + r32) * KROW + cb);
        p0 = __builtin_amdgcn_mfma_f32_32x32x16_bf16(b0, qr[d0], p0, 0, 0, 0);
        p1 = __builtin_amdgcn_mfma_f32_32x32x16_bf16(b1, qr[d0], p1, 0, 0, 0); }
}
__device__ __forceinline__ int v_st(int k, int c) { const int kk = (k & ~0xC) | ((k & 4) << 1) | ((k & 8) >> 1); return ((kk >> 3) * 4 + (c >> 5)) * 512 + ((kk & 7) * 32 + (c & 31)) * 2; }
__device__ __forceinline__ int v_rd_base(int lane) { return ((lane & 3) << 3) | (((lane >> 2) & 3) << 6) | (((lane >> 4) & 1) << 5) | (((lane >> 5) & 1) << 8); }
constexpr int v_rd_off(int d0, int ks, int half) { return d0 * 512 + ks * 4096 + half * 2048; }
template <int OFF> __device__ __forceinline__ s16x4 tr_read(int vb) { s16x4 r; asm volatile("ds_read_b64_tr_b16 %0, %1 offset:%2" : "=&v"(r) : "v"(vb), "i"(OFF) : "memory"); return r; }
template <int D0> __device__ __forceinline__ void pv_one(f32x16& od, int vb, bf16x8 pa0, bf16x8 pa1, bf16x8 pa2, bf16x8 pa3) {
    const s16x4 l0 = tr_read<v_rd_off(D0, 0, 0)>(vb), h0 = tr_read<v_rd_off(D0, 0, 1)>(vb), l1 = tr_read<v_rd_off(D0, 1, 0)>(vb), h1 = tr_read<v_rd_off(D0, 1, 1)>(vb);
    const s16x4 l2 = tr_read<v_rd_off(D0, 2, 0)>(vb), h2 = tr_read<v_rd_off(D0, 2, 1)>(vb), l3 = tr_read<v_rd_off(D0, 3, 0)>(vb), h3 = tr_read<v_rd_off(D0, 3, 1)>(vb);
    asm volatile("s_waitcnt lgkmcnt(0)" ::: "memory"); ATT_SBAR();
#define ATT_PK(L, H) (bf16x8){L[0], L[1], L[2], L[3], H[0], H[1], H[2], H[3]}
    od = __builtin_amdgcn_mfma_f32_32x32x16_bf16(pa0, ATT_PK(l0, h0), od, 0, 0, 0);
    od = __builtin_amdgcn_mfma_f32_32x32x16_bf16(pa1, ATT_PK(l1, h1), od, 0, 0, 0);
    od = __builtin_amdgcn_mfma_f32_32x32x16_bf16(pa2, ATT_PK(l2, h2), od, 0, 0, 0);
    od = __builtin_amdgcn_mfma_f32_32x32x16_bf16(pa3, ATT_PK(l3, h3), od, 0, 0, 0);
}
__device__ __forceinline__ void pv_d0(f32x16* o, int vb, bf16x8 pa0, bf16x8 pa1, bf16x8 pa2, bf16x8 pa3) {
    pv_one<0>(o[0], vb, pa0, pa1, pa2, pa3); pv_one<1>(o[1], vb, pa0, pa1, pa2, pa3); pv_one<2>(o[2], vb, pa0, pa1, pa2, pa3); pv_one<3>(o[3], vb, pa0, pa1, pa2, pa3);
}
template <int OFF> __device__ __forceinline__ bf16x8 k_read(int ka) { bf16x8 r; asm volatile("ds_read_b128 %0, %1 offset:%2" : "=&v"(r) : "v"(ka), "i"(OFF) : "memory"); return r; }
template <int N> __device__ __forceinline__ void lgk_wait() { asm volatile("s_waitcnt lgkmcnt(%0)" :: "n"(N) : "memory"); }
constexpr int CS_LA = 6;
template <int DQK, int KB, int VB, bool PV, int F> __device__ __forceinline__ void cs_read(bf16x8 (&kf)[CS_LA + 1], s16x4 (&vf)[CS_LA + 1][2], const int ka, const int vb) {
    constexpr int KROW = Cfg<DQK>::KROW, KO = KB * Cfg<DQK>::SHM_K, VO = VB * Cfg<DQK>::SHM_V, NMK = DQK / 8, NM = NMK + (PV ? 16 : 0);
    if constexpr (F < NMK) kf[F % (CS_LA + 1)] = k_read<KO + (F & 1) * 32 * KROW + (F / 2) * 32>(ka);
    else if constexpr (F < NM) { constexpr int v = F - NMK;
        vf[F % (CS_LA + 1)][0] = tr_read<VO + v_rd_off(v / 4, v % 4, 0)>(vb); vf[F % (CS_LA + 1)][1] = tr_read<VO + v_rd_off(v / 4, v % 4, 1)>(vb); }
}
template <int DQK, bool PV> constexpr int cs_outstanding(int I) {
    const int NMK = DQK / 8, NM = NMK + (PV ? 16 : 0); int n = 0;
    for (int f = I + 1; f <= I + CS_LA - 1 && f < NM; ++f) n += (f < NMK) ? 1 : 2;
    return n;
}
template <int DQK, int KB, int VB, bool PV, int I> __device__ __forceinline__ void cs_step(f32x16& p0, f32x16& p1, f32x16* o, const bf16x8* qr, bf16x8 (&kf)[CS_LA + 1], s16x4 (&vf)[CS_LA + 1][2], const int ka, const int vb, const bf16x8 (&pa)[4]) {
    constexpr int NMK = DQK / 8, NM = NMK + (PV ? 16 : 0);
    if constexpr (I < NM) {
        lgk_wait<cs_outstanding<DQK, PV>(I)>(); ATT_SBAR();
        if constexpr (I < NMK) { if constexpr ((I & 1) == 0) p0 = __builtin_amdgcn_mfma_f32_32x32x16_bf16(kf[I % (CS_LA + 1)], qr[I / 2], p0, 0, 0, 0); else p1 = __builtin_amdgcn_mfma_f32_32x32x16_bf16(kf[I % (CS_LA + 1)], qr[I / 2], p1, 0, 0, 0); }
        else { constexpr int v = I - NMK; o[v / 4] = __builtin_amdgcn_mfma_f32_32x32x16_bf16(pa[v % 4], ATT_PK(vf[I % (CS_LA + 1)][0], vf[I % (CS_LA + 1)][1]), o[v / 4], 0, 0, 0); }
        ATT_SBAR();
        cs_read<DQK, KB, VB, PV, I + CS_LA>(kf, vf, ka, vb);
    }
}
template <int DQK, int KB, int VB, bool PV>
__device__ __forceinline__ void c_segment(f32x16& p0, f32x16& p1, f32x16* o, const bf16x8* qr, const int ka, const int vb, const bf16x8 pa0, const bf16x8 pa1, const bf16x8 pa2, const bf16x8 pa3) {
    bf16x8 kf[CS_LA + 1]; s16x4 vf[CS_LA + 1][2]; const bf16x8 pa[4] = {pa0, pa1, pa2, pa3};
    __builtin_amdgcn_s_setprio(1);
    cs_read<DQK, KB, VB, PV, 0>(kf, vf, ka, vb); cs_read<DQK, KB, VB, PV, 1>(kf, vf, ka, vb); cs_read<DQK, KB, VB, PV, 2>(kf, vf, ka, vb); cs_read<DQK, KB, VB, PV, 3>(kf, vf, ka, vb);
    if constexpr (CS_LA > 4) cs_read<DQK, KB, VB, PV, 4>(kf, vf, ka, vb); if constexpr (CS_LA > 5) cs_read<DQK, KB, VB, PV, 5>(kf, vf, ka, vb); if constexpr (CS_LA > 6) cs_read<DQK, KB, VB, PV, 6>(kf, vf, ka, vb); if constexpr (CS_LA > 7) cs_read<DQK, KB, VB, PV, 7>(kf, vf, ka, vb);
    p0 = f32x16{}; p1 = f32x16{};
#define CS_S(i) cs_step<DQK, KB, VB, PV, i>(p0, p1, o, qr, kf, vf, ka, vb, pa)
    CS_S(0); CS_S(1); CS_S(2); CS_S(3); CS_S(4); CS_S(5); CS_S(6); CS_S(7); CS_S(8); CS_S(9); CS_S(10); CS_S(11); CS_S(12); CS_S(13); CS_S(14); CS_S(15); CS_S(16); CS_S(17); CS_S(18); CS_S(19);
    CS_S(20); CS_S(21); CS_S(22); CS_S(23); CS_S(24); CS_S(25); CS_S(26); CS_S(27); CS_S(28); CS_S(29); CS_S(30); CS_S(31); CS_S(32); CS_S(33); CS_S(34); CS_S(35); CS_S(36); CS_S(37); CS_S(38); CS_S(39);
#undef CS_S
    __builtin_amdgcn_s_setprio(0);
}
template <int DQK, int VB>
__device__ __forceinline__ void pv_segment(f32x16* o, const int vb, const bf16x8 pa0, const bf16x8 pa1, const bf16x8 pa2, const bf16x8 pa3) {
    constexpr int VO = VB * Cfg<DQK>::SHM_V;
    s16x4 vf[CS_LA + 1][2]; const bf16x8 pa[4] = {pa0, pa1, pa2, pa3};
#define PV_RD(v) do { if constexpr ((v) < 16) { vf[(v) % (CS_LA + 1)][0] = tr_read<VO + v_rd_off((v) / 4, (v) % 4, 0)>(vb); vf[(v) % (CS_LA + 1)][1] = tr_read<VO + v_rd_off((v) / 4, (v) % 4, 1)>(vb); } } while (0)
#define PV_S(v) do { lgk_wait<2 * (((v) + CS_LA - 1 < 16 ? (v) + CS_LA - 1 : 15) - (v))>(); ATT_SBAR(); \
    o[(v) / 4] = __builtin_amdgcn_mfma_f32_32x32x16_bf16(pa[(v) % 4], ATT_PK(vf[(v) % (CS_LA + 1)][0], vf[(v) % (CS_LA + 1)][1]), o[(v) / 4], 0, 0, 0); ATT_SBAR(); PV_RD((v) + CS_LA); } while (0)
    PV_RD(0); PV_RD(1); PV_RD(2); PV_RD(3); if constexpr (CS_LA > 4) PV_RD(4); if constexpr (CS_LA > 5) PV_RD(5); if constexpr (CS_LA > 6) PV_RD(6); if constexpr (CS_LA > 7) PV_RD(7);
    PV_S(0); PV_S(1); PV_S(2); PV_S(3); PV_S(4); PV_S(5); PV_S(6); PV_S(7); PV_S(8); PV_S(9); PV_S(10); PV_S(11); PV_S(12); PV_S(13); PV_S(14); PV_S(15);
#undef PV_RD
#undef PV_S
}
__device__ __forceinline__ void rope_pair(bf16x8& a, bf16x8& b, const float* cs, const float* sn) {
    const f32x4 c0 = *(const f32x4*)cs, c1 = *(const f32x4*)(cs + 4), s0 = *(const f32x4*)sn, s1 = *(const f32x4*)(sn + 4);
#pragma unroll
    for (int e = 0; e < 8; ++e) { const float c = e < 4 ? c0[e & 3] : c1[e & 3], s = e < 4 ? s0[e & 3] : s1[e & 3]; const float x1 = bf2f(a[e]), x2 = bf2f(b[e]);
        a[e] = f2bf(x1 * c - x2 * s); b[e] = f2bf(x2 * c + x1 * s); }
}

struct Unit {
    const bf16* Q;
    const bf16* Kn;
    const bf16* Kr;
    const bf16* V;
    int t0a, nta, t0b, ntb;
    int mask;
    int qpos0, kpos0;
    int has_sink; float sink;
    int rope;
    const float* tab;
    bf16* O;
};

template <int DQK, int SDEPTH, int LDQ, int LDKN, int LDKR, int LDV, int LDO, int VAR = 0>
__device__ __forceinline__ void attn_unit(const Unit& U, char* lds, const float scale, const int tid) {
    using C_ = Cfg<DQK>;
    constexpr int KROW = C_::KROW, SHM_V = C_::SHM_V, SHM_K = C_::SHM_K, ND = DQK / 16;
    const float C = scale * 1.4426950408889634f, TS = THR / scale;
    const int wid = __builtin_amdgcn_readfirstlane(tid >> 6), lane = tid & 63, r32 = lane & 31, hi = lane >> 5;
    char* V_lds = lds + C_::OFF_V; char* K_lds = lds + C_::OFF_K;
    float* ws = (float*)(lds + C_::OFF_WS) + wid * 64; float* li_l = ws; float* al_l = ws + 32;
    float m_reg = -1e30f, l_reg = 0; f32x16 o[4] = {}; bf16x8 qr[ND];
    const int sr = tid >> 4, sc = (tid & 15) * 8, vst0 = v_st(sr, sc), vst1 = v_st(32 + sr, sc);
    const int kr_r = tid >> 3, kr_c = (tid & 7) * 8;
    const int vb0 = (int)(uintptr_t)V_lds + v_rd_base(lane), ka0 = (int)(uintptr_t)K_lds + r32 * KROW + hi * 16;
    bf16x8 vs0, vs1, ks0, ks1, kx;
    const int NT = U.nta + U.ntb;
#define ATT_TOK(j) ((j) < U.nta ? U.t0a + (j) * KVBLK : U.t0b + ((j) - U.nta) * KVBLK)
    const unsigned offV = (unsigned)(sr * LDV + sc) * 2u, offK = (unsigned)(sr * LDKN + sc) * 2u, offR = (unsigned)(kr_r * LDKR + kr_c) * 2u;
#define ATT_LOADV(j) do { const long tk = ATT_TOK(j); const char* vb_ = (const char*)(U.V + tk * LDV); \
    vs0 = *reinterpret_cast<const bf16x8*>(vb_ + offV); vs1 = *reinterpret_cast<const bf16x8*>(vb_ + (size_t)(32 * LDV * 2) + offV); } while (0)
#define ATT_LOADK(j) do { const long tk = ATT_TOK(j); const char* kb_ = (const char*)(U.Kn + tk * LDKN); \
    ks0 = *reinterpret_cast<const bf16x8*>(kb_ + offK); ks1 = *reinterpret_cast<const bf16x8*>(kb_ + (size_t)(32 * LDKN * 2) + offK); \
    if constexpr (DQK == 192) { const char* rb_ = (const char*)(U.Kr + tk * LDKR); kx = *reinterpret_cast<const bf16x8*>(rb_ + offR); } } while (0)
#define ATT_WRITEV(b) do { *(bf16x8*)(V_lds + (b) * SHM_V + vst0) = vs0; *(bf16x8*)(V_lds + (b) * SHM_V + vst1) = vs1; } while (0)
#define ATT_WRITEK(b) do { *(bf16x8*)(K_lds + (b) * SHM_K + sr * KROW + sc * 2) = ks0; *(bf16x8*)(K_lds + (b) * SHM_K + (32 + sr) * KROW + sc * 2) = ks1; \
    if constexpr (DQK == 192) *(bf16x8*)(K_lds + (b) * SHM_K + kr_r * KROW + (128 + kr_c) * 2) = kx; } while (0)
#define ATT_VWAIT() asm volatile("s_waitcnt vmcnt(0)" ::: "memory")
#define ATT_RESC(a) do { if (__any((a) < 1.f)) { if (hi == 0) al_l[r32] = (a); asm volatile("s_waitcnt lgkmcnt(0)" ::: "memory"); \
    _Pragma("unroll") for (int d = 0; d < 4; ++d) _Pragma("unroll") for (int r = 0; r < 16; ++r) o[d][r] *= al_l[crow(r, hi)]; } } while (0)
    const int qpos = U.qpos0 + wid * QBLK + r32;
#define ATT_MASK(P0, P1, j) do { if (U.mask && (j) < U.nta) { const int kb = U.kpos0 + (j) * KVBLK + 4 * hi - qpos; \
    _Pragma("unroll") for (int r = 0; r < 16; ++r) { const int dk = kb + (r & 3) + 8 * (r >> 2); \
        if (dk > 128 || dk < -128) P0[r] = -INFINITY; if (dk + 32 > 128 || dk + 32 < -128) P1[r] = -INFINITY; } } } while (0)
#define ATT_SEAM() do { ATT_SBAR(); __syncthreads(); ATT_SBAR(); } while (0)
#define ATT_L(j) do { if constexpr ((VAR & 1) != 0) { ATT_PK4(p0, 0, pa0); ATT_PK4(p0, 8, pa1); ATT_PK4(p1, 0, pa2); ATT_PK4(p1, 8, pa3); } else { \
    ATT_MASK(p0, p1, j); partialSM(p0, p1, m_reg, mn, al, C, TS); finishSM(p0, p1, al, l_reg, pa0, pa1, pa2, pa3); ATT_RESC(al); } } while (0)
    ATT_LOADK(0); ATT_LOADV(0);
    const bf16* Qw = U.Q + (long)(wid * QBLK + r32) * LDQ + hi * 8;
#pragma unroll
    for (int d0 = 0; d0 < ND; ++d0) qr[d0] = *reinterpret_cast<const bf16x8*>(Qw + d0 * 16);
    if (U.rope) {
        const int n = U.qpos0 + wid * QBLK + r32, prow = n >> 6, pcol = n & 63;
        if constexpr (DQK == 128) {
            const float* cr = U.tab + prow * 32 + hi * 8; const float* cc = U.tab + pcol * 32 + hi * 8;
            rope_pair(qr[0], qr[2], cr, cr + 2048); rope_pair(qr[1], qr[3], cr + 16, cr + 16 + 2048);
            rope_pair(qr[4], qr[6], cc, cc + 2048); rope_pair(qr[5], qr[7], cc + 16, cc + 16 + 2048);
        } else {
            const float* cr = U.tab + prow * 16 + hi * 8; const float* cc = U.tab + pcol * 16 + hi * 8;
            rope_pair(qr[8], qr[9], cr, cr + 1024); rope_pair(qr[10], qr[11], cc, cc + 1024);
        }
    }
    f32x16 p0, p1; float mn, al; bf16x8 pa0, pa1, pa2, pa3;
    ATT_VWAIT(); ATT_WRITEK(0); ATT_LOADK(1);
    ATT_SEAM();
#define ATT_LOADK_L(j) do { if constexpr ((VAR & 2) == 0) ATT_LOADK(j); } while (0)
#define ATT_LOADV_L(j) do { if constexpr ((VAR & 2) == 0) ATT_LOADV(j); } while (0)
    if (wid >= 4) __builtin_amdgcn_s_barrier();
    ATT_SBAR();
    c_segment<DQK, 0, 0, false>(p0, p1, o, qr, ka0, vb0, pa0, pa1, pa2, pa3);
    if constexpr ((VAR & 4) == 0) { ATT_VWAIT(); ATT_WRITEK(1); ATT_WRITEV(0); }
    if (2 < NT) ATT_LOADK_L(2); ATT_LOADV_L(1);
    ATT_SEAM(); ATT_L(0); ATT_SEAM();
    for (int j = 1; j + 1 < NT; j += 2) {
        c_segment<DQK, 1, 0, true>(p0, p1, o, qr, ka0, vb0, pa0, pa1, pa2, pa3);
        if constexpr ((VAR & 4) == 0) { ATT_VWAIT(); ATT_WRITEK(0); ATT_WRITEV(1); }
        ATT_LOADK_L(j + 2); ATT_LOADV_L(j + 1);
        ATT_SEAM(); ATT_L(j); ATT_SEAM();
        c_segment<DQK, 0, 1, true>(p0, p1, o, qr, ka0, vb0, pa0, pa1, pa2, pa3);
        if constexpr ((VAR & 4) == 0) { ATT_VWAIT(); ATT_WRITEK(1); ATT_WRITEV(0); }
        if (j + 3 < NT) ATT_LOADK_L(j + 3); ATT_LOADV_L(j + 2);
        ATT_SEAM(); ATT_L(j + 1); ATT_SEAM();
    }
    c_segment<DQK, 1, 0, true>(p0, p1, o, qr, ka0, vb0, pa0, pa1, pa2, pa3);
    if constexpr ((VAR & 4) == 0) { ATT_VWAIT(); ATT_WRITEV(1); }
    ATT_SEAM(); ATT_L(NT - 1); ATT_SEAM();
    pv_segment<DQK, 1>(o, vb0, pa0, pa1, pa2, pa3);
    ATT_SBAR();
    if (wid < 4) __builtin_amdgcn_s_barrier();
    ATT_SBAR();
    if (U.has_sink) l_reg += __builtin_amdgcn_exp2f(U.sink * 1.4426950408889634f - m_reg * C);
    if (hi == 0) li_l[r32] = l_reg; asm volatile("s_waitcnt lgkmcnt(0)" ::: "memory");
    float rli[16];
#pragma unroll
    for (int r = 0; r < 16; ++r) rli[r] = __builtin_amdgcn_rcpf(li_l[crow(r, hi)]);
    bf16* Ow = U.O + (long)(wid * QBLK) * LDO;
#pragma unroll
    for (int r = 0; r < 16; ++r) { const int orow = crow(r, hi);
#pragma unroll
        for (int d0 = 0; d0 < 4; ++d0) Ow[(long)orow * LDO + d0 * 32 + r32] = (bf16)cvtpk(o[d0][r] * rli[r], 0.f); }
    __syncthreads();
#undef ATT_TOK
#undef ATT_LOADV
#undef ATT_LOADK
#undef ATT_WRITEV
#undef ATT_WRITEK
#undef ATT_VWAIT
#undef ATT_RESC
#undef ATT_MASK
#undef ATT_SEAM
#undef ATT_L
#undef ATT_LOADK_L
#undef ATT_LOADV_L
}
}

namespace gla {
using att::bf16; using att::bf16x8; using att::s16x4; using att::f32x16; using att::f32x4; using att::u32x4; using att::crow; using att::cvtpk; using att::bf2f; using att::f2bf;
constexpr int ROWB = 144;
constexpr int T_QI = 0, T_KI = 64 * ROWB, T_KIT = 2 * 64 * ROWB, T_V = 3 * 64 * ROWB  , T_BYTES = T_V + 16384  ;
constexpr int OFF_ST = 2 * T_BYTES  , OFF_DEC = OFF_ST + 128 * ROWB  , BYTES = OFF_DEC + 2 * 256;
static_assert(T_V % 16 == 0 && T_BYTES % 16 == 0 && OFF_ST % 16 == 0 && BYTES <= 131072, "gla LDS map");
struct Unit {
    const bf16* P; int ldp;
    const float* wg; const float* bg;
    bf16* og;
    int b, h, dir;
};
__device__ __forceinline__ float log_sigmoid(float z) { return fminf(z, 0.f) - __logf(1.f + __expf(-fabsf(z))); }
template <int CTRL, int ROWMASK> __device__ __forceinline__ float dpp_add(float v) { return v + __int_as_float(__builtin_amdgcn_update_dpp(0, __float_as_int(v), CTRL, ROWMASK, 0xf, false)); }
__device__ __forceinline__ float wave_prefix(float v) {
    v = dpp_add<0x111, 0xf>(v); v = dpp_add<0x112, 0xf>(v); v = dpp_add<0x114, 0xf>(v); v = dpp_add<0x118, 0xf>(v);
    v = dpp_add<0x142, 0xa>(v);
    v = dpp_add<0x143, 0xc>(v);
    return v;
}

__device__ __forceinline__ void gla_unit(const Unit& U, char* lds, const int tid) {
    const int wid = __builtin_amdgcn_readfirstlane(tid >> 6), lane = tid & 63, r32 = lane & 31, hi = lane >> 5;
    const int h = U.h, dir = U.dir;
    for (int i = tid; i < 128 * ROWB / 4; i += 512) ((unsigned*)(lds + OFF_ST))[i] = 0u;
#define GLA_TB(s) ((s) < 4 ? NLAT + U.b * CTX + 64 * (dir ? 3 - (s) : (s)) : U.b * SEQ + 64 * (dir ? 67 - (s) : (s) - 4))
#define GLA_TOK(tb, i) ((long)((tb) + (dir ? 63 - (i) : (i))))
    if (wid < 4) {
        typedef short s16x4v __attribute__((ext_vector_type(4)));
        const int w = wid, pt = tid, t16 = lane & 15, dq = lane >> 4;
        s16x4v wa; f32x4 bias4;
#pragma unroll
        for (int e = 0; e < 4; ++e) { wa[e] = f2bf(U.wg[(4 * dq + e) * 256 + h * 64 + 16 * w + t16]); bias4[e] = U.bg[h * 64 + 16 * w + 4 * dq + e]; }
        s16x4v qr_[4], kr_[4], gr_[4]; bf16x8 vv[4];
#define GLA_LOAD(s) do { const int tb_ = GLA_TB(s); \
    _Pragma("unroll") for (int b4 = 0; b4 < 4; ++b4) { const bf16* row = U.P + GLA_TOK(tb_, 16 * b4 + t16) * U.ldp; \
        qr_[b4] = *reinterpret_cast<const s16x4v*>(row + C_GQ + h * 64 + 16 * w + 4 * dq); kr_[b4] = *reinterpret_cast<const s16x4v*>(row + C_GK + h * 64 + 16 * w + 4 * dq); \
        gr_[b4] = *reinterpret_cast<const s16x4v*>(row + C_GLR + dir * 16 + 4 * dq); } \
    _Pragma("unroll") for (int c_ = 0; c_ < 4; ++c_) { const int ch = pt + 256 * c_; vv[c_] = *reinterpret_cast<const bf16x8*>(U.P + GLA_TOK(tb_, ch >> 4) * U.ldp + C_GV + h * 128 + (ch & 15) * 8); } } while (0)
#define GLA_PREP(buf) do { char* T = lds + (buf) * T_BYTES; \
    f32x4 carry = {0.f, 0.f, 0.f, 0.f}; \
    _Pragma("unroll") for (int b4 = 0; b4 < 4; ++b4) { const int irow = 16 * b4 + t16; \
        f32x4 z = __builtin_amdgcn_mfma_f32_16x16x16bf16_1k(wa, gr_[b4], bias4, 0, 0, 0);            \
        s16x4v qo, ko; \
        _Pragma("unroll") for (int r = 0; r < 4; ++r) { float v = log_sigmoid(z[r]) * (1.f / 16.f); \
            v = dpp_add<0x111, 0xf>(v); v = dpp_add<0x112, 0xf>(v); v = dpp_add<0x114, 0xf>(v); v = dpp_add<0x118, 0xf>(v);     \
            v += carry[r]; carry[r] = __int_as_float(__builtin_amdgcn_ds_swizzle(__float_as_int(v), 0x1F0));                    \
            const short ks = f2bf(bf2f(kr_[b4][r]) * __expf(-v)); \
            qo[r] = f2bf(bf2f(qr_[b4][r]) * 0.125f * __expf(v)); ko[r] = ks; \
            *(short*)(T + T_KIT + (16 * w + 4 * dq + r) * ROWB + irow * 2) = ks; } \
        *(s16x4v*)(T + T_QI + irow * ROWB + (16 * w + 4 * dq) * 2) = qo; *(s16x4v*)(T + T_KI + irow * ROWB + (16 * w + 4 * dq) * 2) = ko; } \
    if (t16 == 0) { f32x4 dv; _Pragma("unroll") for (int r = 0; r < 4; ++r) dv[r] = __expf(carry[r]); *(f32x4*)(lds + OFF_DEC + (buf) * 256 + (16 * w + 4 * dq) * 4) = dv; } \
    _Pragma("unroll") for (int c_ = 0; c_ < 4; ++c_) { const int ch = pt + 256 * c_; *(bf16x8*)(T + T_V + att::v_st(ch >> 4, (ch & 15) * 8)) = vv[c_]; } } while (0)
        GLA_LOAD(0); GLA_PREP(0); GLA_LOAD(1);
        __syncthreads();
        for (int s = 0; s < 68; ++s) {
            if (s + 1 < 68) { GLA_PREP((s + 1) & 1); if (s + 2 < 68) GLA_LOAD(s + 2); }
            __syncthreads();
            __syncthreads();
        }
#undef GLA_LOAD
#undef GLA_PREP
    } else {
        const int m = wid - 4, rh = m & 1, ebp = m >> 1;
        f32x16 S0 = {}, S1 = {};
        __syncthreads();
        for (int s = 0; s < 68; ++s) {
            const int tb = GLA_TB(s); const char* T = lds + (s & 1) * T_BYTES; const float* DEC = (const float*)(lds + OFF_DEC + (s & 1) * 256);
            const int vb = (int)(uintptr_t)(T + T_V) + att::v_rd_base(lane) + (2 * ebp) * 512;
            bf16x8 qf[4];
#pragma unroll
            for (int d0 = 0; d0 < 4; ++d0) qf[d0] = *reinterpret_cast<const bf16x8*>(T + T_QI + (rh * 32 + r32) * ROWB + (d0 * 16 + hi * 8) * 2);
            f32x16 p0 = {}, p1 = {};
#pragma unroll
            for (int d0 = 0; d0 < 4; ++d0) { const int cb = (d0 * 16 + hi * 8) * 2;
                const bf16x8 ka = *reinterpret_cast<const bf16x8*>(T + T_KI + r32 * ROWB + cb), kb = *reinterpret_cast<const bf16x8*>(T + T_KI + (32 + r32) * ROWB + cb);
                p0 = __builtin_amdgcn_mfma_f32_32x32x16_bf16(ka, qf[d0], p0, 0, 0, 0); p1 = __builtin_amdgcn_mfma_f32_32x32x16_bf16(kb, qf[d0], p1, 0, 0, 0); }
            { const int irow = rh * 32 + r32 - dir;
#pragma unroll
              for (int r = 0; r < 16; ++r) { const int mm = crow(r, hi); if (mm > irow) p0[r] = 0.f; if (mm + 32 > irow) p1[r] = 0.f; } }
            bf16x8 pa0, pa1, pa2, pa3;
            ATT_PK4(p0, 0, pa0); ATT_PK4(p0, 8, pa1); ATT_PK4(p1, 0, pa2); ATT_PK4(p1, 8, pa3);
            bf16x8 kf[4];
#pragma unroll
            for (int ks = 0; ks < 4; ++ks) kf[ks] = *reinterpret_cast<const bf16x8*>(T + T_KIT + (rh * 32 + r32) * ROWB + (ks * 16 + hi * 8) * 2);
            float dec[16];
#pragma unroll
            for (int r = 0; r < 16; ++r) dec[r] = DEC[rh * 32 + crow(r, hi)];
#pragma unroll
            for (int eb2 = 0; eb2 < 2; ++eb2) { const int eb = 2 * ebp + eb2;
                f32x16 o = {};
                att::pv_one<0>(o, vb + eb2 * 512, pa0, pa1, pa2, pa3);
#pragma unroll
                for (int d0 = 0; d0 < 4; ++d0) { const bf16x8 sf = *reinterpret_cast<const bf16x8*>(lds + OFF_ST + (eb * 32 + r32) * ROWB + (d0 * 16 + hi * 8) * 2);
                    o = __builtin_amdgcn_mfma_f32_32x32x16_bf16(qf[d0], sf, o, 0, 0, 0); }
#pragma unroll
                for (int r = 0; r < 16; ++r) U.og[GLA_TOK(tb, rh * 32 + crow(r, hi)) * 512 + h * 128 + eb * 32 + r32] = (bf16)att::cvtpk(o[r], 0.f);
                if (eb2 == 0) { att::pv_one<0>(S0, vb, kf[0], kf[1], kf[2], kf[3]);
#pragma unroll
                    for (int r = 0; r < 16; ++r) S0[r] *= dec[r]; }
                else { att::pv_one<0>(S1, vb + 512, kf[0], kf[1], kf[2], kf[3]);
#pragma unroll
                    for (int r = 0; r < 16; ++r) S1[r] *= dec[r]; }
            }
            __syncthreads();
#pragma unroll
            for (int g = 0; g < 4; ++g) { uint2 wv; wv.x = cvtpk(S0[4 * g], S0[4 * g + 1]); wv.y = cvtpk(S0[4 * g + 2], S0[4 * g + 3]);
                *(uint2*)(lds + OFF_ST + ((2 * ebp) * 32 + r32) * ROWB + (rh * 32 + 8 * g + 4 * hi) * 2) = wv;
                uint2 wu; wu.x = cvtpk(S1[4 * g], S1[4 * g + 1]); wu.y = cvtpk(S1[4 * g + 2], S1[4 * g + 3]);
                *(uint2*)(lds + OFF_ST + ((2 * ebp + 1) * 32 + r32) * ROWB + (rh * 32 + 8 * g + 4 * hi) * 2) = wu; }
            __syncthreads();
        }
    }
    __syncthreads();
#undef GLA_TB
#undef GLA_TOK
}
}

constexpr size_t MiB = 1u << 20;
constexpr size_t WS_CTL = 0, CTL_BYTES = 1 * MiB;
constexpr size_t WS_SSQ = 1 * MiB;
constexpr size_t MOD_BYTES = (size_t)DEPTH * 9 * NMOD * D_MODEL * 4;
constexpr size_t ZERO_BYTES = 3 * MiB;
static_assert(WS_SSQ + (size_t)DEPTH * 2 * NTOK * 4 <= ZERO_BYTES, "zeroed region");
constexpr size_t WS_TAB = 3 * MiB;
constexpr size_t WS_RSTD = WS_TAB + 64 * 1024;
constexpr size_t WS_W = 4 * MiB;
constexpr size_t W_IN = 0, W_UQKV = W_IN + (size_t)IN_WP * D_MODEL * 2, W_OUT = W_UQKV + (size_t)(UQ_WP + UKV_W) * 512 * 2, W_GU = W_OUT + (size_t)D_MODEL * D_MODEL * 2,
                 W_DOWN = W_GU + (size_t)2 * FFN * D_MODEL * 2, W_LAYER = W_DOWN + (size_t)D_MODEL * FFN * 2;
constexpr size_t WS_H = WS_W + DEPTH * W_LAYER;
constexpr size_t WS_MIX = WS_H + (size_t)NTOK * D_MODEL * 2;
constexpr size_t WS_XC = WS_MIX + (size_t)NTOK * D_MODEL * 2;
constexpr size_t WS_R1 = WS_XC + (size_t)NCTX * D_MODEL * 4;
constexpr size_t WS_P = WS_R1, WS_Q = WS_P + (size_t)NTOK * IN_WP * 2, WS_KV = WS_Q + (size_t)NTOK * UQ_WP * 2, WS_GOF = WS_KV + (size_t)NTOK * UKV_W * 2,
                 WS_GOB = WS_GOF + (size_t)NTOK * 512 * 4, WS_R1_END = WS_GOB + (size_t)NTOK * 512 * 4;
constexpr size_t WS_ACT = WS_R1;
static_assert(WS_ACT + (size_t)NTOK * FFN * 2 <= WS_R1_END, "ACT overlay fits");
constexpr size_t WS_PART = WS_R1_END;
constexpr size_t WS_XS = WS_PART + (size_t)4 * NCTX * D_MODEL * 4;
constexpr size_t WS_MODX = WS_XS + 2 * MiB;
constexpr size_t WS_END = WS_MODX + 2 * MiB;
static_assert(W_LAYER % 256 == 0 && WS_H % 256 == 0 && WS_R1 % 256 == 0 && WS_Q % 256 == 0 && WS_KV % 256 == 0 && WS_GOF % 256 == 0, "alignment");
constexpr int CW_BAR = 4096;
constexpr int CW_PANEL = 32768;
constexpr int CW_QUEUE = 16384;
constexpr int RING_BYTES = 131072, LDSCTL_OFF = RING_BYTES, LDS_BYTES = 147456;

#define GAS __attribute__((address_space(1)))
#define LAS __attribute__((address_space(3)))
typedef unsigned short bf16;
typedef unsigned v4u __attribute__((ext_vector_type(4)));
typedef unsigned v2u __attribute__((ext_vector_type(2)));
typedef float f32x4 __attribute__((ext_vector_type(4)));
#define LDS_WAIT() asm volatile("s_waitcnt lgkmcnt(0)" ::: "memory")
__device__ __forceinline__ unsigned f2bf(float f) { unsigned u = __builtin_bit_cast(unsigned, f); return (u + 0x7fffu + ((u >> 16) & 1u)) >> 16; }
__device__ __forceinline__ unsigned pk2(float lo, float hi) { return f2bf(lo) | (f2bf(hi) << 16); }
__device__ __forceinline__ float bflo(unsigned w) { return __uint_as_float(w << 16); }
__device__ __forceinline__ float bfhi(unsigned w) { return __uint_as_float(w & 0xffff0000u); }
template <int O> __device__ __forceinline__ float swz_xor(float v) { return __int_as_float(__builtin_amdgcn_ds_swizzle(__float_as_int(v), (O << 10) | 0x1f)); }
__device__ __forceinline__ float sum16(float v) { v += swz_xor<1>(v); v += swz_xor<2>(v); v += swz_xor<4>(v); v += swz_xor<8>(v); return v; }
__device__ __forceinline__ float sum32(float v) { v = sum16(v); v += swz_xor<16>(v); return v; }
__device__ __forceinline__ float wave_sum(float v) { v = sum32(v); auto rr = __builtin_amdgcn_permlane32_swap(__float_as_uint(v), __float_as_uint(v), false, false); return __uint_as_float(rr[0]) + __uint_as_float(rr[1]); }

#define XB_TMO      128
#define XB_XCNT(j)  (256  + 64 * (j))
#define XB_XSUB(j)  (1280 + 64 * (j))
#define XB_XGEN(j)  (2304 + 64 * (j))
#define XB_TOP      3328
#define XB_TOPGEN   3392
#define XCD_BAR_WORDS 3456
#define XB_SPIN_CAP (1u << 21)
__device__ __forceinline__ unsigned xb_ld(unsigned* p)              { return __hip_atomic_load(p, __ATOMIC_RELAXED, __HIP_MEMORY_SCOPE_AGENT); }
__device__ __forceinline__ unsigned xb_add(unsigned* p, unsigned v) { return __hip_atomic_fetch_add(p, v, __ATOMIC_RELAXED, __HIP_MEMORY_SCOPE_AGENT); }
__device__ __forceinline__ unsigned xb_xcc_id() { return (unsigned)__builtin_amdgcn_s_getreg((3 << 11) | 20) & 0xFu; }
#define XB_SPIN(cond, bar) do { unsigned _sp = 0; while (cond) { __builtin_amdgcn_s_sleep(1); \
    if ((++_sp & 255u) == 0u) { if (xb_ld(&(bar)[XB_TMO])) break; if (_sp > XB_SPIN_CAP) { atomicAdd(&(bar)[XB_TMO], 1u); break; } } } } while (0)
struct XcdBarrier { unsigned* bar; unsigned x; volatile LAS unsigned* st; };
__device__ __forceinline__ XcdBarrier xcd_barrier_post(unsigned* bar, volatile LAS unsigned* st) {
    XcdBarrier b; b.bar = bar; b.x = xb_xcc_id(); b.st = st;
    if (threadIdx.x == 0) (void)xb_add(&bar[XB_XCNT(b.x)], 1u);
    return b;
}
__device__ __forceinline__ void xcd_barrier_complete(unsigned* bar, unsigned x, unsigned& nloc, unsigned& nx) {
    const unsigned G = gridDim.x * gridDim.y * gridDim.z;
    unsigned sum, cnt, mine, sp = 0u;
    for (;;) {
        sum = 0u; cnt = 0u; mine = 0u;
#pragma unroll
        for (unsigned j = 0; j < 16; ++j) { const unsigned c = xb_ld(&bar[XB_XCNT(j)]); sum += c; cnt += (c > 0u) ? 1u : 0u; mine = (j == x) ? c : mine; }
        if (sum == G) break;
        __builtin_amdgcn_s_sleep(1);
        if ((++sp & 255u) == 0u) { if (xb_ld(&bar[XB_TMO])) break; if (sp > XB_SPIN_CAP) { atomicAdd(&bar[XB_TMO], 1u); break; } }
    }
    nloc = mine > 0u ? mine : 1u; nx = cnt > 0u ? cnt : 1u;
}
__device__ __forceinline__ void xcd_barrier(const XcdBarrier& b) {
    asm volatile("s_waitcnt vmcnt(0)" ::: "memory");
    __syncthreads();
    if (threadIdx.x == 0) {
        unsigned* bar = b.bar;
        const unsigned bx_ = (unsigned)__builtin_amdgcn_readfirstlane((int)xb_xcc_id());
        __builtin_amdgcn_s_waitcnt(0);
        unsigned nloc = b.st[0], nx = b.st[1];
        if (nloc == 0u) { xcd_barrier_complete(bar, bx_, nloc, nx); b.st[0] = nloc; b.st[1] = nx; }
        const unsigned old = xb_add(&bar[XB_XSUB(bx_)], 1u);
        const unsigned gen = old / nloc;
        if (old + 1u == (gen + 1u) * nloc) {
            __builtin_amdgcn_fence(__ATOMIC_RELEASE, "agent");
            asm volatile("s_waitcnt vmcnt(0)" ::: "memory");
            const unsigned og = xb_add(&bar[XB_TOP], 1u);
            const unsigned tg = og / nx;
            if (og + 1u == (tg + 1u) * nx) xb_add(&bar[XB_TOPGEN], 1u);
            else XB_SPIN(xb_ld(&bar[XB_TOPGEN]) == tg, bar);
            __builtin_amdgcn_fence(__ATOMIC_ACQUIRE, "agent");
            xb_add(&bar[XB_XGEN(bx_)], 1u);
            asm volatile("s_waitcnt vmcnt(0)" ::: "memory");
        } else {
            XB_SPIN(xb_ld(&bar[XB_XGEN(bx_)]) == gen, bar);
            __builtin_amdgcn_fence(__ATOMIC_ACQUIRE, "agent");
            asm volatile("s_waitcnt vmcnt(0)" ::: "memory");
        }
    }
    __syncthreads();
}

constexpr int NWAVES = 8;
struct Ptrs {
    const float *x, *c, *ctx, *c_ctx, *w_mod, *b_mod, *g_mix, *g_ffn, *w_in, *g_mla_q, *g_mla_kv, *w_mla_uq, *w_mla_ukv, *swa_sink, *w_gate_f, *b_gate_f, *w_gate_b, *b_gate_b, *g_gla_out,
                *w_out, *w_ffn_gu, *w_ffn_down, *g_final;
    float* out; unsigned char* ws;
};

template <bool INMAP = false>
__device__ __forceinline__ void transpose_item(const float* W, int K, int N, bf16* WT, int drow0, int k0, int n0, const float* kscale, LAS float* scr, int lane) {
    const int kk = lane >> 3, n4 = (lane & 7) * 4;
    f32x4 v[8];
#pragma unroll
    for (int i = 0; i < 8; ++i) v[i] = __builtin_nontemporal_load((const f32x4*)(W + (size_t)(k0 + 8 * i + kk) * N + n0 + n4));
#pragma unroll
    for (int i = 0; i < 8; ++i) { const int k = 8 * i + kk; f32x4 x = v[i]; if (kscale) x = x * kscale[k0 + k];
        scr[k * 33 + n4] = x.x; scr[k * 33 + n4 + 1] = x.y; scr[k * 33 + n4 + 2] = x.z; scr[k * 33 + n4 + 3] = x.w; }
    LDS_WAIT(); asm volatile("" ::: "memory");
    const int c = lane & 7;
#pragma unroll
    for (int j = 0; j < 4; ++j) { const int n = (lane >> 3) + 8 * j; const LAS float* s = scr + (8 * c) * 33 + n;
        v4u o; o.x = pk2(s[0 * 33], s[1 * 33]); o.y = pk2(s[2 * 33], s[3 * 33]); o.z = pk2(s[4 * 33], s[5 * 33]); o.w = pk2(s[6 * 33], s[7 * 33]);
        const int drow = INMAP ? pg8::w_in_row(drow0 + n) : drow0 + n;
        *(GAS v4u*)(WT + (size_t)drow * K + k0 + 8 * c) = o; }
    LDS_WAIT(); asm volatile("" ::: "memory");
}
constexpr int TI_IN = 32 * 123, TI_UQ = 8 * 36, TI_UKV = 8 * 48, TI_OUT = 32 * 64, TI_GU = 32 * 352, TI_DOWN = 88 * 64, TI_LAYER = TI_IN + TI_UQ + TI_UKV + TI_OUT + TI_GU + TI_DOWN, TI_EARLY = TI_IN + TI_UQ + TI_UKV;

__device__ __forceinline__ void sincos_d(double a, double& s, double& c) {
    const double TWO_PI = 6.283185307179586476925287, INV = 0.15915494309189533576888;
    const double k = __builtin_rint(a * INV); const double r = a - k * TWO_PI, r2 = r * r;
    double ts = 1.0, tc = 1.0;
#pragma unroll
    for (int n = 12; n >= 1; --n) { ts = 1.0 - ts * r2 / (double)((2 * n) * (2 * n + 1)); tc = 1.0 - tc * r2 / (double)((2 * n - 1) * (2 * n)); }
    s = r * ts; c = tc;
}

__device__ __forceinline__ void norm_rows(const float* xl, const float* xc, int M, bf16* H, const float* g, const float* modl, int ch_shift, int ch_scale, int gw, int NGW, int lane, const float* part, float* xc_out, int row_begin) {
    for (int row = row_begin + 2 * gw; row < M; row += 2 * NGW) {
        const bool lat = row < NLAT; const int gi = lat ? (row >> 12) : BATCH;
        const float* xr = lat ? xl + (size_t)row * D_MODEL : xc + (size_t)(row - NLAT) * D_MODEL;
        const float* sh = modl + (size_t)gi * (NMOD * D_MODEL) + ch_shift * D_MODEL; const float* sc = modl + (size_t)gi * (NMOD * D_MODEL) + ch_scale * D_MODEL;
        f32x4 v[2][8]; float ss[2] = {0.f, 0.f};
#pragma unroll
        for (int r = 0; r < 2; ++r)
#pragma unroll
            for (int j = 0; j < 8; ++j) v[r][j] = *(const f32x4*)(xr + (size_t)r * D_MODEL + 4 * lane + 256 * j);
        if (!lat && part) {
#pragma unroll
            for (int r = 0; r < 2; ++r) { const float* pr = part + (size_t)(row + r - NLAT) * D_MODEL + 4 * lane; float* xo = xc_out + (size_t)(row + r - NLAT) * D_MODEL + 4 * lane;
#pragma unroll
                for (int j = 0; j < 8; ++j) { const f32x4 p0 = *(const f32x4*)(pr + 256 * j), p1 = *(const f32x4*)(pr + (size_t)NCTX * D_MODEL + 256 * j), p2 = *(const f32x4*)(pr + (size_t)2 * NCTX * D_MODEL + 256 * j), p3 = *(const f32x4*)(pr + (size_t)3 * NCTX * D_MODEL + 256 * j);
                    v[r][j] = v[r][j] + ((p0 + p1) + (p2 + p3)); *(f32x4*)(xo + 256 * j) = v[r][j]; } }
        }
#pragma unroll
        for (int r = 0; r < 2; ++r)
#pragma unroll
            for (int j = 0; j < 8; ++j) ss[r] += (v[r][j].x * v[r][j].x + v[r][j].y * v[r][j].y) + (v[r][j].z * v[r][j].z + v[r][j].w * v[r][j].w);
        const float rstd0 = 1.f / sqrtf(wave_sum(ss[0]) * (1.f / D_MODEL) + EPS), rstd1 = 1.f / sqrtf(wave_sum(ss[1]) * (1.f / D_MODEL) + EPS);
        bf16* hr = H + (size_t)row * D_MODEL;
#pragma unroll
        for (int j = 0; j < 8; ++j) { const int col = 4 * lane + 256 * j; const f32x4 gv = *(const f32x4*)(g + col), sv = *(const f32x4*)(sc + col), hv = *(const f32x4*)(sh + col);
            const f32x4 gs = gv * (sv + 1.f);
            const f32x4 y0 = (v[0][j] * rstd0) * gs + hv, y1 = (v[1][j] * rstd1) * gs + hv;
            v2u o0; o0.x = pk2(y0.x, y0.y); o0.y = pk2(y0.z, y0.w); *(v2u*)(hr + col) = o0;
            v2u o1; o1.x = pk2(y1.x, y1.y); o1.y = pk2(y1.z, y1.w); *(v2u*)(hr + D_MODEL + col) = o1; }
    }
}
#ifndef DUP_G5
#define DUP_G5 1
#endif
#ifndef ACT_TILED
#define ACT_TILED 1
#endif
#ifndef EN_CONV
#define EN_CONV 1
#endif
#ifndef FUSE_NORM
#define FUSE_NORM 1
#endif
#ifndef BURN_MFMA
#define BURN_MFMA 0
#endif
#ifndef WGM_G1
#define WGM_G1 4
#endif
#ifndef WGM_G2
#define WGM_G2 8
#endif
#ifndef WGM_G4
#define WGM_G4 4
#endif
#ifndef REV_G5
#define REV_G5 1
#endif
#ifndef WGM_RES
#define WGM_RES 4
#endif
#ifndef DUP_G5
#define DUP_G5 1
#endif
#ifndef STAG_ON
#define STAG_ON 0
#endif
#ifndef DUP_MLA
#define DUP_MLA 1
#endif
#ifndef DUP_SWA
#define DUP_SWA 1
#endif
#ifndef DUP_P0T
#define DUP_P0T 1
#endif
#ifndef DUP_N1
#define DUP_N1 1
#endif
#ifndef DUP_G1
#define DUP_G1 1
#endif
#ifndef DUP_G2
#define DUP_G2 1
#endif
#ifndef DUP_GLA
#define DUP_GLA 1
#endif
#ifndef DUP_GL2
#define DUP_GL2 1
#endif
#ifndef DUP_N2
#define DUP_N2 1
#endif
#ifndef DUP_G4
#define DUP_G4 1
#endif
#ifndef EN_P0
#define EN_P0 1
#endif
#ifndef EN_N1
#define EN_N1 1
#endif
#ifndef EN_G1
#define EN_G1 1
#endif
#ifndef EN_GL1
#define EN_GL1 1
#endif
#ifndef EN_G2
#define EN_G2 1
#endif
#ifndef EN_MIX
#define EN_MIX 1
#endif
#ifndef EN_GL2
#define EN_GL2 1
#endif
#ifndef HALVE_LAST
#define HALVE_LAST 1
#endif
#ifndef PROBE_ATT
#define PROBE_ATT 0
#endif
#ifndef PROBE_ATT_VAR
#define PROBE_ATT_VAR 0
#endif
#ifndef EN_G3
#define EN_G3 1
#endif
#ifndef EN_N2
#define EN_N2 1
#endif
#ifndef EN_G4
#define EN_G4 1
#endif
#ifndef EN_G5
#define EN_G5 1
#endif
#ifndef EN_GLA
#define EN_GLA 1
#endif
#ifndef EN_MLA
#define EN_MLA 1
#endif
#ifndef EN_SWA
#define EN_SWA 1
#endif
#define CONVERT_ITEM(lc, rr) do { const int cl_ = (lc); int r = (rr); \
            bf16* wl = (bf16*)(ws + WS_W + (size_t)cl_ * W_LAYER); \
            if (r < TI_IN) { const int kb = r / 123, nb = r % 123; transpose_item<true>(AP->w_in + (size_t)cl_ * D_MODEL * IN_W, D_MODEL, IN_W, (bf16*)((char*)wl + W_IN), 32 * nb, 64 * kb, 32 * nb, nullptr, scr, lane); break; } r -= TI_IN; \
            if (r < TI_UQ) { const int kb = r / 36, nb = r % 36; transpose_item(AP->w_mla_uq + (size_t)cl_ * 512 * UQ_W, 512, UQ_W, (bf16*)((char*)wl + W_UQKV), 32 * nb, 64 * kb, 32 * nb, AP->g_mla_q + cl_ * 512, scr, lane); break; } r -= TI_UQ; \
            if (r < TI_UKV) { const int kb = r / 48, nb = r % 48; transpose_item(AP->w_mla_ukv + (size_t)cl_ * 512 * UKV_W, 512, UKV_W, (bf16*)((char*)wl + W_UQKV), UQ_WP + 32 * nb, 64 * kb, 32 * nb, AP->g_mla_kv + cl_ * 512, scr, lane); break; } r -= TI_UKV; \
            if (r < TI_OUT) { const int kb = r / 64, nb = r % 64; transpose_item(AP->w_out + (size_t)cl_ * D_MODEL * D_MODEL, D_MODEL, D_MODEL, (bf16*)((char*)wl + W_OUT), 32 * nb, 64 * kb, 32 * nb, nullptr, scr, lane); break; } r -= TI_OUT; \
            if (r < TI_GU) { const int kb = r / 352, nb = r % 352; const int n0 = 32 * nb; const int j = n0 < FFN ? n0 : n0 - FFN; const int drow = (j >> 7) * 256 + (n0 < FFN ? 0 : 128) + (j & 127); \
                transpose_item(AP->w_ffn_gu + (size_t)cl_ * D_MODEL * 2 * FFN, D_MODEL, 2 * FFN, (bf16*)((char*)wl + W_GU), drow, 64 * kb, n0, nullptr, scr, lane); break; } r -= TI_GU; \
            { const int kb = r / 64, nb = r % 64; transpose_item(AP->w_ffn_down + (size_t)cl_ * FFN * D_MODEL, FFN, D_MODEL, (bf16*)((char*)wl + W_DOWN), 32 * nb, 64 * kb, 32 * nb, nullptr, scr, lane); } \
    } while (0)
__global__ void __launch_bounds__(NWAVES * 64, 2) fwd_kernel(Ptrs A) {
    extern __shared__ __attribute__((aligned(16))) unsigned char lds_raw[];
    LAS unsigned char* lds = (LAS unsigned char*)lds_raw;
    const int G = gridDim.x, bx = blockIdx.x, NGW = G * NWAVES;
    const int vcu = (G % 8 == 0) ? (bx % 8) * (G / 8) + bx / 8 : bx;
#define STAGGER(nunits_, T_) do { if (STAG_ON) { const int r_ = (nunits_) % G; const int lg_ = bx >> 6, lgfree_ = (r_ + 63) >> 6; \
    if (r_ != 0 && lg_ >= lgfree_) { const unsigned long long w_ = (unsigned long long)((lg_ - lgfree_ + 1) * (T_) / (4 - lgfree_ + 1)); const unsigned long long t0_ = __builtin_amdgcn_s_memrealtime(); \
        while (__builtin_amdgcn_s_memrealtime() - t0_ < w_) __builtin_amdgcn_s_sleep(8); } } } while (0)
typedef const __attribute__((address_space(4))) Ptrs* KArgP;
#define PHASE_IDS() int tid = threadIdx.x; asm volatile("" : "+v"(tid)); const int lane = tid & 63, wave = __builtin_amdgcn_readfirstlane(tid >> 6), gw = vcu * NWAVES + wave; (void)lane; (void)gw; \
    KArgP AP = (KArgP)__builtin_amdgcn_kernarg_segment_ptr(); asm volatile("" : "+s"(AP)); \
    unsigned char* const ws = AP->ws; unsigned* const ctl = (unsigned*)(ws + WS_CTL); float* const MOD = (float*)(ws + WS_MODX); float* const SSQ = (float*)(ws + WS_SSQ) + (size_t)l * 2 * NTOK; (void)SSQ; float* const TAB32 = (float*)(ws + WS_TAB); float* const TAB16 = TAB32 + 4096; \
    float* const RSTDQ = (float*)(ws + WS_RSTD); float* const RSTDKV = RSTDQ + NTOK; bf16* const Hb = (bf16*)(ws + WS_H); bf16* const MIX = (bf16*)(ws + WS_MIX); float* const XC = (float*)(ws + WS_XC); \
    bf16* const Pb = (bf16*)(ws + WS_P); bf16* const Qb = (bf16*)(ws + WS_Q); bf16* const KVb = (bf16*)(ws + WS_KV); bf16* const GOF = (bf16*)(ws + WS_GOF); bf16* const GOB = (bf16*)(ws + WS_GOB); bf16* const ACT = (bf16*)(ws + WS_ACT); float* const PART = (float*)(ws + WS_PART); (void)PART; \
    const float* const modl = MOD + (size_t)l * 9 * (NMOD * D_MODEL); const float* const xl_in = (l == 0) ? AP->x : AP->out; const float* const xc_in = (l == 0) ? AP->ctx : XC; \
    const char* const wl = (const char*)(ws + WS_W + (size_t)l * W_LAYER); \
    (void)ctl; (void)MOD; (void)TAB32; (void)TAB16; (void)RSTDQ; (void)RSTDKV; (void)Hb; (void)MIX; (void)XC; (void)Pb; (void)Qb; (void)KVb; (void)GOF; (void)GOB; (void)ACT; (void)modl; (void)xl_in; (void)xc_in; (void)wl
    volatile LAS unsigned* LCTL = (volatile LAS unsigned*)(lds + LDSCTL_OFF);
    for (int u = threadIdx.x; u < (LDS_BYTES - LDSCTL_OFF) / 4; u += NWAVES * 64) LCTL[u] = 0u;
    __syncthreads();
    XcdBarrier bar = xcd_barrier_post((unsigned*)(A.ws + WS_CTL) + CW_BAR, LCTL);
#define GRID_BAR() xcd_barrier(bar)

#if EN_P0
        { const int l = 0; PHASE_IDS(); asm volatile("; PHASE_MARK EN_P0");
    {
        LAS float* sS = (LAS float*)lds;
        LAS float* sR = (LAS float*)(lds + 73728);
        for (int u = tid; u < 9 * D_MODEL; u += 512) { const int i = u >> 11, kx = u & (D_MODEL - 1); const float cv = i < BATCH ? AP->c[i * D_MODEL + kx] : AP->c_ctx[kx]; sS[u] = cv * pg8::fast_sigmoid(cv); }
        __syncthreads();
        for (int it = bx; it < DEPTH * 192; it += G) {
            const int l = it / 192, cchunk = it % 192, kk = lane >> 4, c4 = (lane & 15) * 4;
            f32x4 acc[9];
#pragma unroll
            for (int i = 0; i < 9; ++i) acc[i] = (f32x4){0.f, 0.f, 0.f, 0.f};
            const float* wp = AP->w_mod + ((size_t)l * D_MODEL + wave * 256 + kk) * (NMOD * D_MODEL) + cchunk * 64 + c4;
#pragma unroll 1
            for (int k8 = 0; k8 < 64; k8 += 8) { f32x4 wv[8];
#pragma unroll
                for (int q = 0; q < 8; ++q) wv[q] = __builtin_nontemporal_load((const f32x4*)(wp + (size_t)(4 * (k8 + q)) * (NMOD * D_MODEL)));
#pragma unroll
                for (int q = 0; q < 8; ++q) {
#pragma unroll
                    for (int i = 0; i < 9; ++i) acc[i] += wv[q] * sS[i * D_MODEL + wave * 256 + 4 * (k8 + q) + kk];
                    __builtin_amdgcn_sched_barrier(0); } }
#pragma unroll
            for (int i = 0; i < 9; ++i)
#pragma unroll
                for (int e = 0; e < 4; ++e) { float s = acc[i][e]; s += swz_xor<16>(s); auto rr = __builtin_amdgcn_permlane32_swap(__float_as_uint(s), __float_as_uint(s), false, false); acc[i][e] = __uint_as_float(rr[0]) + __uint_as_float(rr[1]); }
            if (lane < 16) {
#pragma unroll
                for (int i = 0; i < 9; ++i) *(LAS f32x4*)(sR + (wave * 9 + i) * 64 + c4) = acc[i]; }
            __syncthreads();
            for (int u = tid; u < 9 * 64; u += 512) { float s = 0.f;
#pragma unroll
                for (int w8 = 0; w8 < 8; ++w8) s += sR[w8 * 576 + u];
                const int i = u >> 6, col = cchunk * 64 + (u & 63);
                MOD[((size_t)l * 9 + i) * (NMOD * D_MODEL) + col] = s + AP->b_mod[(size_t)l * (NMOD * D_MODEL) + col]; }
            __syncthreads();
        }
        LAS float* scr = (LAS float*)(lds + wave * 16384);
        for (int it = gw; it < TI_LAYER; it += NGW) CONVERT_ITEM(0, it);
        for (int u = bx * 512 + tid; u < DEPTH * (160 * 2048 + 128 * 512) / 8; u += G * 512) {
            const int l = u / ((160 * 2048 + 128 * 512) / 8); const int r = u % ((160 * 2048 + 128 * 512) / 8);
            char* wl = (char*)(ws + WS_W + (size_t)l * W_LAYER);
            v4u z = {0u, 0u, 0u, 0u};
            if (r < 160 * 2048 / 8) *(v4u*)(wl + W_IN + (size_t)IN_W * D_MODEL * 2 + (size_t)r * 16) = z;
            else *(v4u*)(wl + W_UQKV + (size_t)UQ_W * 512 * 2 + (size_t)(r - 160 * 2048 / 8) * 16) = z;
        }
        for (int u = bx * 512 + tid; u < 64 * 32 + 64 * 16; u += G * 512) {
            const bool big = u < 2048; const int v = big ? u : u - 2048; const int half = big ? 32 : 16; const int pos = v / half, i = v % half;
            const double rr = big ? 0.74989420933245582730 : 0.56234132519034908039;
            double f = 1.0; for (int q = 0; q < i; ++q) f *= rr;
            double s, c; sincos_d((double)pos * f, s, c);
            float* T = big ? TAB32 : TAB16; T[v] = (float)c; T[64 * half + v] = (float)s;
        }
    }
        }
#endif
    GRID_BAR();

    for (int l = 0; l < DEPTH; ++l) {
        const bool last = (l == DEPTH - 1);
        const bool fused = FUSE_NORM && (G == 256);
        const int Mres = last ? NLAT : NTOK;

#if EN_N1
        { PHASE_IDS(); asm volatile("; PHASE_MARK EN_N1");
        _Pragma("unroll") for (int rep_ = 0; rep_ < DUP_N1; ++rep_) { if (rep_) GRID_BAR();
        norm_rows(xl_in, xc_in, NTOK, Hb, AP->g_mix + l * D_MODEL, modl, 0, 1, gw, NGW, lane, l > 0 ? PART : nullptr, XC, (fused && l > 0) ? NLAT : 0);
        }
        }
#endif
        GRID_BAR();

#if EN_G1
        { PHASE_IDS(); asm volatile("; PHASE_MARK EN_G1");
        _Pragma("unroll") for (int rep_ = 0; rep_ < DUP_G1; ++rep_) {
        { pg8::Gemm g{Hb, (const bf16*)(wl + W_IN), NTOK, IN_WP, D_MODEL, D_MODEL, 1 << 30, 0, D_MODEL, 0, 0, 0}; pg8::StaticOrder S; S.init(NTOK, IN_WP, G, bx, WGM_G1); S.mode = HALVE_LAST;
          pg8::EpiInProj E{Pb, IN_WP, SSQ, NTOK, TAB32, TAB16, NLAT, SEQ - 1};
          STAGGER((NTOK / 256) * (IN_WP / 256), 4000); pg8::gemm_phase<pg8::EpiInProj, pg8::StaticOrder>(lds, g, S, E, tid);
          if (HALVE_LAST) { S.mode = 2; pg8::gemm_phase<pg8::EpiInProj, pg8::StaticOrder, PG8_ALIGN_DEFAULT, true>(lds, g, S, E, tid); } }
        }
        }
#endif
        GRID_BAR();

#if EN_G2
        { PHASE_IDS(); asm volatile("; PHASE_MARK EN_G2");
        _Pragma("unroll") for (int rep_ = 0; rep_ < DUP_G2; ++rep_) {
        { pg8::Gemm g{Pb, (const bf16*)(wl + W_UQKV), NTOK, UQ_WP + UKV_W, 512, IN_WP, UQ_WP / 256, C_CKV, 512, 0, 0, 0}; pg8::StaticOrder S; S.init(NTOK, UQ_WP + UKV_W, G, bx, WGM_G2);
          pg8::EpiQKV E{Qb, UQ_WP, KVb, UKV_W, SSQ, SSQ + NTOK, UQ_WP / 256};
          STAGGER((NTOK / 256) * ((UQ_WP + UKV_W) / 256), 1000); pg8::gemm_phase<pg8::EpiQKV, pg8::StaticOrder>(lds, g, S, E, tid); }
        }
        }
#endif
        GRID_BAR();

#if EN_MIX
#if EN_GLA
        { PHASE_IDS(); asm volatile("; PHASE_MARK EN_GLA");
        _Pragma("nounroll") for (int rep_ = 0; rep_ < DUP_GLA; ++rep_) {
        if (bx < 64) {
            gla::Unit U; U.P = Pb; U.ldp = IN_WP; U.b = bx >> 3; U.h = (bx >> 1) & 3; U.dir = bx & 1;
            U.wg = (U.dir ? AP->w_gate_b : AP->w_gate_f) + (size_t)l * 16 * 256; U.bg = (U.dir ? AP->b_gate_b : AP->b_gate_f) + (size_t)l * 256; U.og = U.dir ? GOB : GOF;
            gla::gla_unit(U, (char*)lds_raw, tid);
        }
        }
        }
#endif
#if EN_CONV
        if (l + 1 < DEPTH && bx >= 64 && bx < 128) { PHASE_IDS();
            LAS float* scr = (LAS float*)(lds + wave * 16384);
            for (int it = (bx - 64) * NWAVES + wave; it < TI_LAYER; it += 64 * NWAVES) CONVERT_ITEM(l + 1, it);
            __syncthreads();
        }
#endif
#if EN_MLA
        { PHASE_IDS(); asm volatile("; PHASE_MARK EN_MLA");
        {
            const int nitem = last ? 768 : 816; unsigned* head = ctl + CW_QUEUE + (l * 2 + 0) * 64;
            for (;;) {
                if (tid == 0) LCTL[4] = xb_add(head, 1u);
                __syncthreads(); int it = (int)LCTL[4]; __syncthreads();
                if (it >= nitem * DUP_MLA) break;
                if (DUP_MLA > 1) it %= nitem;
                att::Unit U; const bool lat = it < 768; const int bh = lat ? it >> 4 : it - 768, qb = lat ? it & 15 : 0, b = bh / 6, h = bh % 6;
                const long row0 = lat ? (long)b * SEQ + qb * 256 : (long)NLAT + b * CTX;
                U.Q = Qb + row0 * UQ_WP + h * 192;
                U.Kn = KVb + h * 256; U.V = KVb + h * 256 + 128; U.Kr = Pb + C_KR;
                U.t0a = lat ? b * SEQ : NLAT + b * CTX; U.nta = lat ? 64 : 4; U.t0b = NLAT + b * CTX; U.ntb = lat ? 4 : 0;
                U.mask = 0; U.qpos0 = qb * 256; U.kpos0 = 0; U.has_sink = 0; U.sink = 0.f; U.rope = lat ? 1 : 0; U.tab = TAB16;
                U.O = MIX + row0 * D_MODEL + MX_MLA + h * 128;
                att::attn_unit<192, 1, UQ_WP, UKV_W, IN_WP, UKV_W, D_MODEL>(U, (char*)lds_raw, 0.07216878364870322f, tid);
            }
        }
        }
#endif
#if EN_SWA
        { PHASE_IDS(); asm volatile("; PHASE_MARK EN_SWA");
        {
            const int nitem = last ? 768 : 816; unsigned* head = ctl + CW_QUEUE + (l * 2 + 1) * 64;
            for (;;) {
                if (tid == 0) LCTL[4] = xb_add(head, 1u);
                __syncthreads(); int it = (int)LCTL[4]; __syncthreads();
                if (it >= nitem * DUP_SWA) break;
                if (DUP_SWA > 1) it %= nitem;
                att::Unit U; const bool lat = it < 768; const int bh = lat ? it >> 4 : it - 768, qb = lat ? it & 15 : 0, b = bh / 6, hq = bh % 6, kvh = hq / 3;
                const long row0 = lat ? (long)b * SEQ + qb * 256 : (long)NLAT + b * CTX;
                const int ks = lat ? (qb * 256 - 128 < 0 ? 0 : qb * 256 - 128) : 0, ke = lat ? (qb * 256 + 384 > SEQ ? SEQ : qb * 256 + 384) : 0;
                U.Q = Pb + row0 * IN_WP + C_QS + hq * 128;
                U.Kn = Pb + C_KS + kvh * 128; U.V = Pb + C_VS + kvh * 128; U.Kr = nullptr;
                U.t0a = lat ? b * SEQ + ks : NLAT + b * CTX; U.nta = lat ? (ke - ks) / 64 : 4; U.t0b = NLAT + b * CTX; U.ntb = lat ? 4 : 0;
                U.mask = lat ? 1 : 0; U.qpos0 = qb * 256; U.kpos0 = ks; U.has_sink = 1; U.sink = AP->swa_sink[l * 6 + hq]; U.rope = lat ? 1 : 0; U.tab = TAB32;
                U.O = MIX + row0 * D_MODEL + MX_SWA + hq * 128;
                att::attn_unit<128, 2, IN_WP, IN_WP, IN_WP, IN_WP, D_MODEL>(U, (char*)lds_raw, 0.08838834764831845f, tid);
            }
        }
        }
#endif
#if PROBE_ATT
        { PHASE_IDS(); asm volatile("; PHASE_MARK PROBE_ATT");
        {
            const int nitem = last ? 768 : 816; unsigned* head = ctl + CW_QUEUE + 2048 + l * 64;
            for (;;) {
                if (tid == 0) LCTL[4] = xb_add(head, 1u);
                __syncthreads(); int it = (int)LCTL[4]; __syncthreads();
                if (it >= nitem) break;
                att::Unit U; const bool lat = it < 768; const int bh = lat ? it >> 4 : it - 768, qb = lat ? it & 15 : 0, b = bh / 6, h = bh % 6;
                const long row0 = lat ? (long)b * SEQ + qb * 256 : (long)NLAT + b * CTX;
                U.Q = Qb + row0 * UQ_WP + h * 192;
                U.Kn = KVb + h * 256; U.V = KVb + h * 256 + 128; U.Kr = Pb + C_KR;
                U.t0a = lat ? b * SEQ : NLAT + b * CTX; U.nta = lat ? 64 : 4; U.t0b = NLAT + b * CTX; U.ntb = lat ? 4 : 0;
                U.mask = 0; U.qpos0 = qb * 256; U.kpos0 = 0; U.has_sink = 0; U.sink = 0.f; U.rope = lat ? 1 : 0; U.tab = TAB16;
                U.O = (att::bf16*)(ws + WS_PART) + (size_t)(it & 31) * 256 * D_MODEL + h * 128;
                att::attn_unit<192, 1, UQ_WP, UKV_W, IN_WP, UKV_W, D_MODEL, PROBE_ATT_VAR>(U, (char*)lds_raw, 0.07216878364870322f, tid);
            }
        }
        }
#endif
#endif
        GRID_BAR();

#if EN_GL2
        { PHASE_IDS(); asm volatile("; PHASE_MARK EN_GL2");
        _Pragma("unroll") for (int rep_ = 0; rep_ < DUP_GL2; ++rep_) { if (rep_) GRID_BAR();
        for (int row = gw; row < Mres; row += NGW) {
            const v4u fa = *(const v4u*)(GOF + (size_t)row * 512 + lane * 8), fb = *(const v4u*)(GOB + (size_t)row * 512 + lane * 8);
            const f32x4 o0 = {bflo(fa.x) + bflo(fb.x), bfhi(fa.x) + bfhi(fb.x), bflo(fa.y) + bflo(fb.y), bfhi(fa.y) + bfhi(fb.y)};
            const f32x4 o1 = {bflo(fa.z) + bflo(fb.z), bfhi(fa.z) + bfhi(fb.z), bflo(fa.w) + bflo(fb.w), bfhi(fa.w) + bfhi(fb.w)};
            float ss = (o0.x * o0.x + o0.y * o0.y) + (o0.z * o0.z + o0.w * o0.w) + (o1.x * o1.x + o1.y * o1.y) + (o1.z * o1.z + o1.w * o1.w);
            ss = sum16(ss);
            const float rs = 1.f / sqrtf(ss * (1.f / 128.f) + EPS);
            const float* gp = AP->g_gla_out + l * 512 + lane * 8; const f32x4 g0 = *(const f32x4*)gp, g1 = *(const f32x4*)(gp + 4);
            const v4u rw = *(const v4u*)(Pb + (size_t)row * IN_WP + C_GR + lane * 8);
            float r[8] = {bflo(rw.x), bfhi(rw.x), bflo(rw.y), bfhi(rw.y), bflo(rw.z), bfhi(rw.z), bflo(rw.w), bfhi(rw.w)};
            float y[8] = {o0.x * g0.x, o0.y * g0.y, o0.z * g0.z, o0.w * g0.w, o1.x * g1.x, o1.y * g1.y, o1.z * g1.z, o1.w * g1.w};
#pragma unroll
            for (int e = 0; e < 8; ++e) y[e] = y[e] * rs * (r[e] * pg8::fast_sigmoid(r[e]));
            v4u w; w.x = pk2(y[0], y[1]); w.y = pk2(y[2], y[3]); w.z = pk2(y[4], y[5]); w.w = pk2(y[6], y[7]);
            *(v4u*)(MIX + (size_t)row * D_MODEL + MX_GLA + lane * 8) = w;
        }
        }
        }
#endif
        GRID_BAR();

#if EN_G3
        { PHASE_IDS(); asm volatile("; PHASE_MARK EN_G3");
        {
          pg8::Gemm g{MIX, (const bf16*)(wl + W_OUT), NLAT, D_MODEL, D_MODEL, D_MODEL, 1 << 30, 0, D_MODEL, 0, 0, 0}; pg8::StaticOrder S; S.init(NLAT, D_MODEL, G, bx, WGM_RES);
          if (fused) { pg8::EpiResNorm E{xl_in, AP->out, modl + 2 * D_MODEL, NMOD * D_MODEL, Hb, AP->g_ffn + l * D_MODEL, modl + 3 * D_MODEL, modl + 4 * D_MODEL,
                                        (float*)(ws + WS_XS), ctl + CW_PANEL + ((l * 2 + 0) * 128) * 64, ctl + CW_BAR + XB_TMO, lds + LDSCTL_OFF + 2048, 0};
              pg8::gemm_phase<pg8::EpiResNorm, pg8::StaticOrder>(lds, g, S, E, tid); }
          else { pg8::EpiRes E{xl_in, xc_in, AP->out, XC, modl + 2 * D_MODEL, NMOD * D_MODEL, D_MODEL};
              pg8::gemm_phase<pg8::EpiRes, pg8::StaticOrder>(lds, g, S, E, tid); }
          if (!last) { pg8::Gemm g2{MIX + (size_t)NLAT * D_MODEL, (const bf16*)(wl + W_OUT), NCTX, D_MODEL, D_MODEL / 4, D_MODEL, 1 << 30, 0, D_MODEL, D_MODEL / 4, 0, 0}; pg8::SplitKOrder S2; S2.init(NCTX / 256, D_MODEL / 256, 4, G, bx);
              pg8::EpiPart E2{PART, modl + (size_t)BATCH * (NMOD * D_MODEL) + 2 * D_MODEL, NCTX, D_MODEL};
              pg8::gemm_phase<pg8::EpiPart, pg8::SplitKOrder>(lds, g2, S2, E2, tid); } }
        }
#endif
        GRID_BAR();

#if EN_N2
        { PHASE_IDS(); asm volatile("; PHASE_MARK EN_N2");
        _Pragma("unroll") for (int rep_ = 0; rep_ < DUP_N2; ++rep_) { if (rep_) GRID_BAR();
        norm_rows(AP->out, xc_in, Mres, Hb, AP->g_ffn + l * D_MODEL, modl, 3, 4, gw, NGW, lane, last ? nullptr : PART, XC, fused ? NLAT : 0);
        }
        }
#endif
        GRID_BAR();

#if EN_G4
        { PHASE_IDS(); asm volatile("; PHASE_MARK EN_G4");
        _Pragma("unroll") for (int rep_ = 0; rep_ < (DUP_G4 == 3 ? 1 : DUP_G4); ++rep_) {
        { pg8::Gemm g{Hb, (const bf16*)(wl + W_GU), Mres, 2 * FFN, D_MODEL, D_MODEL, 1 << 30, 0, D_MODEL, 0, 0, 0}; pg8::StaticOrder S; S.init(Mres, 2 * FFN, G, bx, WGM_G4); S.mode = HALVE_LAST;
          pg8::EpiSwiglu E{ACT, FFN, ACT_TILED ? NTOK : 0};
          STAGGER((Mres / 256) * (2 * FFN / 256), 4000);
          if (DUP_G4 == 3) { pg8::EpiSum E3{(float*)(ws + WS_MIX)};
              pg8::gemm_phase<pg8::EpiSum, pg8::StaticOrder>(lds, g, S, E3, tid); }
          pg8::gemm_phase<pg8::EpiSwiglu, pg8::StaticOrder>(lds, g, S, E, tid);
          if (HALVE_LAST) { S.mode = 2; pg8::gemm_phase<pg8::EpiSwiglu, pg8::StaticOrder, PG8_ALIGN_DEFAULT, true>(lds, g, S, E, tid); } }
        }
        }
#endif
        GRID_BAR();

#if EN_G5
        { PHASE_IDS(); asm volatile("; PHASE_MARK EN_G5");
        { pg8::Gemm g{ACT, (const bf16*)(wl + W_DOWN), NLAT, D_MODEL, FFN, ACT_TILED ? 64 : FFN, 1 << 30, 0, FFN, 0, ACT_TILED ? (long)NTOK * 128 : 0, 0}; pg8::StaticOrder S; S.init(NLAT, D_MODEL, G, bx, WGM_RES, REV_G5);
          if (fused) { const float* modn = MOD + (size_t)(l + 1) * 9 * (NMOD * D_MODEL);
              pg8::EpiResNorm E{AP->out, AP->out, modl + 5 * D_MODEL, NMOD * D_MODEL, Hb, last ? AP->g_final : AP->g_mix + (l + 1) * D_MODEL, modn, modn + D_MODEL,
                                (float*)(ws + WS_XS) + 128 * 256 * 8, ctl + CW_PANEL + ((l * 2 + 1) * 128) * 64, ctl + CW_BAR + XB_TMO, lds + LDSCTL_OFF + 2048, last ? 1 : 0};
              pg8::gemm_phase<pg8::EpiResNorm, pg8::StaticOrder>(lds, g, S, E, tid); }
          else { pg8::EpiRes E{AP->out, XC, AP->out, XC, modl + 5 * D_MODEL, NMOD * D_MODEL, D_MODEL};
              pg8::gemm_phase<pg8::EpiRes, pg8::StaticOrder>(lds, g, S, E, tid); }
          if (DUP_G5 >= 3) { pg8::StaticOrder S3; S3.init(NLAT, D_MODEL, G, bx, WGM_RES, REV_G5); if (DUP_G5 == 4) S3.pm_mod = 16;
              pg8::EpiSum E3{(float*)(ws + WS_MIX)}; pg8::gemm_phase<pg8::EpiSum, pg8::StaticOrder>(lds, g, S3, E3, tid); }
          if (!last) { pg8::Gemm g2{ACT + (size_t)NLAT * (ACT_TILED ? 64 : FFN), (const bf16*)(wl + W_DOWN), NCTX, D_MODEL, FFN / 4, ACT_TILED ? 64 : FFN, 1 << 30, 0, FFN, FFN / 4, ACT_TILED ? (long)NTOK * 128 : 0, ACT_TILED ? (long)(FFN / 4 / 64) * NTOK * 128 : 0}; pg8::SplitKOrder S2; S2.init(NCTX / 256, D_MODEL / 256, 4, G, bx);
              pg8::EpiPart E2{PART, modl + (size_t)BATCH * (NMOD * D_MODEL) + 5 * D_MODEL, NCTX, D_MODEL};
              pg8::gemm_phase<pg8::EpiPart, pg8::SplitKOrder>(lds, g2, S2, E2, tid); } }
        }
#endif
        GRID_BAR();
    }

#if BURN_MFMA
    {
        typedef short bx8 __attribute__((ext_vector_type(8))); typedef float fx4 __attribute__((ext_vector_type(4)));
        int t_ = threadIdx.x; asm volatile("" : "+v"(t_));
        bx8 a_, b_; for (int e = 0; e < 8; ++e) { a_[e] = (short)(0x3c00 + ((t_ * 7 + e) & 127)); b_[e] = (short)(0x3c00 + ((t_ * 13 + e * 5) & 127)); }
        fx4 c_[8]; for (int i = 0; i < 8; ++i) c_[i] = (fx4){0.f, 0.f, 0.f, 0.f};
#pragma unroll 1
        for (int it = 0; it < BURN_MFMA * 128; ++it) {
#pragma unroll
            for (int i = 0; i < 8; ++i) c_[i] = __builtin_amdgcn_mfma_f32_16x16x32_bf16(a_, b_, c_[i], 0, 0, 0);
        }
        float s_ = 0.f; for (int i = 0; i < 8; ++i) s_ += c_[i][0] + c_[i][1] + c_[i][2] + c_[i][3];
        ((float*)(A.ws + WS_PART))[blockIdx.x * 512 + threadIdx.x] = s_;
    }
#endif
    const int l = 0; PHASE_IDS();
    if (!(FUSE_NORM && G == 256))
    for (int row = gw; row < NLAT; row += NGW) {
        float* xr = AP->out + (size_t)row * D_MODEL;
        f32x4 v[8]; float ss = 0.f;
#pragma unroll
        for (int j = 0; j < 8; ++j) { v[j] = *(const f32x4*)(xr + 4 * lane + 256 * j); ss += (v[j].x * v[j].x + v[j].y * v[j].y) + (v[j].z * v[j].z + v[j].w * v[j].w); }
        const float rstd = 1.f / sqrtf(wave_sum(ss) * (1.f / D_MODEL) + EPS);
#pragma unroll
        for (int j = 0; j < 8; ++j) { const int col = 4 * lane + 256 * j; const f32x4 gv = *(const f32x4*)(AP->g_final + col); *(f32x4*)(xr + col) = (v[j] * rstd) * gv; }
    }
}

extern "C" void kernel_launch(void* const* d_in, const int* in_sizes, int n_in, void* d_out, int out_size, void* d_ws, size_t ws_size, hipStream_t stream) {
    static int grid = 0;
    if (grid == 0) {
        if (n_in != 23 || in_sizes[0] != NLAT * D_MODEL || out_size != NLAT * D_MODEL || ws_size < WS_END) {
            fprintf(stderr, "kernel_launch: unexpected shapes: n_in %d in0 %d out %d ws %zu (need %zu)\n", n_in, n_in > 0 ? in_sizes[0] : -1, out_size, ws_size, (size_t)WS_END); grid = -1; return; }
        int dev = 0, cus = 0, per_cu = 0;
        if (hipGetDevice(&dev) != hipSuccess || hipDeviceGetAttribute(&cus, hipDeviceAttributeMultiprocessorCount, dev) != hipSuccess) { fprintf(stderr, "kernel_launch: device query failed\n"); grid = -1; return; }
        if (hipFuncSetAttribute((const void*)fwd_kernel, hipFuncAttributeMaxDynamicSharedMemorySize, LDS_BYTES) != hipSuccess) { fprintf(stderr, "kernel_launch: hipFuncSetAttribute failed\n"); grid = -1; return; }
        if (hipOccupancyMaxActiveBlocksPerMultiprocessor(&per_cu, (const void*)fwd_kernel, NWAVES * 64, LDS_BYTES) != hipSuccess || per_cu < 1) { fprintf(stderr, "kernel_launch: occupancy query reports %d workgroups per CU\n", per_cu); (void)hipGetLastError(); grid = -1; return; }
        grid = cus;
    }
    if (grid < 0) return;
    if (hipMemsetAsync((char*)d_ws, 0, ZERO_BYTES, stream) != hipSuccess) { fprintf(stderr, "kernel_launch: memset failed\n"); return; }
    Ptrs p{};
    const float** pf = (const float**)&p;
    for (int i = 0; i < 23; ++i) pf[i] = (const float*)d_in[i];
    p.out = (float*)d_out; p.ws = (unsigned char*)d_ws;
    hipLaunchKernelGGL(fwd_kernel, dim3(grid), dim3(NWAVES * 64), LDS_BYTES, stream, p);
    const hipError_t le = hipPeekAtLastError();
    if (le != hipSuccess) fprintf(stderr, "kernel_launch: launch failed: %s\n", hipGetErrorName(le));
}
```

```cpp
#include <hip/hip_runtime.h>
#include <cstdio>
#include <cstdint>
#include <cmath>

constexpr int D_MODEL = 2048, BATCH = 8, SEQ = 4096, DEPTH = 4, CTX = 256;
constexpr int NLAT = BATCH * SEQ;
constexpr int NCTX = BATCH * CTX;
constexpr int NTOK = NLAT + NCTX;
constexpr int IN_W = 3936, IN_WP = 4096;
constexpr int FFN = 5632, NMOD = 6;
constexpr int UQ_W = 1152, UQ_WP = 1280, UKV_W = 1536;
constexpr float EPS = 1e-6f;
constexpr int C_CQ = 0, C_CKV = 512, C_KR = 1024, C_QS = 1088, C_KS = 1856, C_VS = 2112, C_GQ = 2368, C_GK = 2624, C_GV = 2880, C_GLR = 3392, C_GR = 3424;
constexpr int MX_MLA = 0, MX_SWA = 768, MX_GLA = 1536;

namespace pg8 {
#define PG8_LAS __attribute__((address_space(3)))
typedef unsigned short bf16_t;
typedef short bf16x8 __attribute__((ext_vector_type(8)));
typedef float f32x4 __attribute__((ext_vector_type(4)));
typedef unsigned u32x4 __attribute__((ext_vector_type(4)));
constexpr int BM = 256, BK = 64, HALF = 128, HTB = HALF * BK * 2  , STAGE_BYTES = 8 * HTB, NXCD = 8, WGM = 8;

__host__ __device__ __forceinline__ int lds_byte(int r, int c) { const int st = (r >> 4) * 2 + (c >> 5), rr = r & 15, cc = c & 31, ob = rr * 64 + cc * 2; return st * 1024 + (ob ^ (((ob >> 9) & 1) << 5)); }
__host__ __device__ __forceinline__ void stage_rc(int b, int& R, int& C) { const int st = b / 1024, sb = b % 1024, swz = sb ^ (((sb >> 9) & 1) << 5); R = (st >> 1) * 16 + swz / 64; C = (st & 1) * 32 + (swz % 64) / 2; }
__host__ __device__ __forceinline__ int perm32(int rho) { const int n = rho >> 4, i = rho & 15; return 8 * (i >> 2) + 4 * n + (i & 3); }

struct Unit { int pm, pn, ks; int hm = 0; };
struct Gemm { const bf16_t* A; const bf16_t* Bt; int M, N, K, lda, a_split_pn, a_split_off, ldb, ksplit; long kstepA, ksplitA; };

struct StaticOrder {
    int nM, nN, nwg, G, c, wgm, rev, pm_mod = 0, mode = 0;
    __host__ __device__ void init(int M, int N, int G_, int c_, int wgm_ = WGM, int rev_ = 0) { nM = M / BM; nN = N / BM; nwg = nM * nN; G = G_; c = c_; wgm = wgm_; rev = rev_; }
    __host__ __device__ bool next(int i, Unit& u) const {
        long L = (long)i * G + c; u.hm = 0;
        if (mode) { const int full = nwg / G, R = nwg - full * G; const bool split = R > 0 && 2 * R <= G;
            if (mode == 1) { if (split && i >= full) return false; }
            else { if (!split || i > 0 || c >= 2 * R) return false; L = (long)full * G + (c >> 1); u.hm = 1 + (c & 1); } }
        if (L >= nwg) return false;
        int wgid = (int)L; { const int q = nwg / NXCD, r = nwg % NXCD, xcd = wgid % NXCD, off = wgid / NXCD; wgid = (xcd < r ? xcd * (q + 1) : r * (q + 1) + (xcd - r) * q) + off; }
        const int nig = wgm * nN, gid = wgid / nig, fm = gid * wgm, gsz = (nM - fm) < wgm ? (nM - fm) : wgm;
        u.pm = fm + ((wgid % nig) % gsz); u.pn = (wgid % nig) / gsz; u.ks = 0; if (rev) u.pm = nM - 1 - u.pm; if (pm_mod) u.pm %= pm_mod; return true;
    }
    __device__ __forceinline__ void a_ready(const Unit&) const {}
    __device__ __forceinline__ void done(const Unit&) const {}
};

struct SplitKOrder {
    int nM, nN, nS, G, c;
    __host__ __device__ void init(int nM_, int nN_, int nS_, int G_, int c_) { nM = nM_; nN = nN_; nS = nS_; G = G_; c = c_; }
    __host__ __device__ bool next(int i, Unit& u) const { const int L = i * G + c; if (L >= nM * nN * nS) return false; u.ks = L % nS; u.pm = (L / nS) % nM; u.pn = L / (nS * nM); return true; }
    __device__ __forceinline__ void a_ready(const Unit&) const {}
    __device__ __forceinline__ void done(const Unit&) const {}
};

typedef float f32x2_t __attribute__((ext_vector_type(2))); typedef __bf16 bf16x2_t __attribute__((ext_vector_type(2)));
__device__ __forceinline__ unsigned cvt_pk_bf16(float lo, float hi) { f32x2_t v = {lo, hi}; bf16x2_t b = __builtin_convertvector(v, bf16x2_t); return __builtin_bit_cast(unsigned, b); }
typedef float f32x2 __attribute__((ext_vector_type(2)));
#ifndef NT_ACT
#define NT_ACT 0
#endif
typedef unsigned u32x2 __attribute__((ext_vector_type(2)));
__device__ __forceinline__ float fast_sigmoid(float x) { return __builtin_amdgcn_rcpf(1.0f + __builtin_amdgcn_exp2f(-1.4426950408889634f * x)); }
struct EpiStoreBf16 {
    static constexpr bool PERM = true, AFTER_DRAIN = false;
    bf16_t* O; int ldc;
    __device__ __forceinline__ void operator()(const f32x4 (&acc)[2][2][4][2], const Unit& u, int wr, int wc, int fr, int fq) const {
        const int row0 = u.pm * BM + wr * 64 + fr, col0 = u.pn * BM + wc * 32 + 8 * fq;
#pragma unroll
        for (int ai = 0; ai < 2; ++ai)
#pragma unroll
            for (int m = 0; m < 4; ++m) { bf16_t* rowp = O + (size_t)(row0 + ai * HALF + m * 16) * ldc + col0;
#pragma unroll
                for (int bj = 0; bj < 2; ++bj) { const f32x4 v0 = acc[ai][bj][m][0], v1 = acc[ai][bj][m][1];
                    u32x4 w; w.x = cvt_pk_bf16(v0[0], v0[1]); w.y = cvt_pk_bf16(v0[2], v0[3]); w.z = cvt_pk_bf16(v1[0], v1[1]); w.w = cvt_pk_bf16(v1[2], v1[3]);
                    *(u32x4*)(rowp + bj * HALF) = w; } }
    }
};
struct EpiQKV {
    static constexpr bool PERM = true, AFTER_DRAIN = false;
    bf16_t* Oq; int ldq; bf16_t* Okv; int ldkv; const float* rq; const float* rkv; int split;
    __device__ __forceinline__ void operator()(const f32x4 (&acc)[2][2][4][2], const Unit& u, int wr, int wc, int fr, int fq) const {
        const bool first = u.pn < split;
        bf16_t* base = first ? Oq : Okv; const int ld = first ? ldq : ldkv; const float* rs = first ? rq : rkv;
        const int row0 = u.pm * BM + wr * 64 + fr, col0 = (first ? u.pn : u.pn - split) * BM + wc * 32 + 8 * fq;
        float sv[2][4];
#pragma unroll
        for (int ai = 0; ai < 2; ++ai)
#pragma unroll
            for (int m = 0; m < 4; ++m) sv[ai][m] = rs[row0 + ai * HALF + m * 16];
#pragma unroll
        for (int ai = 0; ai < 2; ++ai)
#pragma unroll
            for (int m = 0; m < 4; ++m) { const int row = row0 + ai * HALF + m * 16; const float s = __builtin_amdgcn_rsqf(sv[ai][m] * (1.0f / 512.0f) + 1e-6f); bf16_t* rowp = base + (size_t)row * ld + col0;
#pragma unroll
                for (int bj = 0; bj < 2; ++bj) { const f32x4 v0 = acc[ai][bj][m][0] * s, v1 = acc[ai][bj][m][1] * s;
                    u32x4 w; w.x = cvt_pk_bf16(v0[0], v0[1]); w.y = cvt_pk_bf16(v0[2], v0[3]); w.z = cvt_pk_bf16(v1[0], v1[1]); w.w = cvt_pk_bf16(v1[2], v1[3]);
                    *(u32x4*)(rowp + bj * HALF) = w; } }
    }
};
struct EpiRes {
    static constexpr bool PERM = false, AFTER_DRAIN = false;
    const float* base_l; const float* base_c; float* out_l; float* out_c; const float* gate; int gpitch; int ncols;
    __device__ __forceinline__ void operator()(const f32x4 (&acc)[2][2][4][2], const Unit& u, int wr, int wc, int fr, int fq) const {
        const bool lat = u.pm < (NLAT / BM);
        const int gi = lat ? (u.pm >> 4) : BATCH;
        const float* bs = lat ? base_l : base_c; float* os = lat ? out_l : out_c;
        const int row0 = (lat ? u.pm : u.pm - NLAT / BM) * BM + wr * 64 + fr, col0 = u.pn * BM + wc * 32 + 4 * fq;
        f32x4 gv[2][2];
#pragma unroll
        for (int bj = 0; bj < 2; ++bj)
#pragma unroll
            for (int n = 0; n < 2; ++n) gv[bj][n] = *(const f32x4*)(gate + (size_t)gi * gpitch + col0 + bj * HALF + n * 16);
#pragma unroll
        for (int ai = 0; ai < 2; ++ai)
#pragma unroll
            for (int m = 0; m < 4; ++m) { const size_t off = (size_t)(row0 + ai * HALF + m * 16) * ncols + col0;
#pragma unroll
                for (int bj = 0; bj < 2; ++bj)
#pragma unroll
                    for (int n = 0; n < 2; ++n) { const f32x4 b = *(const f32x4*)(bs + off + bj * HALF + n * 16); *(f32x4*)(os + off + bj * HALF + n * 16) = b + gv[bj][n] * acc[ai][bj][m][n]; }
                asm volatile("" ::: "memory"); }
    }
};
struct EpiSwiglu {
    static constexpr bool PERM = true, AFTER_DRAIN = false;
    bf16_t* O; int ldc; int tiled_rows;
    __device__ __forceinline__ void operator()(const f32x4 (&acc)[2][2][4][2], const Unit& u, int wr, int wc, int fr, int fq) const {
        const int row0 = u.pm * BM + (u.hm == 2 ? HALF : 0) + wr * 64 + fr, col0 = u.pn * HALF + wc * 32 + 8 * fq;
#pragma unroll
        for (int ai = 0; ai < 2; ++ai) { if (ai == 1 && u.hm) break;
#pragma unroll
            for (int m = 0; m < 4; ++m) { const int row = row0 + ai * HALF + m * 16;
                bf16_t* rowp = tiled_rows ? O + ((size_t)(col0 >> 6) * tiled_rows + row) * 64 + (col0 & 63) : O + (size_t)row * ldc + col0;
                float r[8];
#pragma unroll
                for (int n = 0; n < 2; ++n)
#pragma unroll
                    for (int i = 0; i < 4; ++i) { const float g = acc[ai][0][m][n][i], up = acc[ai][1][m][n][i]; r[n * 4 + i] = g * fast_sigmoid(g) * up; }
                u32x4 w; w.x = cvt_pk_bf16(r[0], r[1]); w.y = cvt_pk_bf16(r[2], r[3]); w.z = cvt_pk_bf16(r[4], r[5]); w.w = cvt_pk_bf16(r[6], r[7]);
#if NT_ACT
                __builtin_nontemporal_store(w, (u32x4*)rowp);
#else
                *(u32x4*)rowp = w;
#endif
                }
        }
    }
};

struct EpiSum {
    static constexpr bool PERM = false, AFTER_DRAIN = false;
    float* O;
    __device__ __forceinline__ void operator()(const f32x4 (&acc)[2][2][4][2], const Unit& u, int wr, int wc, int fr, int fq) const {
        float s = 0.f;
#pragma unroll
        for (int ai = 0; ai < 2; ++ai)
#pragma unroll
            for (int bj = 0; bj < 2; ++bj)
#pragma unroll
                for (int m = 0; m < 4; ++m)
#pragma unroll
                    for (int n = 0; n < 2; ++n) s += (acc[ai][bj][m][n][0] + acc[ai][bj][m][n][1]) + (acc[ai][bj][m][n][2] + acc[ai][bj][m][n][3]);
        O[(size_t)(u.pm * 8 + u.pn) * 512 + (wr * 4 + wc) * 64 + fq * 16 + fr] = s;
    }
};

struct EpiPart {
    static constexpr bool PERM = false, AFTER_DRAIN = false;
    float* slab; const float* gate; int nrows, ncols;
    __device__ __forceinline__ void operator()(const f32x4 (&acc)[2][2][4][2], const Unit& u, int wr, int wc, int fr, int fq) const {
        const int row0 = u.pm * BM + wr * 64 + fr, col0 = u.pn * BM + wc * 32 + 4 * fq;
        float* os = slab + (size_t)u.ks * nrows * ncols;
        f32x4 gv[2][2];
#pragma unroll
        for (int bj = 0; bj < 2; ++bj)
#pragma unroll
            for (int n = 0; n < 2; ++n) gv[bj][n] = *(const f32x4*)(gate + col0 + bj * HALF + n * 16);
#pragma unroll
        for (int ai = 0; ai < 2; ++ai)
#pragma unroll
            for (int m = 0; m < 4; ++m) { const size_t off = (size_t)(row0 + ai * HALF + m * 16) * ncols + col0;
#pragma unroll
                for (int bj = 0; bj < 2; ++bj)
#pragma unroll
                    for (int n = 0; n < 2; ++n) *(f32x4*)(os + off + bj * HALF + n * 16) = gv[bj][n] * acc[ai][bj][m][n]; }
    }
};

struct EpiResNorm {
    static constexpr bool PERM = false, AFTER_DRAIN = false;
    const float* base_l; float* out_l; const float* gate; int gpitch;
    bf16_t* H;
    const float* gvec; const float* shiftp; const float* scalep;
    float* slots; unsigned* cnt; unsigned* tmo;
    PG8_LAS unsigned char* scr;
    int fin;
    __device__ __forceinline__ void operator()(f32x4 (&acc)[2][2][4][2], const Unit& u, int wr, int wc, int fr, int fq) const {
        const int gi = u.pm >> 4, row0 = u.pm * BM + wr * 64 + fr, col0 = u.pn * BM + wc * 32 + 4 * fq, wid = wr * 4 + wc, lane = fq * 16 + fr, tid = wid * 64 + lane;
        PG8_LAS float* P = (PG8_LAS float*)scr; PG8_LAS float* S = (PG8_LAS float*)(scr + 4096); PG8_LAS unsigned* flag = (PG8_LAS unsigned*)(scr + 5120);
        { f32x4 gv[2][2];
#pragma unroll
          for (int bj = 0; bj < 2; ++bj)
#pragma unroll
              for (int n = 0; n < 2; ++n) gv[bj][n] = *(const f32x4*)(gate + (size_t)gi * gpitch + col0 + bj * HALF + n * 16);
          f32x4 bb[2][2][2];
#define ERN_LOADB(it_, buf_) do { const size_t o_ = (size_t)(row0 + ((it_) >> 2) * HALF + ((it_) & 3) * 16) * 2048 + col0; \
    _Pragma("unroll") for (int bj = 0; bj < 2; ++bj) _Pragma("unroll") for (int n = 0; n < 2; ++n) bb[buf_][bj][n] = *(const f32x4*)(base_l + o_ + bj * HALF + n * 16); } while (0)
          ERN_LOADB(0, 0);
#pragma unroll
          for (int it = 0; it < 8; ++it) { const int ai = it >> 2, m = it & 3; const size_t off = (size_t)(row0 + ai * HALF + m * 16) * 2048 + col0; float ss = 0.f;
                  if (it + 1 < 8) ERN_LOADB(it + 1, (it + 1) & 1);
#pragma unroll
                  for (int bj = 0; bj < 2; ++bj)
#pragma unroll
                      for (int n = 0; n < 2; ++n) { const f32x4 b = bb[it & 1][bj][n]; const f32x4 x = b + gv[bj][n] * acc[ai][bj][m][n]; acc[ai][bj][m][n] = x;
                          if (!fin) *(f32x4*)(out_l + off + bj * HALF + n * 16) = x; ss += (x[0] * x[0] + x[1] * x[1]) + (x[2] * x[2] + x[3] * x[3]); }
                  ss += __int_as_float(__builtin_amdgcn_ds_swizzle(__float_as_int(ss), (16 << 10) | 0x1f));
                  { auto rr = __builtin_amdgcn_permlane32_swap(__float_as_uint(ss), __float_as_uint(ss), false, false); ss = __uint_as_float(rr[0]) + __uint_as_float(rr[1]); }
                  if (fq == 0) P[(ai * HALF + wr * 64 + m * 16 + fr) * 4 + wc] = ss;
                  asm volatile("" ::: "memory"); }
#undef ERN_LOADB
        }
        asm volatile("s_waitcnt lgkmcnt(0)" ::: "memory"); __builtin_amdgcn_s_barrier(); asm volatile("" ::: "memory");
        if (tid < 256) { const f32x4 p = *(const PG8_LAS f32x4*)(P + tid * 4); const float s = (p[0] + p[1]) + (p[2] + p[3]);
            __hip_atomic_store((unsigned*)slots + ((size_t)(u.pm * 256 + tid) * 8 + u.pn), __float_as_uint(s), __ATOMIC_RELAXED, __HIP_MEMORY_SCOPE_AGENT);
            asm volatile("s_waitcnt vmcnt(0)" ::: "memory");
            if (lane == 0) __hip_atomic_fetch_add(cnt + 64 * u.pm, 1u, __ATOMIC_RELAXED, __HIP_MEMORY_SCOPE_AGENT); }
        if (wid == 0) { unsigned dead = 0u, sp = 0u;
            while ((unsigned)__builtin_amdgcn_readfirstlane(__hip_atomic_load(cnt + 64 * u.pm, __ATOMIC_RELAXED, __HIP_MEMORY_SCOPE_AGENT)) < 32u) {
                __builtin_amdgcn_s_sleep(1);
                if ((++sp & 255u) == 0u) { if (__builtin_amdgcn_readfirstlane(__hip_atomic_load(tmo, __ATOMIC_RELAXED, __HIP_MEMORY_SCOPE_AGENT)) != 0u) { dead = 1u; break; }
                    if (sp > (1u << 20)) { if (lane == 0) __hip_atomic_fetch_add(tmo, 1u, __ATOMIC_RELAXED, __HIP_MEMORY_SCOPE_AGENT); dead = 1u; break; } } }
            __builtin_amdgcn_fence(__ATOMIC_ACQUIRE, "agent");
            if (lane == 0) flag[0] = dead; }
        asm volatile("s_waitcnt vmcnt(0) lgkmcnt(0)" ::: "memory"); __builtin_amdgcn_s_barrier(); asm volatile("" ::: "memory");
        if (tid < 256) { const unsigned* sl = (const unsigned*)slots + (size_t)(u.pm * 256 + tid) * 8; float t = 0.f;
#pragma unroll
            for (int q = 0; q < 8; ++q) t += __uint_as_float(__hip_atomic_load(sl + q, __ATOMIC_RELAXED, __HIP_MEMORY_SCOPE_AGENT));
            S[tid] = __builtin_amdgcn_rsqf(t * (1.0f / 2048.0f) + 1e-6f); }
        asm volatile("s_waitcnt lgkmcnt(0)" ::: "memory"); __builtin_amdgcn_s_barrier(); asm volatile("" ::: "memory");
        const bool bad = flag[0] != 0u; const float qnan = __builtin_nanf("");
        f32x4 gs[2][2], sh[2][2];
#pragma unroll
        for (int bj = 0; bj < 2; ++bj)
#pragma unroll
            for (int n = 0; n < 2; ++n) { const int c = col0 + bj * HALF + n * 16; const f32x4 g4 = *(const f32x4*)(gvec + c);
                if (fin) { gs[bj][n] = g4; sh[bj][n] = (f32x4){0.f, 0.f, 0.f, 0.f}; }
                else { gs[bj][n] = g4 * (*(const f32x4*)(scalep + (size_t)gi * gpitch + c) + 1.0f); sh[bj][n] = *(const f32x4*)(shiftp + (size_t)gi * gpitch + c); } }
#pragma unroll
        for (int ai = 0; ai < 2; ++ai)
#pragma unroll
            for (int m = 0; m < 4; ++m) { const int r = ai * HALF + wr * 64 + m * 16 + fr; const float rs = bad ? qnan : S[r]; const size_t off = (size_t)(u.pm * BM + r) * 2048 + col0;
#pragma unroll
                for (int bj = 0; bj < 2; ++bj)
#pragma unroll
                    for (int n = 0; n < 2; ++n) { const f32x4 y = (acc[ai][bj][m][n] * rs) * gs[bj][n] + sh[bj][n];
                        if (fin) *(f32x4*)(out_l + off + bj * HALF + n * 16) = y;
                        else { u32x2 w; w.x = cvt_pk_bf16(y[0], y[1]); w.y = cvt_pk_bf16(y[2], y[3]); *(u32x2*)(H + off + bj * HALF + n * 16) = w; } } }
    }
};

__host__ __device__ __forceinline__ int w_in_row(int c) {
    if (c >= 1856 && c < 2112) { const int B = 1856 + ((c - 1856) & ~127), d = (c - 1856) & 127, blk = d >> 6, n = (d & 63) >> 5, i = d & 31; return B + 8 * (blk * 8 + (i >> 2)) + 4 * n + (i & 3); }
    if (c >= 1024 && c < 1088) { const int d = c - 1024, blk = d >> 5, n = (d & 31) >> 4, i = d & 15; return 1024 + 8 * (blk * 4 + (i >> 2)) + 4 * n + (i & 3); }
    return c;
}
struct EpiInProj {
    static constexpr bool PERM = true, AFTER_DRAIN = false;
    bf16_t* O; int ldc; float* ssq; int ssq_rows; const float* tab32; const float* tab16; int nlat, seqmask;
    __device__ __forceinline__ void operator()(const f32x4 (&acc)[2][2][4][2], const Unit& u, int wr, int wc, int fr, int fq) const {
        const int row0 = u.pm * BM + (u.hm == 2 ? HALF : 0) + wr * 64 + fr; const bool stat = u.pn < 4; const bool lat = u.pm * BM < nlat; const int nai = u.hm ? 1 : 2;
#pragma unroll
        for (int bj = 0; bj < 2; ++bj) {
            const int p0 = u.pn * BM + bj * HALF + wc * 32 + 8 * fq;
            const bool inKS = p0 >= 1856 && p0 < 2112, inKR = p0 >= 1024 && p0 < 1088;
            if (inKS || inKR) {
                const int half = inKS ? 32 : 16, base = inKS ? 1856 + ((p0 - 1856) & ~127) : 1024, t = (p0 - base) >> 3, blk = inKS ? (t >> 3) : (t >> 2), i0 = 4 * (inKS ? (t & 7) : (t & 3));
                const float* tb = inKS ? tab32 : tab16; const int c1 = base + blk * 2 * half + i0;
#pragma unroll
                for (int ai = 0; ai < 2; ++ai) if (ai < nai) {
                    f32x4 cc[4], sn[4];
                    if (lat) {
#pragma unroll
                        for (int m = 0; m < 4; ++m) { const int ns = (row0 + ai * HALF + m * 16) & seqmask, pos = blk ? (ns & 63) : (ns >> 6);
                            cc[m] = *(const f32x4*)(tb + pos * half + i0); sn[m] = *(const f32x4*)(tb + 64 * half + pos * half + i0); } }
#pragma unroll
                    for (int m = 0; m < 4; ++m) { const int row = row0 + ai * HALF + m * 16; f32x4 x1 = acc[ai][bj][m][0], x2 = acc[ai][bj][m][1];
                        if (lat) { const f32x4 c = cc[m], s = sn[m];
                            const f32x4 y1 = x1 * c - x2 * s, y2 = x2 * c + x1 * s; x1 = y1; x2 = y2; }
                        u32x2 w1, w2; w1.x = cvt_pk_bf16(x1[0], x1[1]); w1.y = cvt_pk_bf16(x1[2], x1[3]); w2.x = cvt_pk_bf16(x2[0], x2[1]); w2.y = cvt_pk_bf16(x2[2], x2[3]);
                        bf16_t* rowp = O + (size_t)row * ldc + c1; *(u32x2*)rowp = w1; *(u32x2*)(rowp + half) = w2; } }
            } else {
#pragma unroll
                for (int ai = 0; ai < 2; ++ai) if (ai < nai)
#pragma unroll
                    for (int m = 0; m < 4; ++m) { const f32x4 v0 = acc[ai][bj][m][0], v1 = acc[ai][bj][m][1];
                        u32x4 w; w.x = cvt_pk_bf16(v0[0], v0[1]); w.y = cvt_pk_bf16(v0[2], v0[3]); w.z = cvt_pk_bf16(v1[0], v1[1]); w.w = cvt_pk_bf16(v1[2], v1[3]);
                        *(u32x4*)(O + (size_t)(row0 + ai * HALF + m * 16) * ldc + p0) = w; }
            }
        }
        if (stat) {
#pragma unroll
            for (int ai = 0; ai < 2; ++ai) if (ai < nai)
#pragma unroll
                for (int m = 0; m < 4; ++m) { float ss = 0.f;
#pragma unroll
                    for (int bj = 0; bj < 2; ++bj) { const f32x4 v0 = acc[ai][bj][m][0], v1 = acc[ai][bj][m][1];
                        ss += ((v0[0] * v0[0] + v0[1] * v0[1]) + (v0[2] * v0[2] + v0[3] * v0[3])) + ((v1[0] * v1[0] + v1[1] * v1[1]) + (v1[2] * v1[2] + v1[3] * v1[3])); }
                    ss += __int_as_float(__builtin_amdgcn_ds_swizzle(__float_as_int(ss), (16 << 10) | 0x1f));
                    { auto rr = __builtin_amdgcn_permlane32_swap(__float_as_uint(ss), __float_as_uint(ss), false, false); ss = __uint_as_float(rr[0]) + __uint_as_float(rr[1]); }
                    if (fq == 0) __hip_atomic_fetch_add(ssq + (size_t)(u.pn >> 1) * ssq_rows + row0 + ai * HALF + m * 16, ss, __ATOMIC_RELAXED, __HIP_MEMORY_SCOPE_AGENT); }
        }
    }
};

#ifndef PG8_ALIGN_DEFAULT
#define PG8_ALIGN_DEFAULT true
#endif
__device__ __forceinline__ f32x4 zero_quad() { f32x2 lo, hi; asm volatile("v_mov_b64 %0, 0" : "=v"(lo)); asm volatile("v_mov_b64 %0, 0" : "=v"(hi)); return (f32x4){lo[0], lo[1], hi[0], hi[1]}; }
template <class Epi, class Sched, bool ALIGN_EPI = PG8_ALIGN_DEFAULT, bool HALFM = false>
__device__ __forceinline__ void gemm_phase(PG8_LAS unsigned char* lds, const Gemm g, const Sched& S, const Epi& E, const int tid) {
    const int wid = __builtin_amdgcn_readfirstlane(tid >> 6), lane = tid & 63, wr = wid >> 2, wc = wid & 3, fr = lane & 15, fq = lane >> 4;
    const int K = g.K, nt = K / BK;
    unsigned voffA[2], voffB[2];
#pragma unroll
    for (int i = 0; i < 2; ++i) { int R, C; stage_rc(tid * 16 + i * 8192, R, C); const int Rb = Epi::PERM ? ((R & ~31) + perm32(R & 31)) : R;
        voffA[i] = (unsigned)(R * g.lda + C) * 2u; voffB[i] = (unsigned)(Rb * g.ldb + C) * 2u; }
    const size_t kstep = (size_t)(BK * 2), kstepA = g.kstepA ? (size_t)g.kstepA : kstep;
    const size_t hstepA = (size_t)HALF * g.lda * 2, hstepB = (size_t)HALF * g.ldb * 2;
    const size_t tstepA = 2 * hstepA, tstepB = 2 * hstepB; const size_t hA1 = HALFM ? (size_t)0 : hstepA;
#define PG8_AOFF(u) ((size_t)(u).pm * tstepA + ((HALFM && (u).hm == 2) ? hstepA : (size_t)0) + ((u).pn >= g.a_split_pn ? (size_t)g.a_split_off * 2 : (size_t)0) + (size_t)(u).ks * (g.ksplitA ? (size_t)g.ksplitA : (size_t)g.ksplit * 2))
#define PG8_BOFF(u) ((size_t)(u).pn * tstepB + (size_t)(u).ks * g.ksplit * 2)
    const unsigned ldsw = (unsigned)wid * 1024u;
    const int aoff = lds_byte(wr * 64 + fr, fq * 8), boff = lds_byte(wc * 32 + fr, fq * 8);
#define PG8_SA(b, h) (((b) * 2 + (h)) * HTB)
#define PG8_SB(b, h) ((4 + (b) * 2 + (h)) * HTB)
#define PG8_STAGE(bufoff, gbase, voff) do { _Pragma("unroll") for (int _i = 0; _i < 2; ++_i) \
        __builtin_amdgcn_global_load_lds((const unsigned*)((const char*)(gbase) + (voff)[_i]), (PG8_LAS unsigned*)(lds + (bufoff) + ldsw + _i * 8192), 16, 0, 0); } while (0)
#define PG8_LDA(dst, b, h) do { _Pragma("unroll") for (int m = 0; m < 4; ++m) _Pragma("unroll") for (int k = 0; k < 2; ++k) dst[m][k] = *(const PG8_LAS bf16x8*)(lds + PG8_SA(b, h) + aoff + m * 2048 + k * 1024); } while (0)
#define PG8_LDB(dst, b, h) do { _Pragma("unroll") for (int n = 0; n < 2; ++n) _Pragma("unroll") for (int k = 0; k < 2; ++k) dst[n][k] = *(const PG8_LAS bf16x8*)(lds + PG8_SB(b, h) + boff + n * 2048 + k * 1024); } while (0)
#define PG8_MMA(ai, bj, At, Bt) do { __builtin_amdgcn_s_setprio(1); _Pragma("unroll") for (int m = 0; m < 4; ++m) _Pragma("unroll") for (int n = 0; n < 2; ++n) _Pragma("unroll") for (int k = 0; k < 2; ++k) \
        acc[ai][bj][m][n] = __builtin_amdgcn_mfma_f32_16x16x32_bf16(Bt[n][k], At[m][k], acc[ai][bj][m][n], 0, 0, 0); __builtin_amdgcn_s_setprio(0); } while (0)
#define PG8_WAIT_V(n) asm volatile("s_waitcnt vmcnt(" #n ")" ::: "memory")
#define PG8_WAIT_L(n) asm volatile("s_waitcnt lgkmcnt(" #n ")" ::: "memory")
#define PG8_BAR __builtin_amdgcn_s_barrier()
#define PG8_SCHED __builtin_amdgcn_sched_barrier(0)
    Unit cur, nxt; int ui = 0;
    if (!S.next(0, cur)) return;
    f32x4 acc[2][2][4][2];
#pragma unroll
    for (int a = 0; a < 2; ++a)
#pragma unroll
        for (int b = 0; b < 2; ++b)
#pragma unroll
            for (int m = 0; m < 4; ++m)
#pragma unroll
                for (int n = 0; n < 2; ++n) acc[a][b][m][n] = zero_quad();
    bf16x8 At[4][2], B0[2][2], B1[2][2];
    const char* cA = (const char*)g.A + PG8_AOFF(cur); const char* cB = (const char*)g.Bt + PG8_BOFF(cur);
    S.a_ready(cur);
    {
        PG8_STAGE(PG8_SB(0, 0), cB, voffB); PG8_STAGE(PG8_SB(0, 1), cB + hstepB, voffB); PG8_STAGE(PG8_SA(0, 0), cA, voffA); PG8_STAGE(PG8_SA(0, 1), cA + hA1, voffA);
        if (wr == 1) PG8_BAR;
        PG8_WAIT_V(2); PG8_BAR;
        PG8_STAGE(PG8_SB(1, 0), cB + kstep, voffB); PG8_STAGE(PG8_SA(1, 0), cA + kstepA, voffA); PG8_STAGE(PG8_SB(1, 1), cB + hstepB + kstep, voffB);
        PG8_WAIT_V(6); PG8_BAR;
    }
    for (;;) {
        const bool has_next = S.next(ui + 1, nxt);
        const char* nA = has_next ? (const char*)g.A + PG8_AOFF(nxt) : cA; const char* nB = has_next ? (const char*)g.Bt + PG8_BOFF(nxt) : cB;
        for (int t = 0; t < nt; t += 2) {
            const bool last = (t == nt - 2);
            const char* a1 = cA + (size_t)(t + 1) * kstepA;
            const char* a2 = last ? nA : cA + (size_t)(t + 2) * kstepA; const char* b2 = last ? nB : cB + (size_t)(t + 2) * kstep;
            const char* a3 = a2 + kstepA; const char* b3 = b2 + kstep;
            if (last && has_next) S.a_ready(nxt);
            {
            PG8_LDB(B0, 0, 0); PG8_LDB(B1, 0, 1); PG8_SCHED; PG8_LDA(At, 0, 0); PG8_STAGE(PG8_SA(1, 1), a1 + hA1, voffA);
            PG8_WAIT_V(8); PG8_WAIT_L(0); PG8_BAR; PG8_MMA(0, 0, At, B0); PG8_MMA(0, 1, At, B1); PG8_BAR; PG8_SCHED;
            PG8_LDA(At, 0, 1); PG8_STAGE(PG8_SB(0, 0), b2, voffB); PG8_STAGE(PG8_SB(0, 1), b2 + hstepB, voffB); PG8_STAGE(PG8_SA(0, 0), a2, voffA);
            PG8_WAIT_V(8); PG8_WAIT_L(0); PG8_BAR; if constexpr (!HALFM) { PG8_MMA(1, 0, At, B0); PG8_MMA(1, 1, At, B1); } PG8_BAR; PG8_SCHED;
            PG8_LDB(B0, 1, 0); PG8_LDB(B1, 1, 1); PG8_SCHED; PG8_LDA(At, 1, 0); PG8_STAGE(PG8_SA(0, 1), a2 + hA1, voffA);
            PG8_WAIT_V(8); PG8_WAIT_L(0); PG8_BAR; PG8_MMA(0, 0, At, B0); PG8_MMA(0, 1, At, B1); PG8_BAR; PG8_SCHED;
            PG8_LDA(At, 1, 1); PG8_STAGE(PG8_SB(1, 0), b3, voffB); PG8_STAGE(PG8_SB(1, 1), b3 + hstepB, voffB); PG8_STAGE(PG8_SA(1, 0), a3, voffA);
            PG8_WAIT_V(8); PG8_WAIT_L(0); PG8_BAR; if constexpr (!HALFM) { PG8_MMA(1, 0, At, B0); PG8_MMA(1, 1, At, B1); } PG8_BAR; PG8_SCHED;
            }
        }
        if constexpr (ALIGN_EPI) { if (wr == 0) PG8_BAR; }
        if constexpr (!Epi::AFTER_DRAIN) { E(acc, cur, wr, wc, fr, fq); S.done(cur); }
        if (!has_next) break;
#pragma unroll
        for (int a = 0; a < 2; ++a)
#pragma unroll
            for (int b = 0; b < 2; ++b)
#pragma unroll
                for (int m = 0; m < 4; ++m)
#pragma unroll
                    for (int n = 0; n < 2; ++n) acc[a][b][m][n] = zero_quad();
        cur = nxt; cA = nA; cB = nB; ++ui;
        if constexpr (ALIGN_EPI) { if (wr == 1) PG8_BAR; }
    }
    PG8_WAIT_V(0);
    if constexpr (!ALIGN_EPI) { if (wr == 0) PG8_BAR; }
    PG8_BAR;
    if constexpr (Epi::AFTER_DRAIN) { E.fused(acc, cur, wr, wc, fr, fq, lds, wid, lane); S.done(cur); }
#undef PG8_AOFF
#undef PG8_BOFF
#undef PG8_SA
#undef PG8_SB
#undef PG8_STAGE
#undef PG8_LDA
#undef PG8_LDB
#undef PG8_MMA
#undef PG8_WAIT_V
#undef PG8_WAIT_L
#undef PG8_BAR
#undef PG8_SCHED
}
}
namespace att {
typedef unsigned short bf16;
using bf16x8 = __attribute__((ext_vector_type(8))) short;
using s16x4  = __attribute__((ext_vector_type(4))) short;
using f32x16 = __attribute__((ext_vector_type(16))) float;
using f32x4  = __attribute__((ext_vector_type(4))) float;
using u32x4  = __attribute__((ext_vector_type(4))) unsigned;
constexpr int NW = 8, QBLK = 32, KVBLK = 64, DV = 128;
constexpr float THR = 8.f;
#define ATT_SBAR() __builtin_amdgcn_sched_barrier(0)
__device__ __forceinline__ int crow(int r, int hi) { return (r & 3) + 8 * (r >> 2) + 4 * hi; }
typedef float f32x2_t __attribute__((ext_vector_type(2))); typedef __bf16 bf16x2_t __attribute__((ext_vector_type(2)));
__device__ __forceinline__ unsigned cvtpk(float lo, float hi) { f32x2_t v = {lo, hi}; bf16x2_t b = __builtin_convertvector(v, bf16x2_t); return __builtin_bit_cast(unsigned, b); }
__device__ __forceinline__ float bf2f(short s) { return __uint_as_float(((unsigned)(unsigned short)s) << 16); }
__device__ __forceinline__ short f2bf(float f) { unsigned u = __float_as_uint(f); u += 0x7fffu + ((u >> 16) & 1u); return (short)(u >> 16); }

template <int DQK> struct Cfg {
    static constexpr int KROW = DQK * 2 + 16;
    static constexpr int SHM_V = KVBLK * DV * 2, SHM_K = KVBLK * KROW;
    static constexpr int OFF_V = 0, OFF_K = 2 * SHM_V, OFF_WS = 2 * SHM_V + 2 * SHM_K, BYTES = OFF_WS + NW * 64 * 4;
};

__device__ __forceinline__ void partialSM(f32x16& p0, f32x16& p1, float& m_reg, float& mn, float& alpha, const float C, const float TS) {
    float pmax = p0[0];
#pragma unroll
    for (int r = 1; r < 16; ++r) pmax = fmaxf(pmax, p0[r]);
#pragma unroll
    for (int r = 0; r < 16; ++r) pmax = fmaxf(pmax, p1[r]);
    { auto rr = __builtin_amdgcn_permlane32_swap(__float_as_uint(pmax), __float_as_uint(pmax), false, false);
      pmax = fmaxf(__uint_as_float(rr[0]), __uint_as_float(rr[1])); }
    if (__builtin_expect(__all(pmax - m_reg <= TS), 1)) { mn = m_reg; alpha = 1.f; }
    else { mn = fmaxf(m_reg, pmax); alpha = __builtin_amdgcn_exp2f((m_reg - mn) * C); m_reg = mn; }
    const float mnC = -mn * C;
#pragma unroll
    for (int r = 0; r < 16; ++r) p0[r] = fmaf(p0[r], C, mnC);
#pragma unroll
    for (int r = 0; r < 16; ++r) p1[r] = fmaf(p1[r], C, mnC);
#pragma unroll
    for (int r = 0; r < 16; ++r) p0[r] = __builtin_amdgcn_exp2f(p0[r]);
}
__device__ __forceinline__ void finishSM(f32x16& p0, f32x16& p1, float alpha, float& l_reg, bf16x8& pa0, bf16x8& pa1, bf16x8& pa2, bf16x8& pa3) {
#pragma unroll
    for (int r = 0; r < 16; ++r) p1[r] = __builtin_amdgcn_exp2f(p1[r]);
    float ps = 0;
#pragma unroll
    for (int r = 0; r < 16; ++r) ps += p0[r];
#pragma unroll
    for (int r = 0; r < 16; ++r) ps += p1[r];
    { auto rr = __builtin_amdgcn_permlane32_swap(__float_as_uint(ps), __float_as_uint(ps), false, false);
      ps = __uint_as_float(rr[0]) + __uint_as_float(rr[1]); }
    l_reg = l_reg * alpha + ps;
#define ATT_PK4(P, BASE, OUT) do { unsigned a0 = cvtpk(P[BASE + 0], P[BASE + 1]), a1 = cvtpk(P[BASE + 2], P[BASE + 3]);   \
    unsigned b0 = cvtpk(P[BASE + 4], P[BASE + 5]), b1 = cvtpk(P[BASE + 6], P[BASE + 7]);                              \
    auto r0 = __builtin_amdgcn_permlane32_swap(a0, b0, false, false); auto r1 = __builtin_amdgcn_permlane32_swap(a1, b1, false, false); \
    u32x4 w = {r0[0], r1[0], r0[1], r1[1]}; OUT = *reinterpret_cast<bf16x8*>(&w); } while (0)
    ATT_PK4(p0, 0, pa0); ATT_PK4(p0, 8, pa1); ATT_PK4(p1, 0, pa2); ATT_PK4(p1, 8, pa3);
}
template <int DQK> __device__ __forceinline__ void qkt(f32x16& p0, f32x16& p1, const char* Ks, const bf16x8* qr, int r32, int hi) {
    constexpr int KROW = Cfg<DQK>::KROW;
    p0 = f32x16{}; p1 = f32x16{};
#pragma unroll
    for (int d0 = 0; d0 < DQK / 16; ++d0) { const int cb = (d0 * 16 + hi * 8) * 2;
        const bf16x8 b0 = *reinterpret_cast<const bf16x8*>(Ks + r32 * KROW + cb);
        const bf16x8 b1 = *reinterpret_cast<const bf16x8*>(Ks + (32 + r32) * KROW + cb);
        p0 = __builtin_amdgcn_mfma_f32_32x32x16_bf16(b0, qr[d0], p0, 0, 0, 0);
        p1 = __builtin_amdgcn_mfma_f32_32x32x16_bf16(b1, qr[d0], p1, 0, 0, 0); }
}
__device__ __forceinline__ int v_st(int k, int c) { const int kk = (k & ~0xC) | ((k & 4) << 1) | ((k & 8) >> 1); return ((kk >> 3) * 4 + (c >> 5)) * 512 + ((kk & 7) * 32 + (c & 31)) * 2; }
__device__ __forceinline__ int v_rd_base(int lane) { return ((lane & 3) << 3) | (((lane >> 2) & 3) << 6) | (((lane >> 4) & 1) << 5) | (((lane >> 5) & 1) << 8); }
constexpr int v_rd_off(int d0, int ks, int half) { return d0 * 512 + ks * 4096 + half * 2048; }
template <int OFF> __device__ __forceinline__ s16x4 tr_read(int vb) { s16x4 r; asm volatile("ds_read_b64_tr_b16 %0, %1 offset:%2" : "=&v"(r) : "v"(vb), "i"(OFF) : "memory"); return r; }
template <int D0> __device__ __forceinline__ void pv_one(f32x16& od, int vb, bf16x8 pa0, bf16x8 pa1, bf16x8 pa2, bf16x8 pa3) {
    const s16x4 l0 = tr_read<v_rd_off(D0, 0, 0)>(vb), h0 = tr_read<v_rd_off(D0, 0, 1)>(vb), l1 = tr_read<v_rd_off(D0, 1, 0)>(vb), h1 = tr_read<v_rd_off(D0, 1, 1)>(vb);
    const s16x4 l2 = tr_read<v_rd_off(D0, 2, 0)>(vb), h2 = tr_read<v_rd_off(D0, 2, 1)>(vb), l3 = tr_read<v_rd_off(D0, 3, 0)>(vb), h3 = tr_read<v_rd_off(D0, 3, 1)>(vb);
    asm volatile("s_waitcnt lgkmcnt(0)" ::: "memory"); ATT_SBAR();
#define ATT_PK(L, H) (bf16x8){L[0], L[1], L[2], L[3], H[0], H[1], H[2], H[3]}
    od = __builtin_amdgcn_mfma_f32_32x32x16_bf16(pa0, ATT_PK(l0, h0), od, 0, 0, 0);
    od = __builtin_amdgcn_mfma_f32_32x32x16_bf16(pa1, ATT_PK(l1, h1), od, 0, 0, 0);
    od = __builtin_amdgcn_mfma_f32_32x32x16_bf16(pa2, ATT_PK(l2, h2), od, 0, 0, 0);
    od = __builtin_amdgcn_mfma_f32_32x32x16_bf16(pa3, ATT_PK(l3, h3), od, 0, 0, 0);
}
__device__ __forceinline__ void pv_d0(f32x16* o, int vb, bf16x8 pa0, bf16x8 pa1, bf16x8 pa2, bf16x8 pa3) {
    pv_one<0>(o[0], vb, pa0, pa1, pa2, pa3); pv_one<1>(o[1], vb, pa0, pa1, pa2, pa3); pv_one<2>(o[2], vb, pa0, pa1, pa2, pa3); pv_one<3>(o[3], vb, pa0, pa1, pa2, pa3);
}
template <int OFF> __device__ __forceinline__ bf16x8 k_read(int ka) { bf16x8 r; asm volatile("ds_read_b128 %0, %1 offset:%2" : "=&v"(r) : "v"(ka), "i"(OFF) : "memory"); return r; }
template <int N> __device__ __forceinline__ void lgk_wait() { asm volatile("s_waitcnt lgkmcnt(%0)" :: "n"(N) : "memory"); }
constexpr int CS_LA = 6;
template <int DQK, int KB, int VB, bool PV, int F> __device__ __forceinline__ void cs_read(bf16x8 (&kf)[CS_LA + 1], s16x4 (&vf)[CS_LA + 1][2], const int ka, const int vb) {
    constexpr int KROW = Cfg<DQK>::KROW, KO = KB * Cfg<DQK>::SHM_K, VO = VB * Cfg<DQK>::SHM_V, NMK = DQK / 8, NM = NMK + (PV ? 16 : 0);
    if constexpr (F < NMK) kf[F % (CS_LA + 1)] = k_read<KO + (F & 1) * 32 * KROW + (F / 2) * 32>(ka);
    else if constexpr (F < NM) { constexpr int v = F - NMK;
        vf[F % (CS_LA + 1)][0] = tr_read<VO + v_rd_off(v / 4, v % 4, 0)>(vb); vf[F % (CS_LA + 1)][1] = tr_read<VO + v_rd_off(v / 4, v % 4, 1)>(vb); }
}
template <int DQK, bool PV> constexpr int cs_outstanding(int I) {
    const int NMK = DQK / 8, NM = NMK + (PV ? 16 : 0); int n = 0;
    for (int f = I + 1; f <= I + CS_LA - 1 && f < NM; ++f) n += (f < NMK) ? 1 : 2;
    return n;
}
template <int DQK, int KB, int VB, bool PV, int I> __device__ __forceinline__ void cs_step(f32x16& p0, f32x16& p1, f32x16* o, const bf16x8* qr, bf16x8 (&kf)[CS_LA + 1], s16x4 (&vf)[CS_LA + 1][2], const int ka, const int vb, const bf16x8 (&pa)[4]) {
    constexpr int NMK = DQK / 8, NM = NMK + (PV ? 16 : 0);
    if constexpr (I < NM) {
        lgk_wait<cs_outstanding<DQK, PV>(I)>(); ATT_SBAR();
        if constexpr (I < NMK) { if constexpr ((I & 1) == 0) p0 = __builtin_amdgcn_mfma_f32_32x32x16_bf16(kf[I % (CS_LA + 1)], qr[I / 2], p0, 0, 0, 0); else p1 = __builtin_amdgcn_mfma_f32_32x32x16_bf16(kf[I % (CS_LA + 1)], qr[I / 2], p1, 0, 0, 0); }
        else { constexpr int v = I - NMK; o[v / 4] = __builtin_amdgcn_mfma_f32_32x32x16_bf16(pa[v % 4], ATT_PK(vf[I % (CS_LA + 1)][0], vf[I % (CS_LA + 1)][1]), o[v / 4], 0, 0, 0); }
        ATT_SBAR();
        cs_read<DQK, KB, VB, PV, I + CS_LA>(kf, vf, ka, vb);
    }
}
template <int DQK, int KB, int VB, bool PV>
__device__ __forceinline__ void c_segment(f32x16& p0, f32x16& p1, f32x16* o, const bf16x8* qr, const int ka, const int vb, const bf16x8 pa0, const bf16x8 pa1, const bf16x8 pa2, const bf16x8 pa3) {
    bf16x8 kf[CS_LA + 1]; s16x4 vf[CS_LA + 1][2]; const bf16x8 pa[4] = {pa0, pa1, pa2, pa3};
    __builtin_amdgcn_s_setprio(1);
    cs_read<DQK, KB, VB, PV, 0>(kf, vf, ka, vb); cs_read<DQK, KB, VB, PV, 1>(kf, vf, ka, vb); cs_read<DQK, KB, VB, PV, 2>(kf, vf, ka, vb); cs_read<DQK, KB, VB, PV, 3>(kf, vf, ka, vb);
    if constexpr (CS_LA > 4) cs_read<DQK, KB, VB, PV, 4>(kf, vf, ka, vb); if constexpr (CS_LA > 5) cs_read<DQK, KB, VB, PV, 5>(kf, vf, ka, vb); if constexpr (CS_LA > 6) cs_read<DQK, KB, VB, PV, 6>(kf, vf, ka, vb); if constexpr (CS_LA > 7) cs_read<DQK, KB, VB, PV, 7>(kf, vf, ka, vb);
    p0 = f32x16{}; p1 = f32x16{};
#define CS_S(i) cs_step<DQK, KB, VB, PV, i>(p0, p1, o, qr, kf, vf, ka, vb, pa)
    CS_S(0); CS_S(1); CS_S(2); CS_S(3); CS_S(4); CS_S(5); CS_S(6); CS_S(7); CS_S(8); CS_S(9); CS_S(10); CS_S(11); CS_S(12); CS_S(13); CS_S(14); CS_S(15); CS_S(16); CS_S(17); CS_S(18); CS_S(19);
    CS_S(20); CS_S(21); CS_S(22); CS_S(23); CS_S(24); CS_S(25); CS_S(26); CS_S(27); CS_S(28); CS_S(29); CS_S(30); CS_S(31); CS_S(32); CS_S(33); CS_S(34); CS_S(35); CS_S(36); CS_S(37); CS_S(38); CS_S(39);
#undef CS_S
    __builtin_amdgcn_s_setprio(0);
}
template <int DQK, int VB>
__device__ __forceinline__ void pv_segment(f32x16* o, const int vb, const bf16x8 pa0, const bf16x8 pa1, const bf16x8 pa2, const bf16x8 pa3) {
    constexpr int VO = VB * Cfg<DQK>::SHM_V;
    s16x4 vf[CS_LA + 1][2]; const bf16x8 pa[4] = {pa0, pa1, pa2, pa3};
#define PV_RD(v) do { if constexpr ((v) < 16) { vf[(v) % (CS_LA + 1)][0] = tr_read<VO + v_rd_off((v) / 4, (v) % 4, 0)>(vb); vf[(v) % (CS_LA + 1)][1] = tr_read<VO + v_rd_off((v) / 4, (v) % 4, 1)>(vb); } } while (0)
#define PV_S(v) do { lgk_wait<2 * (((v) + CS_LA - 1 < 16 ? (v) + CS_LA - 1 : 15) - (v))>(); ATT_SBAR(); \
    o[(v) / 4] = __builtin_amdgcn_mfma_f32_32x32x16_bf16(pa[(v) % 4], ATT_PK(vf[(v) % (CS_LA + 1)][0], vf[(v) % (CS_LA + 1)][1]), o[(v) / 4], 0, 0, 0); ATT_SBAR(); PV_RD((v) + CS_LA); } while (0)
    PV_RD(0); PV_RD(1); PV_RD(2); PV_RD(3); if constexpr (CS_LA > 4) PV_RD(4); if constexpr (CS_LA > 5) PV_RD(5); if constexpr (CS_LA > 6) PV_RD(6); if constexpr (CS_LA > 7) PV_RD(7);
    PV_S(0); PV_S(1); PV_S(2); PV_S(3); PV_S(4); PV_S(5); PV_S(6); PV_S(7); PV_S(8); PV_S(9); PV_S(10); PV_S(11); PV_S(12); PV_S(13); PV_S(14); PV_S(15);
#undef PV_RD
#undef PV_S
}
__device__ __forceinline__ void rope_pair(bf16x8& a, bf16x8& b, const float* cs, const float* sn) {
    const f32x4 c0 = *(const f32x4*)cs, c1 = *(const f32x4*)(cs + 4), s0 = *(const f32x4*)sn, s1 = *(const f32x4*)(sn + 4);
#pragma unroll
    for (int e = 0; e < 8; ++e) { const float c = e < 4 ? c0[e & 3] : c1[e & 3], s = e < 4 ? s0[e & 3] : s1[e & 3]; const float x1 = bf2f(a[e]), x2 = bf2f(b[e]);
        a[e] = f2bf(x1 * c - x2 * s); b[e] = f2bf(x2 * c + x1 * s); }
}

struct Unit {
    const bf16* Q;
    const bf16* Kn;
    const bf16* Kr;
    const bf16* V;
    int t0a, nta, t0b, ntb;
    int mask;
    int qpos0, kpos0;
    int has_sink; float sink;
    int rope;
    const float* tab;
    bf16* O;
};

template <int DQK, int SDEPTH, int LDQ, int LDKN, int LDKR, int LDV, int LDO, int VAR = 0>
__device__ __forceinline__ void attn_unit(const Unit& U, char* lds, const float scale, const int tid) {
    using C_ = Cfg<DQK>;
    constexpr int KROW = C_::KROW, SHM_V = C_::SHM_V, SHM_K = C_::SHM_K, ND = DQK / 16;
    const float C = scale * 1.4426950408889634f, TS = THR / scale;
    const int wid = __builtin_amdgcn_readfirstlane(tid >> 6), lane = tid & 63, r32 = lane & 31, hi = lane >> 5;
    char* V_lds = lds + C_::OFF_V; char* K_lds = lds + C_::OFF_K;
    float* ws = (float*)(lds + C_::OFF_WS) + wid * 64; float* li_l = ws; float* al_l = ws + 32;
    float m_reg = -1e30f, l_reg = 0; f32x16 o[4] = {}; bf16x8 qr[ND];
    const int sr = tid >> 4, sc = (tid & 15) * 8, vst0 = v_st(sr, sc), vst1 = v_st(32 + sr, sc);
    const int kr_r = tid >> 3, kr_c = (tid & 7) * 8;
    const int vb0 = (int)(uintptr_t)V_lds + v_rd_base(lane), ka0 = (int)(uintptr_t)K_lds + r32 * KROW + hi * 16;
    bf16x8 vs0, vs1, ks0, ks1, kx;
    const int NT = U.nta + U.ntb;
#define ATT_TOK(j) ((j) < U.nta ? U.t0a + (j) * KVBLK : U.t0b + ((j) - U.nta) * KVBLK)
    const unsigned offV = (unsigned)(sr * LDV + sc) * 2u, offK = (unsigned)(sr * LDKN + sc) * 2u, offR = (unsigned)(kr_r * LDKR + kr_c) * 2u;
#define ATT_LOADV(j) do { const long tk = ATT_TOK(j); const char* vb_ = (const char*)(U.V + tk * LDV); \
    vs0 = *reinterpret_cast<const bf16x8*>(vb_ + offV); vs1 = *reinterpret_cast<const bf16x8*>(vb_ + (size_t)(32 * LDV * 2) + offV); } while (0)
#define ATT_LOADK(j) do { const long tk = ATT_TOK(j); const char* kb_ = (const char*)(U.Kn + tk * LDKN); \
    ks0 = *reinterpret_cast<const bf16x8*>(kb_ + offK); ks1 = *reinterpret_cast<const bf16x8*>(kb_ + (size_t)(32 * LDKN * 2) + offK); \
    if constexpr (DQK == 192) { const char* rb_ = (const char*)(U.Kr + tk * LDKR); kx = *reinterpret_cast<const bf16x8*>(rb_ + offR); } } while (0)
#define ATT_WRITEV(b) do { *(bf16x8*)(V_lds + (b) * SHM_V + vst0) = vs0; *(bf16x8*)(V_lds + (b) * SHM_V + vst1) = vs1; } while (0)
#define ATT_WRITEK(b) do { *(bf16x8*)(K_lds + (b) * SHM_K + sr * KROW + sc * 2) = ks0; *(bf16x8*)(K_lds + (b) * SHM_K + (32 + sr) * KROW + sc * 2) = ks1; \
    if constexpr (DQK == 192) *(bf16x8*)(K_lds + (b) * SHM_K + kr_r * KROW + (128 + kr_c) * 2) = kx; } while (0)
#define ATT_VWAIT() asm volatile("s_waitcnt vmcnt(0)" ::: "memory")
#define ATT_RESC(a) do { if (__any((a) < 1.f)) { if (hi == 0) al_l[r32] = (a); asm volatile("s_waitcnt lgkmcnt(0)" ::: "memory"); \
    _Pragma("unroll") for (int d = 0; d < 4; ++d) _Pragma("unroll") for (int r = 0; r < 16; ++r) o[d][r] *= al_l[crow(r, hi)]; } } while (0)
    const int qpos = U.qpos0 + wid * QBLK + r32;
#define ATT_MASK(P0, P1, j) do { if (U.mask && (j) < U.nta) { const int kb = U.kpos0 + (j) * KVBLK + 4 * hi - qpos; \
    _Pragma("unroll") for (int r = 0; r < 16; ++r) { const int dk = kb + (r & 3) + 8 * (r >> 2); \
        if (dk > 128 || dk < -128) P0[r] = -INFINITY; if (dk + 32 > 128 || dk + 32 < -128) P1[r] = -INFINITY; } } } while (0)
#define ATT_SEAM() do { ATT_SBAR(); __syncthreads(); ATT_SBAR(); } while (0)
#define ATT_L(j) do { if constexpr ((VAR & 1) != 0) { ATT_PK4(p0, 0, pa0); ATT_PK4(p0, 8, pa1); ATT_PK4(p1, 0, pa2); ATT_PK4(p1, 8, pa3); } else { \
    ATT_MASK(p0, p1, j); partialSM(p0, p1, m_reg, mn, al, C, TS); finishSM(p0, p1, al, l_reg, pa0, pa1, pa2, pa3); ATT_RESC(al); } } while (0)
    ATT_LOADK(0); ATT_LOADV(0);
    const bf16* Qw = U.Q + (long)(wid * QBLK + r32) * LDQ + hi * 8;
#pragma unroll
    for (int d0 = 0; d0 < ND; ++d0) qr[d0] = *reinterpret_cast<const bf16x8*>(Qw + d0 * 16);
    if (U.rope) {
        const int n = U.qpos0 + wid * QBLK + r32, prow = n >> 6, pcol = n & 63;
        if constexpr (DQK == 128) {
            const float* cr = U.tab + prow * 32 + hi * 8; const float* cc = U.tab + pcol * 32 + hi * 8;
            rope_pair(qr[0], qr[2], cr, cr + 2048); rope_pair(qr[1], qr[3], cr + 16, cr + 16 + 2048);
            rope_pair(qr[4], qr[6], cc, cc + 2048); rope_pair(qr[5], qr[7], cc + 16, cc + 16 + 2048);
        } else {
            const float* cr = U.tab + prow * 16 + hi * 8; const float* cc = U.tab + pcol * 16 + hi * 8;
            rope_pair(qr[8], qr[9], cr, cr + 1024); rope_pair(qr[10], qr[11], cc, cc + 1024);
        }
    }
    f32x16 p0, p1; float mn, al; bf16x8 pa0, pa1, pa2, pa3;
    ATT_VWAIT(); ATT_WRITEK(0); ATT_LOADK(1);
    ATT_SEAM();
#define ATT_LOADK_L(j) do { if constexpr ((VAR & 2) == 0) ATT_LOADK(j); } while (0)
#define ATT_LOADV_L(j) do { if constexpr ((VAR & 2) == 0) ATT_LOADV(j); } while (0)
    if (wid >= 4) __builtin_amdgcn_s_barrier();
    ATT_SBAR();
    c_segment<DQK, 0, 0, false>(p0, p1, o, qr, ka0, vb0, pa0, pa1, pa2, pa3);
    if constexpr ((VAR & 4) == 0) { ATT_VWAIT(); ATT_WRITEK(1); ATT_WRITEV(0); }
    if (2 < NT) ATT_LOADK_L(2); ATT_LOADV_L(1);
    ATT_SEAM(); ATT_L(0); ATT_SEAM();
    for (int j = 1; j + 1 < NT; j += 2) {
        c_segment<DQK, 1, 0, true>(p0, p1, o, qr, ka0, vb0, pa0, pa1, pa2, pa3);
        if constexpr ((VAR & 4) == 0) { ATT_VWAIT(); ATT_WRITEK(0); ATT_WRITEV(1); }
        ATT_LOADK_L(j + 2); ATT_LOADV_L(j + 1);
        ATT_SEAM(); ATT_L(j); ATT_SEAM();
        c_segment<DQK, 0, 1, true>(p0, p1, o, qr, ka0, vb0, pa0, pa1, pa2, pa3);
        if constexpr ((VAR & 4) == 0) { ATT_VWAIT(); ATT_WRITEK(1); ATT_WRITEV(0); }
        if (j + 3 < NT) ATT_LOADK_L(j + 3); ATT_LOADV_L(j + 2);
        ATT_SEAM(); ATT_L(j + 1); ATT_SEAM();
    }
    c_segment<DQK, 1, 0, true>(p0, p1, o, qr, ka0, vb0, pa0, pa1, pa2, pa3);
    if constexpr ((VAR & 4) == 0) { ATT_VWAIT(); ATT_WRITEV(1); }
    ATT_SEAM(); ATT_L(NT - 1); ATT_SEAM();
    pv_segment<DQK, 1>(o, vb0, pa0, pa1, pa2, pa3);
    ATT_SBAR();
    if (wid < 4) __builtin_amdgcn_s_barrier();
    ATT_SBAR();
    if (U.has_sink) l_reg += __builtin_amdgcn_exp2f(U.sink * 1.4426950408889634f - m_reg * C);
    if (hi == 0) li_l[r32] = l_reg; asm volatile("s_waitcnt lgkmcnt(0)" ::: "memory");
    float rli[16];
#pragma unroll
    for (int r = 0; r < 16; ++r) rli[r] = __builtin_amdgcn_rcpf(li_l[crow(r, hi)]);
    bf16* Ow = U.O + (long)(wid * QBLK) * LDO;
#pragma unroll
    for (int r = 0; r < 16; ++r) { const int orow = crow(r, hi);
#pragma unroll
        for (int d0 = 0; d0 < 4; ++d0) Ow[(long)orow * LDO + d0 * 32 + r32] = (bf16)cvtpk(o[d0][r] * rli[r], 0.f); }
    __syncthreads();
#undef ATT_TOK
#undef ATT_LOADV
#undef ATT_LOADK
#undef ATT_WRITEV
#undef ATT_WRITEK
#undef ATT_VWAIT
#undef ATT_RESC
#undef ATT_MASK
#undef ATT_SEAM
#undef ATT_L
#undef ATT_LOADK_L
#undef ATT_LOADV_L
}
}

namespace gla {
using att::bf16; using att::bf16x8; using att::s16x4; using att::f32x16; using att::f32x4; using att::u32x4; using att::crow; using att::cvtpk; using att::bf2f; using att::f2bf;
constexpr int ROWB = 144;
constexpr int T_QI = 0, T_KI = 64 * ROWB, T_KIT = 2 * 64 * ROWB, T_V = 3 * 64 * ROWB  , T_BYTES = T_V + 16384  ;
constexpr int OFF_ST = 2 * T_BYTES  , OFF_DEC = OFF_ST + 128 * ROWB  , BYTES = OFF_DEC + 2 * 256;
static_assert(T_V % 16 == 0 && T_BYTES % 16 == 0 && OFF_ST % 16 == 0 && BYTES <= 131072, "gla LDS map");
struct Unit {
    const bf16* P; int ldp;
    const float* wg; const float* bg;
    bf16* og;
    int b, h, dir;
};
__device__ __forceinline__ float log_sigmoid(float z) { return fminf(z, 0.f) - __logf(1.f + __expf(-fabsf(z))); }
template <int CTRL, int ROWMASK> __device__ __forceinline__ float dpp_add(float v) { return v + __int_as_float(__builtin_amdgcn_update_dpp(0, __float_as_int(v), CTRL, ROWMASK, 0xf, false)); }
__device__ __forceinline__ float wave_prefix(float v) {
    v = dpp_add<0x111, 0xf>(v); v = dpp_add<0x112, 0xf>(v); v = dpp_add<0x114, 0xf>(v); v = dpp_add<0x118, 0xf>(v);
    v = dpp_add<0x142, 0xa>(v);
    v = dpp_add<0x143, 0xc>(v);
    return v;
}

__device__ __forceinline__ void gla_unit(const Unit& U, char* lds, const int tid) {
    const int wid = __builtin_amdgcn_readfirstlane(tid >> 6), lane = tid & 63, r32 = lane & 31, hi = lane >> 5;
    const int h = U.h, dir = U.dir;
    for (int i = tid; i < 128 * ROWB / 4; i += 512) ((unsigned*)(lds + OFF_ST))[i] = 0u;
#define GLA_TB(s) ((s) < 4 ? NLAT + U.b * CTX + 64 * (dir ? 3 - (s) : (s)) : U.b * SEQ + 64 * (dir ? 67 - (s) : (s) - 4))
#define GLA_TOK(tb, i) ((long)((tb) + (dir ? 63 - (i) : (i))))
    if (wid < 4) {
        typedef short s16x4v __attribute__((ext_vector_type(4)));
        const int w = wid, pt = tid, t16 = lane & 15, dq = lane >> 4;
        s16x4v wa; f32x4 bias4;
#pragma unroll
        for (int e = 0; e < 4; ++e) { wa[e] = f2bf(U.wg[(4 * dq + e) * 256 + h * 64 + 16 * w + t16]); bias4[e] = U.bg[h * 64 + 16 * w + 4 * dq + e]; }
        s16x4v qr_[4], kr_[4], gr_[4]; bf16x8 vv[4];
#define GLA_LOAD(s) do { const int tb_ = GLA_TB(s); \
    _Pragma("unroll") for (int b4 = 0; b4 < 4; ++b4) { const bf16* row = U.P + GLA_TOK(tb_, 16 * b4 + t16) * U.ldp; \
        qr_[b4] = *reinterpret_cast<const s16x4v*>(row + C_GQ + h * 64 + 16 * w + 4 * dq); kr_[b4] = *reinterpret_cast<const s16x4v*>(row + C_GK + h * 64 + 16 * w + 4 * dq); \
        gr_[b4] = *reinterpret_cast<const s16x4v*>(row + C_GLR + dir * 16 + 4 * dq); } \
    _Pragma("unroll") for (int c_ = 0; c_ < 4; ++c_) { const int ch = pt + 256 * c_; vv[c_] = *reinterpret_cast<const bf16x8*>(U.P + GLA_TOK(tb_, ch >> 4) * U.ldp + C_GV + h * 128 + (ch & 15) * 8); } } while (0)
#define GLA_PREP(buf) do { char* T = lds + (buf) * T_BYTES; \
    f32x4 carry = {0.f, 0.f, 0.f, 0.f}; \
    _Pragma("unroll") for (int b4 = 0; b4 < 4; ++b4) { const int irow = 16 * b4 + t16; \
        f32x4 z = __builtin_amdgcn_mfma_f32_16x16x16bf16_1k(wa, gr_[b4], bias4, 0, 0, 0);            \
        s16x4v qo, ko; \
        _Pragma("unroll") for (int r = 0; r < 4; ++r) { float v = log_sigmoid(z[r]) * (1.f / 16.f); \
            v = dpp_add<0x111, 0xf>(v); v = dpp_add<0x112, 0xf>(v); v = dpp_add<0x114, 0xf>(v); v = dpp_add<0x118, 0xf>(v);     \
            v += carry[r]; carry[r] = __int_as_float(__builtin_amdgcn_ds_swizzle(__float_as_int(v), 0x1F0));                    \
            const short ks = f2bf(bf2f(kr_[b4][r]) * __expf(-v)); \
            qo[r] = f2bf(bf2f(qr_[b4][r]) * 0.125f * __expf(v)); ko[r] = ks; \
            *(short*)(T + T_KIT + (16 * w + 4 * dq + r) * ROWB + irow * 2) = ks; } \
        *(s16x4v*)(T + T_QI + irow * ROWB + (16 * w + 4 * dq) * 2) = qo; *(s16x4v*)(T + T_KI + irow * ROWB + (16 * w + 4 * dq) * 2) = ko; } \
    if (t16 == 0) { f32x4 dv; _Pragma("unroll") for (int r = 0; r < 4; ++r) dv[r] = __expf(carry[r]); *(f32x4*)(lds + OFF_DEC + (buf) * 256 + (16 * w + 4 * dq) * 4) = dv; } \
    _Pragma("unroll") for (int c_ = 0; c_ < 4; ++c_) { const int ch = pt + 256 * c_; *(bf16x8*)(T + T_V + att::v_st(ch >> 4, (ch & 15) * 8)) = vv[c_]; } } while (0)
        GLA_LOAD(0); GLA_PREP(0); GLA_LOAD(1);
        __syncthreads();
        for (int s = 0; s < 68; ++s) {
            if (s + 1 < 68) { GLA_PREP((s + 1) & 1); if (s + 2 < 68) GLA_LOAD(s + 2); }
            __syncthreads();
            __syncthreads();
        }
#undef GLA_LOAD
#undef GLA_PREP
    } else {
        const int m = wid - 4, rh = m & 1, ebp = m >> 1;
        f32x16 S0 = {}, S1 = {};
        __syncthreads();
        for (int s = 0; s < 68; ++s) {
            const int tb = GLA_TB(s); const char* T = lds + (s & 1) * T_BYTES; const float* DEC = (const float*)(lds + OFF_DEC + (s & 1) * 256);
            const int vb = (int)(uintptr_t)(T + T_V) + att::v_rd_base(lane) + (2 * ebp) * 512;
            bf16x8 qf[4];
#pragma unroll
            for (int d0 = 0; d0 < 4; ++d0) qf[d0] = *reinterpret_cast<const bf16x8*>(T + T_QI + (rh * 32 + r32) * ROWB + (d0 * 16 + hi * 8) * 2);
            f32x16 p0 = {}, p1 = {};
#pragma unroll
            for (int d0 = 0; d0 < 4; ++d0) { const int cb = (d0 * 16 + hi * 8) * 2;
                const bf16x8 ka = *reinterpret_cast<const bf16x8*>(T + T_KI + r32 * ROWB + cb), kb = *reinterpret_cast<const bf16x8*>(T + T_KI + (32 + r32) * ROWB + cb);
                p0 = __builtin_amdgcn_mfma_f32_32x32x16_bf16(ka, qf[d0], p0, 0, 0, 0); p1 = __builtin_amdgcn_mfma_f32_32x32x16_bf16(kb, qf[d0], p1, 0, 0, 0); }
            { const int irow = rh * 32 + r32 - dir;
#pragma unroll
              for (int r = 0; r < 16; ++r) { const int mm = crow(r, hi); if (mm > irow) p0[r] = 0.f; if (mm + 32 > irow) p1[r] = 0.f; } }
            bf16x8 pa0, pa1, pa2, pa3;
            ATT_PK4(p0, 0, pa0); ATT_PK4(p0, 8, pa1); ATT_PK4(p1, 0, pa2); ATT_PK4(p1, 8, pa3);
            bf16x8 kf[4];
#pragma unroll
            for (int ks = 0; ks < 4; ++ks) kf[ks] = *reinterpret_cast<const bf16x8*>(T + T_KIT + (rh * 32 + r32) * ROWB + (ks * 16 + hi * 8) * 2);
            float dec[16];
#pragma unroll
            for (int r = 0; r < 16; ++r) dec[r] = DEC[rh * 32 + crow(r, hi)];
#pragma unroll
            for (int eb2 = 0; eb2 < 2; ++eb2) { const int eb = 2 * ebp + eb2;
                f32x16 o = {};
                att::pv_one<0>(o, vb + eb2 * 512, pa0, pa1, pa2, pa3);
#pragma unroll
                for (int d0 = 0; d0 < 4; ++d0) { const bf16x8 sf = *reinterpret_cast<const bf16x8*>(lds + OFF_ST + (eb * 32 + r32) * ROWB + (d0 * 16 + hi * 8) * 2);
                    o = __builtin_amdgcn_mfma_f32_32x32x16_bf16(qf[d0], sf, o, 0, 0, 0); }
#pragma unroll
                for (int r = 0; r < 16; ++r) U.og[GLA_TOK(tb, rh * 32 + crow(r, hi)) * 512 + h * 128 + eb * 32 + r32] = (bf16)att::cvtpk(o[r], 0.f);
                if (eb2 == 0) { att::pv_one<0>(S0, vb, kf[0], kf[1], kf[2], kf[3]);
#pragma unroll
                    for (int r = 0; r < 16; ++r) S0[r] *= dec[r]; }
                else { att::pv_one<0>(S1, vb + 512, kf[0], kf[1], kf[2], kf[3]);
#pragma unroll
                    for (int r = 0; r < 16; ++r) S1[r] *= dec[r]; }
            }
            __syncthreads();
#pragma unroll
            for (int g = 0; g < 4; ++g) { uint2 wv; wv.x = cvtpk(S0[4 * g], S0[4 * g + 1]); wv.y = cvtpk(S0[4 * g + 2], S0[4 * g + 3]);
                *(uint2*)(lds + OFF_ST + ((2 * ebp) * 32 + r32) * ROWB + (rh * 32 + 8 * g + 4 * hi) * 2) = wv;
                uint2 wu; wu.x = cvtpk(S1[4 * g], S1[4 * g + 1]); wu.y = cvtpk(S1[4 * g + 2], S1[4 * g + 3]);
                *(uint2*)(lds + OFF_ST + ((2 * ebp + 1) * 32 + r32) * ROWB + (rh * 32 + 8 * g + 4 * hi) * 2) = wu; }
            __syncthreads();
        }
    }
    __syncthreads();
#undef GLA_TB
#undef GLA_TOK
}
}

constexpr size_t MiB = 1u << 20;
constexpr size_t WS_CTL = 0, CTL_BYTES = 1 * MiB;
constexpr size_t WS_SSQ = 1 * MiB;
constexpr size_t MOD_BYTES = (size_t)DEPTH * 9 * NMOD * D_MODEL * 4;
constexpr size_t ZERO_BYTES = 3 * MiB;
static_assert(WS_SSQ + (size_t)DEPTH * 2 * NTOK * 4 <= ZERO_BYTES, "zeroed region");
constexpr size_t WS_TAB = 3 * MiB;
constexpr size_t WS_RSTD = WS_TAB + 64 * 1024;
constexpr size_t WS_W = 4 * MiB;
constexpr size_t W_IN = 0, W_UQKV = W_IN + (size_t)IN_WP * D_MODEL * 2, W_OUT = W_UQKV + (size_t)(UQ_WP + UKV_W) * 512 * 2, W_GU = W_OUT + (size_t)D_MODEL * D_MODEL * 2,
                 W_DOWN = W_GU + (size_t)2 * FFN * D_MODEL * 2, W_LAYER = W_DOWN + (size_t)D_MODEL * FFN * 2;
constexpr size_t WS_H = WS_W + DEPTH * W_LAYER;
constexpr size_t WS_MIX = WS_H + (size_t)NTOK * D_MODEL * 2;
constexpr size_t WS_XC = WS_MIX + (size_t)NTOK * D_MODEL * 2;
constexpr size_t WS_R1 = WS_XC + (size_t)NCTX * D_MODEL * 4;
constexpr size_t WS_P = WS_R1, WS_Q = WS_P + (size_t)NTOK * IN_WP * 2, WS_KV = WS_Q + (size_t)NTOK * UQ_WP * 2, WS_GOF = WS_KV + (size_t)NTOK * UKV_W * 2,
                 WS_GOB = WS_GOF + (size_t)NTOK * 512 * 4, WS_R1_END = WS_GOB + (size_t)NTOK * 512 * 4;
constexpr size_t WS_ACT = WS_R1;
static_assert(WS_ACT + (size_t)NTOK * FFN * 2 <= WS_R1_END, "ACT overlay fits");
constexpr size_t WS_PART = WS_R1_END;
constexpr size_t WS_XS = WS_PART + (size_t)4 * NCTX * D_MODEL * 4;
constexpr size_t WS_MODX = WS_XS + 2 * MiB;
constexpr size_t WS_END = WS_MODX + 2 * MiB;
static_assert(W_LAYER % 256 == 0 && WS_H % 256 == 0 && WS_R1 % 256 == 0 && WS_Q % 256 == 0 && WS_KV % 256 == 0 && WS_GOF % 256 == 0, "alignment");
constexpr int CW_BAR = 4096;
constexpr int CW_PANEL = 32768;
constexpr int CW_QUEUE = 16384;
constexpr int RING_BYTES = 131072, LDSCTL_OFF = RING_BYTES, LDS_BYTES = 147456;

#define GAS __attribute__((address_space(1)))
#define LAS __attribute__((address_space(3)))
typedef unsigned short bf16;
typedef unsigned v4u __attribute__((ext_vector_type(4)));
typedef unsigned v2u __attribute__((ext_vector_type(2)));
typedef float f32x4 __attribute__((ext_vector_type(4)));
#define LDS_WAIT() asm volatile("s_waitcnt lgkmcnt(0)" ::: "memory")
__device__ __forceinline__ unsigned f2bf(float f) { unsigned u = __builtin_bit_cast(unsigned, f); return (u + 0x7fffu + ((u >> 16) & 1u)) >> 16; }
__device__ __forceinline__ unsigned pk2(float lo, float hi) { return f2bf(lo) | (f2bf(hi) << 16); }
__device__ __forceinline__ float bflo(unsigned w) { return __uint_as_float(w << 16); }
__device__ __forceinline__ float bfhi(unsigned w) { return __uint_as_float(w & 0xffff0000u); }
template <int O> __device__ __forceinline__ float swz_xor(float v) { return __int_as_float(__builtin_amdgcn_ds_swizzle(__float_as_int(v), (O << 10) | 0x1f)); }
__device__ __forceinline__ float sum16(float v) { v += swz_xor<1>(v); v += swz_xor<2>(v); v += swz_xor<4>(v); v += swz_xor<8>(v); return v; }
__device__ __forceinline__ float sum32(float v) { v = sum16(v); v += swz_xor<16>(v); return v; }
__device__ __forceinline__ float wave_sum(float v) { v = sum32(v); auto rr = __builtin_amdgcn_permlane32_swap(__float_as_uint(v), __float_as_uint(v), false, false); return __uint_as_float(rr[0]) + __uint_as_float(rr[1]); }

#define XB_TMO      128
#define XB_XCNT(j)  (256  + 64 * (j))
#define XB_XSUB(j)  (1280 + 64 * (j))
#define XB_XGEN(j)  (2304 + 64 * (j))
#define XB_TOP      3328
#define XB_TOPGEN   3392
#define XCD_BAR_WORDS 3456
#define XB_SPIN_CAP (1u << 21)
__device__ __forceinline__ unsigned xb_ld(unsigned* p)              { return __hip_atomic_load(p, __ATOMIC_RELAXED, __HIP_MEMORY_SCOPE_AGENT); }
__device__ __forceinline__ unsigned xb_add(unsigned* p, unsigned v) { return __hip_atomic_fetch_add(p, v, __ATOMIC_RELAXED, __HIP_MEMORY_SCOPE_AGENT); }
__device__ __forceinline__ unsigned xb_xcc_id() { return (unsigned)__builtin_amdgcn_s_getreg((3 << 11) | 20) & 0xFu; }
#define XB_SPIN(cond, bar) do { unsigned _sp = 0; while (cond) { __builtin_amdgcn_s_sleep(1); \
    if ((++_sp & 255u) == 0u) { if (xb_ld(&(bar)[XB_TMO])) break; if (_sp > XB_SPIN_CAP) { atomicAdd(&(bar)[XB_TMO], 1u); break; } } } } while (0)
struct XcdBarrier { unsigned* bar; unsigned x; volatile LAS unsigned* st; };
__device__ __forceinline__ XcdBarrier xcd_barrier_post(unsigned* bar, volatile LAS unsigned* st) {
    XcdBarrier b; b.bar = bar; b.x = xb_xcc_id(); b.st = st;
    if (threadIdx.x == 0) (void)xb_add(&bar[XB_XCNT(b.x)], 1u);
    return b;
}
__device__ __forceinline__ void xcd_barrier_complete(unsigned* bar, unsigned x, unsigned& nloc, unsigned& nx) {
    const unsigned G = gridDim.x * gridDim.y * gridDim.z;
    unsigned sum, cnt, mine, sp = 0u;
    for (;;) {
        sum = 0u; cnt = 0u; mine = 0u;
#pragma unroll
        for (unsigned j = 0; j < 16; ++j) { const unsigned c = xb_ld(&bar[XB_XCNT(j)]); sum += c; cnt += (c > 0u) ? 1u : 0u; mine = (j == x) ? c : mine; }
        if (sum == G) break;
        __builtin_amdgcn_s_sleep(1);
        if ((++sp & 255u) == 0u) { if (xb_ld(&bar[XB_TMO])) break; if (sp > XB_SPIN_CAP) { atomicAdd(&bar[XB_TMO], 1u); break; } }
    }
    nloc = mine > 0u ? mine : 1u; nx = cnt > 0u ? cnt : 1u;
}
__device__ __forceinline__ void xcd_barrier(const XcdBarrier& b) {
    asm volatile("s_waitcnt vmcnt(0)" ::: "memory");
    __syncthreads();
    if (threadIdx.x == 0) {
        unsigned* bar = b.bar;
        const unsigned bx_ = (unsigned)__builtin_amdgcn_readfirstlane((int)xb_xcc_id());
        __builtin_amdgcn_s_waitcnt(0);
        unsigned nloc = b.st[0], nx = b.st[1];
        if (nloc == 0u) { xcd_barrier_complete(bar, bx_, nloc, nx); b.st[0] = nloc; b.st[1] = nx; }
        const unsigned old = xb_add(&bar[XB_XSUB(bx_)], 1u);
        const unsigned gen = old / nloc;
        if (old + 1u == (gen + 1u) * nloc) {
            __builtin_amdgcn_fence(__ATOMIC_RELEASE, "agent");
            asm volatile("s_waitcnt vmcnt(0)" ::: "memory");
            const unsigned og = xb_add(&bar[XB_TOP], 1u);
            const unsigned tg = og / nx;
            if (og + 1u == (tg + 1u) * nx) xb_add(&bar[XB_TOPGEN], 1u);
            else XB_SPIN(xb_ld(&bar[XB_TOPGEN]) == tg, bar);
            __builtin_amdgcn_fence(__ATOMIC_ACQUIRE, "agent");
            xb_add(&bar[XB_XGEN(bx_)], 1u);
            asm volatile("s_waitcnt vmcnt(0)" ::: "memory");
        } else {
            XB_SPIN(xb_ld(&bar[XB_XGEN(bx_)]) == gen, bar);
            __builtin_amdgcn_fence(__ATOMIC_ACQUIRE, "agent");
            asm volatile("s_waitcnt vmcnt(0)" ::: "memory");
        }
    }
    __syncthreads();
}

constexpr int NWAVES = 8;
struct Ptrs {
    const float *x, *c, *ctx, *c_ctx, *w_mod, *b_mod, *g_mix, *g_ffn, *w_in, *g_mla_q, *g_mla_kv, *w_mla_uq, *w_mla_ukv, *swa_sink, *w_gate_f, *b_gate_f, *w_gate_b, *b_gate_b, *g_gla_out,
                *w_out, *w_ffn_gu, *w_ffn_down, *g_final;
    float* out; unsigned char* ws;
};

template <bool INMAP = false>
__device__ __forceinline__ void transpose_item(const float* W, int K, int N, bf16* WT, int drow0, int k0, int n0, const float* kscale, LAS float* scr, int lane) {
    const int kk = lane >> 3, n4 = (lane & 7) * 4;
    f32x4 v[8];
#pragma unroll
    for (int i = 0; i < 8; ++i) v[i] = __builtin_nontemporal_load((const f32x4*)(W + (size_t)(k0 + 8 * i + kk) * N + n0 + n4));
#pragma unroll
    for (int i = 0; i < 8; ++i) { const int k = 8 * i + kk; f32x4 x = v[i]; if (kscale) x = x * kscale[k0 + k];
        scr[k * 33 + n4] = x.x; scr[k * 33 + n4 + 1] = x.y; scr[k * 33 + n4 + 2] = x.z; scr[k * 33 + n4 + 3] = x.w; }
    LDS_WAIT(); asm volatile("" ::: "memory");
    const int c = lane & 7;
#pragma unroll
    for (int j = 0; j < 4; ++j) { const int n = (lane >> 3) + 8 * j; const LAS float* s = scr + (8 * c) * 33 + n;
        v4u o; o.x = pk2(s[0 * 33], s[1 * 33]); o.y = pk2(s[2 * 33], s[3 * 33]); o.z = pk2(s[4 * 33], s[5 * 33]); o.w = pk2(s[6 * 33], s[7 * 33]);
        const int drow = INMAP ? pg8::w_in_row(drow0 + n) : drow0 + n;
        *(GAS v4u*)(WT + (size_t)drow * K + k0 + 8 * c) = o; }
    LDS_WAIT(); asm volatile("" ::: "memory");
}
constexpr int TI_IN = 32 * 123, TI_UQ = 8 * 36, TI_UKV = 8 * 48, TI_OUT = 32 * 64, TI_GU = 32 * 352, TI_DOWN = 88 * 64, TI_LAYER = TI_IN + TI_UQ + TI_UKV + TI_OUT + TI_GU + TI_DOWN, TI_EARLY = TI_IN + TI_UQ + TI_UKV;

__device__ __forceinline__ void sincos_d(double a, double& s, double& c) {
    const double TWO_PI = 6.283185307179586476925287, INV = 0.15915494309189533576888;
    const double k = __builtin_rint(a * INV); const double r = a - k * TWO_PI, r2 = r * r;
    double ts = 1.0, tc = 1.0;
#pragma unroll
    for (int n = 12; n >= 1; --n) { ts = 1.0 - ts * r2 / (double)((2 * n) * (2 * n + 1)); tc = 1.0 - tc * r2 / (double)((2 * n - 1) * (2 * n)); }
    s = r * ts; c = tc;
}

__device__ __forceinline__ void norm_rows(const float* xl, const float* xc, int M, bf16* H, const float* g, const float* modl, int ch_shift, int ch_scale, int gw, int NGW, int lane, const float* part, float* xc_out, int row_begin) {
    for (int row = row_begin + 2 * gw; row < M; row += 2 * NGW) {
        const bool lat = row < NLAT; const int gi = lat ? (row >> 12) : BATCH;
        const float* xr = lat ? xl + (size_t)row * D_MODEL : xc + (size_t)(row - NLAT) * D_MODEL;
        const float* sh = modl + (size_t)gi * (NMOD * D_MODEL) + ch_shift * D_MODEL; const float* sc = modl + (size_t)gi * (NMOD * D_MODEL) + ch_scale * D_MODEL;
        f32x4 v[2][8]; float ss[2] = {0.f, 0.f};
#pragma unroll
        for (int r = 0; r < 2; ++r)
#pragma unroll
            for (int j = 0; j < 8; ++j) v[r][j] = *(const f32x4*)(xr + (size_t)r * D_MODEL + 4 * lane + 256 * j);
        if (!lat && part) {
#pragma unroll
            for (int r = 0; r < 2; ++r) { const float* pr = part + (size_t)(row + r - NLAT) * D_MODEL + 4 * lane; float* xo = xc_out + (size_t)(row + r - NLAT) * D_MODEL + 4 * lane;
#pragma unroll
                for (int j = 0; j < 8; ++j) { const f32x4 p0 = *(const f32x4*)(pr + 256 * j), p1 = *(const f32x4*)(pr + (size_t)NCTX * D_MODEL + 256 * j), p2 = *(const f32x4*)(pr + (size_t)2 * NCTX * D_MODEL + 256 * j), p3 = *(const f32x4*)(pr + (size_t)3 * NCTX * D_MODEL + 256 * j);
                    v[r][j] = v[r][j] + ((p0 + p1) + (p2 + p3)); *(f32x4*)(xo + 256 * j) = v[r][j]; } }
        }
#pragma unroll
        for (int r = 0; r < 2; ++r)
#pragma unroll
            for (int j = 0; j < 8; ++j) ss[r] += (v[r][j].x * v[r][j].x + v[r][j].y * v[r][j].y) + (v[r][j].z * v[r][j].z + v[r][j].w * v[r][j].w);
        const float rstd0 = 1.f / sqrtf(wave_sum(ss[0]) * (1.f / D_MODEL) + EPS), rstd1 = 1.f / sqrtf(wave_sum(ss[1]) * (1.f / D_MODEL) + EPS);
        bf16* hr = H + (size_t)row * D_MODEL;
#pragma unroll
        for (int j = 0; j < 8; ++j) { const int col = 4 * lane + 256 * j; const f32x4 gv = *(const f32x4*)(g + col), sv = *(const f32x4*)(sc + col), hv = *(const f32x4*)(sh + col);
            const f32x4 gs = gv * (sv + 1.f);
            const f32x4 y0 = (v[0][j] * rstd0) * gs + hv, y1 = (v[1][j] * rstd1) * gs + hv;
            v2u o0; o0.x = pk2(y0.x, y0.y); o0.y = pk2(y0.z, y0.w); *(v2u*)(hr + col) = o0;
            v2u o1; o1.x = pk2(y1.x, y1.y); o1.y = pk2(y1.z, y1.w); *(v2u*)(hr + D_MODEL + col) = o1; }
    }
}
#ifndef DUP_G5
#define DUP_G5 1
#endif
#ifndef ACT_TILED
#define ACT_TILED 1
#endif
#ifndef EN_CONV
#define EN_CONV 1
#endif
#ifndef FUSE_NORM
#define FUSE_NORM 1
#endif
#ifndef BURN_MFMA
#define BURN_MFMA 0
#endif
#ifndef WGM_G1
#define WGM_G1 4
#endif
#ifndef WGM_G2
#define WGM_G2 8
#endif
#ifndef WGM_G4
#define WGM_G4 4
#endif
#ifndef REV_G5
#define REV_G5 1
#endif
#ifndef WGM_RES
#define WGM_RES 4
#endif
#ifndef DUP_G5
#define DUP_G5 1
#endif
#ifndef STAG_ON
#define STAG_ON 0
#endif
#ifndef DUP_MLA
#define DUP_MLA 1
#endif
#ifndef DUP_SWA
#define DUP_SWA 1
#endif
#ifndef DUP_P0T
#define DUP_P0T 1
#endif
#ifndef DUP_N1
#define DUP_N1 1
#endif
#ifndef DUP_G1
#define DUP_G1 1
#endif
#ifndef DUP_G2
#define DUP_G2 1
#endif
#ifndef DUP_GLA
#define DUP_GLA 1
#endif
#ifndef DUP_GL2
#define DUP_GL2 1
#endif
#ifndef DUP_N2
#define DUP_N2 1
#endif
#ifndef DUP_G4
#define DUP_G4 1
#endif
#ifndef EN_P0
#define EN_P0 1
#endif
#ifndef EN_N1
#define EN_N1 1
#endif
#ifndef EN_G1
#define EN_G1 1
#endif
#ifndef EN_GL1
#define EN_GL1 1
#endif
#ifndef EN_G2
#define EN_G2 1
#endif
#ifndef EN_MIX
#define EN_MIX 1
#endif
#ifndef EN_GL2
#define EN_GL2 1
#endif
#ifndef HALVE_LAST
#define HALVE_LAST 1
#endif
#ifndef PROBE_ATT
#define PROBE_ATT 0
#endif
#ifndef PROBE_ATT_VAR
#define PROBE_ATT_VAR 0
#endif
#ifndef EN_G3
#define EN_G3 1
#endif
#ifndef EN_N2
#define EN_N2 1
#endif
#ifndef EN_G4
#define EN_G4 1
#endif
#ifndef EN_G5
#define EN_G5 1
#endif
#ifndef EN_GLA
#define EN_GLA 1
#endif
#ifndef EN_MLA
#define EN_MLA 1
#endif
#ifndef EN_SWA
#define EN_SWA 1
#endif
#define CONVERT_ITEM(lc, rr) do { const int cl_ = (lc); int r = (rr); \
            bf16* wl = (bf16*)(ws + WS_W + (size_t)cl_ * W_LAYER); \
            if (r < TI_IN) { const int kb = r / 123, nb = r % 123; transpose_item<true>(AP->w_in + (size_t)cl_ * D_MODEL * IN_W, D_MODEL, IN_W, (bf16*)((char*)wl + W_IN), 32 * nb, 64 * kb, 32 * nb, nullptr, scr, lane); break; } r -= TI_IN; \
            if (r < TI_UQ) { const int kb = r / 36, nb = r % 36; transpose_item(AP->w_mla_uq + (size_t)cl_ * 512 * UQ_W, 512, UQ_W, (bf16*)((char*)wl + W_UQKV), 32 * nb, 64 * kb, 32 * nb, AP->g_mla_q + cl_ * 512, scr, lane); break; } r -= TI_UQ; \
            if (r < TI_UKV) { const int kb = r / 48, nb = r % 48; transpose_item(AP->w_mla_ukv + (size_t)cl_ * 512 * UKV_W, 512, UKV_W, (bf16*)((char*)wl + W_UQKV), UQ_WP + 32 * nb, 64 * kb, 32 * nb, AP->g_mla_kv + cl_ * 512, scr, lane); break; } r -= TI_UKV; \
            if (r < TI_OUT) { const int kb = r / 64, nb = r % 64; transpose_item(AP->w_out + (size_t)cl_ * D_MODEL * D_MODEL, D_MODEL, D_MODEL, (bf16*)((char*)wl + W_OUT), 32 * nb, 64 * kb, 32 * nb, nullptr, scr, lane); break; } r -= TI_OUT; \
            if (r < TI_GU) { const int kb = r / 352, nb = r % 352; const int n0 = 32 * nb; const int j = n0 < FFN ? n0 : n0 - FFN; const int drow = (j >> 7) * 256 + (n0 < FFN ? 0 : 128) + (j & 127); \
                transpose_item(AP->w_ffn_gu + (size_t)cl_ * D_MODEL * 2 * FFN, D_MODEL, 2 * FFN, (bf16*)((char*)wl + W_GU), drow, 64 * kb, n0, nullptr, scr, lane); break; } r -= TI_GU; \
            { const int kb = r / 64, nb = r % 64; transpose_item(AP->w_ffn_down + (size_t)cl_ * FFN * D_MODEL, FFN, D_MODEL, (bf16*)((char*)wl + W_DOWN), 32 * nb, 64 * kb, 32 * nb, nullptr, scr, lane); } \
    } while (0)
__global__ void __launch_bounds__(NWAVES * 64, 2) fwd_kernel(Ptrs A) {
    extern __shared__ __attribute__((aligned(16))) unsigned char lds_raw[];
    LAS unsigned char* lds = (LAS unsigned char*)lds_raw;
    const int G = gridDim.x, bx = blockIdx.x, NGW = G * NWAVES;
    const int vcu = (G % 8 == 0) ? (bx % 8) * (G / 8) + bx / 8 : bx;
#define STAGGER(nunits_, T_) do { if (STAG_ON) { const int r_ = (nunits_) % G; const int lg_ = bx >> 6, lgfree_ = (r_ + 63) >> 6; \
    if (r_ != 0 && lg_ >= lgfree_) { const unsigned long long w_ = (unsigned long long)((lg_ - lgfree_ + 1) * (T_) / (4 - lgfree_ + 1)); const unsigned long long t0_ = __builtin_amdgcn_s_memrealtime(); \
        while (__builtin_amdgcn_s_memrealtime() - t0_ < w_) __builtin_amdgcn_s_sleep(8); } } } while (0)
typedef const __attribute__((address_space(4))) Ptrs* KArgP;
#define PHASE_IDS() int tid = threadIdx.x; asm volatile("" : "+v"(tid)); const int lane = tid & 63, wave = __builtin_amdgcn_readfirstlane(tid >> 6), gw = vcu * NWAVES + wave; (void)lane; (void)gw; \
    KArgP AP = (KArgP)__builtin_amdgcn_kernarg_segment_ptr(); asm volatile("" : "+s"(AP)); \
    unsigned char* const ws = AP->ws; unsigned* const ctl = (unsigned*)(ws + WS_CTL); float* const MOD = (float*)(ws + WS_MODX); float* const SSQ = (float*)(ws + WS_SSQ) + (size_t)l * 2 * NTOK; (void)SSQ; float* const TAB32 = (float*)(ws + WS_TAB); float* const TAB16 = TAB32 + 4096; \
    float* const RSTDQ = (float*)(ws + WS_RSTD); float* const RSTDKV = RSTDQ + NTOK; bf16* const Hb = (bf16*)(ws + WS_H); bf16* const MIX = (bf16*)(ws + WS_MIX); float* const XC = (float*)(ws + WS_XC); \
    bf16* const Pb = (bf16*)(ws + WS_P); bf16* const Qb = (bf16*)(ws + WS_Q); bf16* const KVb = (bf16*)(ws + WS_KV); bf16* const GOF = (bf16*)(ws + WS_GOF); bf16* const GOB = (bf16*)(ws + WS_GOB); bf16* const ACT = (bf16*)(ws + WS_ACT); float* const PART = (float*)(ws + WS_PART); (void)PART; \
    const float* const modl = MOD + (size_t)l * 9 * (NMOD * D_MODEL); const float* const xl_in = (l == 0) ? AP->x : AP->out; const float* const xc_in = (l == 0) ? AP->ctx : XC; \
    const char* const wl = (const char*)(ws + WS_W + (size_t)l * W_LAYER); \
    (void)ctl; (void)MOD; (void)TAB32; (void)TAB16; (void)RSTDQ; (void)RSTDKV; (void)Hb; (void)MIX; (void)XC; (void)Pb; (void)Qb; (void)KVb; (void)GOF; (void)GOB; (void)ACT; (void)modl; (void)xl_in; (void)xc_in; (void)wl
    volatile LAS unsigned* LCTL = (volatile LAS unsigned*)(lds + LDSCTL_OFF);
    for (int u = threadIdx.x; u < (LDS_BYTES - LDSCTL_OFF) / 4; u += NWAVES * 64) LCTL[u] = 0u;
    __syncthreads();
    XcdBarrier bar = xcd_barrier_post((unsigned*)(A.ws + WS_CTL) + CW_BAR, LCTL);
#define GRID_BAR() xcd_barrier(bar)

#if EN_P0
        { const int l = 0; PHASE_IDS(); asm volatile("; PHASE_MARK EN_P0");
    {
        LAS float* sS = (LAS float*)lds;
        LAS float* sR = (LAS float*)(lds + 73728);
        for (int u = tid; u < 9 * D_MODEL; u += 512) { const int i = u >> 11, kx = u & (D_MODEL - 1); const float cv = i < BATCH ? AP->c[i * D_MODEL + kx] : AP->c_ctx[kx]; sS[u] = cv * pg8::fast_sigmoid(cv); }
        __syncthreads();
        for (int it = bx; it < DEPTH * 192; it += G) {
            const int l = it / 192, cchunk = it % 192, kk = lane >> 4, c4 = (lane & 15) * 4;
            f32x4 acc[9];
#pragma unroll
            for (int i = 0; i < 9; ++i) acc[i] = (f32x4){0.f, 0.f, 0.f, 0.f};
            const float* wp = AP->w_mod + ((size_t)l * D_MODEL + wave * 256 + kk) * (NMOD * D_MODEL) + cchunk * 64 + c4;
#pragma unroll 1
            for (int k8 = 0; k8 < 64; k8 += 8) { f32x4 wv[8];
#pragma unroll
                for (int q = 0; q < 8; ++q) wv[q] = __builtin_nontemporal_load((const f32x4*)(wp + (size_t)(4 * (k8 + q)) * (NMOD * D_MODEL)));
#pragma unroll
                for (int q = 0; q < 8; ++q) {
#pragma unroll
                    for (int i = 0; i < 9; ++i) acc[i] += wv[q] * sS[i * D_MODEL + wave * 256 + 4 * (k8 + q) + kk];
                    __builtin_amdgcn_sched_barrier(0); } }
#pragma unroll
            for (int i = 0; i < 9; ++i)
#pragma unroll
                for (int e = 0; e < 4; ++e) { float s = acc[i][e]; s += swz_xor<16>(s); auto rr = __builtin_amdgcn_permlane32_swap(__float_as_uint(s), __float_as_uint(s), false, false); acc[i][e] = __uint_as_float(rr[0]) + __uint_as_float(rr[1]); }
            if (lane < 16) {
#pragma unroll
                for (int i = 0; i < 9; ++i) *(LAS f32x4*)(sR + (wave * 9 + i) * 64 + c4) = acc[i]; }
            __syncthreads();
            for (int u = tid; u < 9 * 64; u += 512) { float s = 0.f;
#pragma unroll
                for (int w8 = 0; w8 < 8; ++w8) s += sR[w8 * 576 + u];
                const int i = u >> 6, col = cchunk * 64 + (u & 63);
                MOD[((size_t)l * 9 + i) * (NMOD * D_MODEL) + col] = s + AP->b_mod[(size_t)l * (NMOD * D_MODEL) + col]; }
            __syncthreads();
        }
        LAS float* scr = (LAS float*)(lds + wave * 16384);
        for (int it = gw; it < TI_LAYER; it += NGW) CONVERT_ITEM(0, it);
        for (int u = bx * 512 + tid; u < DEPTH * (160 * 2048 + 128 * 512) / 8; u += G * 512) {
            const int l = u / ((160 * 2048 + 128 * 512) / 8); const int r = u % ((160 * 2048 + 128 * 512) / 8);
            char* wl = (char*)(ws + WS_W + (size_t)l * W_LAYER);
            v4u z = {0u, 0u, 0u, 0u};
            if (r < 160 * 2048 / 8) *(v4u*)(wl + W_IN + (size_t)IN_W * D_MODEL * 2 + (size_t)r * 16) = z;
            else *(v4u*)(wl + W_UQKV + (size_t)UQ_W * 512 * 2 + (size_t)(r - 160 * 2048 / 8) * 16) = z;
        }
        for (int u = bx * 512 + tid; u < 64 * 32 + 64 * 16; u += G * 512) {
            const bool big = u < 2048; const int v = big ? u : u - 2048; const int half = big ? 32 : 16; const int pos = v / half, i = v % half;
            const double rr = big ? 0.74989420933245582730 : 0.56234132519034908039;
            double f = 1.0; for (int q = 0; q < i; ++q) f *= rr;
            double s, c; sincos_d((double)pos * f, s, c);
            float* T = big ? TAB32 : TAB16; T[v] = (float)c; T[64 * half + v] = (float)s;
        }
    }
        }
#endif
    GRID_BAR();

    for (int l = 0; l < DEPTH; ++l) {
        const bool last = (l == DEPTH - 1);
        const bool fused = FUSE_NORM && (G == 256);
        const int Mres = last ? NLAT : NTOK;

#if EN_N1
        { PHASE_IDS(); asm volatile("; PHASE_MARK EN_N1");
        _Pragma("unroll") for (int rep_ = 0; rep_ < DUP_N1; ++rep_) { if (rep_) GRID_BAR();
        norm_rows(xl_in, xc_in, NTOK, Hb, AP->g_mix + l * D_MODEL, modl, 0, 1, gw, NGW, lane, l > 0 ? PART : nullptr, XC, (fused && l > 0) ? NLAT : 0);
        }
        }
#endif
        GRID_BAR();

#if EN_G1
        { PHASE_IDS(); asm volatile("; PHASE_MARK EN_G1");
        _Pragma("unroll") for (int rep_ = 0; rep_ < DUP_G1; ++rep_) {
        { pg8::Gemm g{Hb, (const bf16*)(wl + W_IN), NTOK, IN_WP, D_MODEL, D_MODEL, 1 << 30, 0, D_MODEL, 0, 0, 0}; pg8::StaticOrder S; S.init(NTOK, IN_WP, G, bx, WGM_G1); S.mode = HALVE_LAST;
          pg8::EpiInProj E{Pb, IN_WP, SSQ, NTOK, TAB32, TAB16, NLAT, SEQ - 1};
          STAGGER((NTOK / 256) * (IN_WP / 256), 4000); pg8::gemm_phase<pg8::EpiInProj, pg8::StaticOrder>(lds, g, S, E, tid);
          if (HALVE_LAST) { S.mode = 2; pg8::gemm_phase<pg8::EpiInProj, pg8::StaticOrder, PG8_ALIGN_DEFAULT, true>(lds, g, S, E, tid); } }
        }
        }
#endif
        GRID_BAR();

#if EN_G2
        { PHASE_IDS(); asm volatile("; PHASE_MARK EN_G2");
        _Pragma("unroll") for (int rep_ = 0; rep_ < DUP_G2; ++rep_) {
        { pg8::Gemm g{Pb, (const bf16*)(wl + W_UQKV), NTOK, UQ_WP + UKV_W, 512, IN_WP, UQ_WP / 256, C_CKV, 512, 0, 0, 0}; pg8::StaticOrder S; S.init(NTOK, UQ_WP + UKV_W, G, bx, WGM_G2);
          pg8::EpiQKV E{Qb, UQ_WP, KVb, UKV_W, SSQ, SSQ + NTOK, UQ_WP / 256};
          STAGGER((NTOK / 256) * ((UQ_WP + UKV_W) / 256), 1000); pg8::gemm_phase<pg8::EpiQKV, pg8::StaticOrder>(lds, g, S, E, tid); }
        }
        }
#endif
        GRID_BAR();

#if EN_MIX
#if EN_GLA
        { PHASE_IDS(); asm volatile("; PHASE_MARK EN_GLA");
        _Pragma("nounroll") for (int rep_ = 0; rep_ < DUP_GLA; ++rep_) {
        if (bx < 64) {
            gla::Unit U; U.P = Pb; U.ldp = IN_WP; U.b = bx >> 3; U.h = (bx >> 1) & 3; U.dir = bx & 1;
            U.wg = (U.dir ? AP->w_gate_b : AP->w_gate_f) + (size_t)l * 16 * 256; U.bg = (U.dir ? AP->b_gate_b : AP->b_gate_f) + (size_t)l * 256; U.og = U.dir ? GOB : GOF;
            gla::gla_unit(U, (char*)lds_raw, tid);
        }
        }
        }
#endif
#if EN_CONV
        if (l + 1 < DEPTH && bx >= 64 && bx < 128) { PHASE_IDS();
            LAS float* scr = (LAS float*)(lds + wave * 16384);
            for (int it = (bx - 64) * NWAVES + wave; it < TI_LAYER; it += 64 * NWAVES) CONVERT_ITEM(l + 1, it);
            __syncthreads();
        }
#endif
#if EN_MLA
        { PHASE_IDS(); asm volatile("; PHASE_MARK EN_MLA");
        {
            const int nitem = last ? 768 : 816; unsigned* head = ctl + CW_QUEUE + (l * 2 + 0) * 64;
            for (;;) {
                if (tid == 0) LCTL[4] = xb_add(head, 1u);
                __syncthreads(); int it = (int)LCTL[4]; __syncthreads();
                if (it >= nitem * DUP_MLA) break;
                if (DUP_MLA > 1) it %= nitem;
                att::Unit U; const bool lat = it < 768; const int bh = lat ? it >> 4 : it - 768, qb = lat ? it & 15 : 0, b = bh / 6, h = bh % 6;
                const long row0 = lat ? (long)b * SEQ + qb * 256 : (long)NLAT + b * CTX;
                U.Q = Qb + row0 * UQ_WP + h * 192;
                U.Kn = KVb + h * 256; U.V = KVb + h * 256 + 128; U.Kr = Pb + C_KR;
                U.t0a = lat ? b * SEQ : NLAT + b * CTX; U.nta = lat ? 64 : 4; U.t0b = NLAT + b * CTX; U.ntb = lat ? 4 : 0;
                U.mask = 0; U.qpos0 = qb * 256; U.kpos0 = 0; U.has_sink = 0; U.sink = 0.f; U.rope = lat ? 1 : 0; U.tab = TAB16;
                U.O = MIX + row0 * D_MODEL + MX_MLA + h * 128;
                att::attn_unit<192, 1, UQ_WP, UKV_W, IN_WP, UKV_W, D_MODEL>(U, (char*)lds_raw, 0.07216878364870322f, tid);
            }
        }
        }
#endif
#if EN_SWA
        { PHASE_IDS(); asm volatile("; PHASE_MARK EN_SWA");
        {
            const int nitem = last ? 768 : 816; unsigned* head = ctl + CW_QUEUE + (l * 2 + 1) * 64;
            for (;;) {
                if (tid == 0) LCTL[4] = xb_add(head, 1u);
                __syncthreads(); int it = (int)LCTL[4]; __syncthreads();
                if (it >= nitem * DUP_SWA) break;
                if (DUP_SWA > 1) it %= nitem;
                att::Unit U; const bool lat = it < 768; const int bh = lat ? it >> 4 : it - 768, qb = lat ? it & 15 : 0, b = bh / 6, hq = bh % 6, kvh = hq / 3;
                const long row0 = lat ? (long)b * SEQ + qb * 256 : (long)NLAT + b * CTX;
                const int ks = lat ? (qb * 256 - 128 < 0 ? 0 : qb * 256 - 128) : 0, ke = lat ? (qb * 256 + 384 > SEQ ? SEQ : qb * 256 + 384) : 0;
                U.Q = Pb + row0 * IN_WP + C_QS + hq * 128;
                U.Kn = Pb + C_KS + kvh * 128; U.V = Pb + C_VS + kvh * 128; U.Kr = nullptr;
                U.t0a = lat ? b * SEQ + ks : NLAT + b * CTX; U.nta = lat ? (ke - ks) / 64 : 4; U.t0b = NLAT + b * CTX; U.ntb = lat ? 4 : 0;
                U.mask = lat ? 1 : 0; U.qpos0 = qb * 256; U.kpos0 = ks; U.has_sink = 1; U.sink = AP->swa_sink[l * 6 + hq]; U.rope = lat ? 1 : 0; U.tab = TAB32;
                U.O = MIX + row0 * D_MODEL + MX_SWA + hq * 128;
                att::attn_unit<128, 2, IN_WP, IN_WP, IN_WP, IN_WP, D_MODEL>(U, (char*)lds_raw, 0.08838834764831845f, tid);
            }
        }
        }
#endif
#if PROBE_ATT
        { PHASE_IDS(); asm volatile("; PHASE_MARK PROBE_ATT");
        {
            const int nitem = last ? 768 : 816; unsigned* head = ctl + CW_QUEUE + 2048 + l * 64;
            for (;;) {
                if (tid == 0) LCTL[4] = xb_add(head, 1u);
                __syncthreads(); int it = (int)LCTL[4]; __syncthreads();
                if (it >= nitem) break;
                att::Unit U; const bool lat = it < 768; const int bh = lat ? it >> 4 : it - 768, qb = lat ? it & 15 : 0, b = bh / 6, h = bh % 6;
                const long row0 = lat ? (long)b * SEQ + qb * 256 : (long)NLAT + b * CTX;
                U.Q = Qb + row0 * UQ_WP + h * 192;
                U.Kn = KVb + h * 256; U.V = KVb + h * 256 + 128; U.Kr = Pb + C_KR;
                U.t0a = lat ? b * SEQ : NLAT + b * CTX; U.nta = lat ? 64 : 4; U.t0b = NLAT + b * CTX; U.ntb = lat ? 4 : 0;
                U.mask = 0; U.qpos0 = qb * 256; U.kpos0 = 0; U.has_sink = 0; U.sink = 0.f; U.rope = lat ? 1 : 0; U.tab = TAB16;
                U.O = (att::bf16*)(ws + WS_PART) + (size_t)(it & 31) * 256 * D_MODEL + h * 128;
                att::attn_unit<192, 1, UQ_WP, UKV_W, IN_WP, UKV_W, D_MODEL, PROBE_ATT_VAR>(U, (char*)lds_raw, 0.07216878364870322f, tid);
            }
        }
        }
#endif
#endif
        GRID_BAR();

#if EN_GL2
        { PHASE_IDS(); asm volatile("; PHASE_MARK EN_GL2");
        _Pragma("unroll") for (int rep_ = 0; rep_ < DUP_GL2; ++rep_) { if (rep_) GRID_BAR();
        for (int row = gw; row < Mres; row += NGW) {
            const v4u fa = *(const v4u*)(GOF + (size_t)row * 512 + lane * 8), fb = *(const v4u*)(GOB + (size_t)row * 512 + lane * 8);
            const f32x4 o0 = {bflo(fa.x) + bflo(fb.x), bfhi(fa.x) + bfhi(fb.x), bflo(fa.y) + bflo(fb.y), bfhi(fa.y) + bfhi(fb.y)};
            const f32x4 o1 = {bflo(fa.z) + bflo(fb.z), bfhi(fa.z) + bfhi(fb.z), bflo(fa.w) + bflo(fb.w), bfhi(fa.w) + bfhi(fb.w)};
            float ss = (o0.x * o0.x + o0.y * o0.y) + (o0.z * o0.z + o0.w * o0.w) + (o1.x * o1.x + o1.y * o1.y) + (o1.z * o1.z + o1.w * o1.w);
            ss = sum16(ss);
            const float rs = 1.f / sqrtf(ss * (1.f / 128.f) + EPS);
            const float* gp = AP->g_gla_out + l * 512 + lane * 8; const f32x4 g0 = *(const f32x4*)gp, g1 = *(const f32x4*)(gp + 4);
            const v4u rw = *(const v4u*)(Pb + (size_t)row * IN_WP + C_GR + lane * 8);
            float r[8] = {bflo(rw.x), bfhi(rw.x), bflo(rw.y), bfhi(rw.y), bflo(rw.z), bfhi(rw.z), bflo(rw.w), bfhi(rw.w)};
            float y[8] = {o0.x * g0.x, o0.y * g0.y, o0.z * g0.z, o0.w * g0.w, o1.x * g1.x, o1.y * g1.y, o1.z * g1.z, o1.w * g1.w};
#pragma unroll
            for (int e = 0; e < 8; ++e) y[e] = y[e] * rs * (r[e] * pg8::fast_sigmoid(r[e]));
            v4u w; w.x = pk2(y[0], y[1]); w.y = pk2(y[2], y[3]); w.z = pk2(y[4], y[5]); w.w = pk2(y[6], y[7]);
            *(v4u*)(MIX + (size_t)row * D_MODEL + MX_GLA + lane * 8) = w;
        }
        }
        }
#endif
        GRID_BAR();

#if EN_G3
        { PHASE_IDS(); asm volatile("; PHASE_MARK EN_G3");
        {
          pg8::Gemm g{MIX, (const bf16*)(wl + W_OUT), NLAT, D_MODEL, D_MODEL, D_MODEL, 1 << 30, 0, D_MODEL, 0, 0, 0}; pg8::StaticOrder S; S.init(NLAT, D_MODEL, G, bx, WGM_RES);
          if (fused) { pg8::EpiResNorm E{xl_in, AP->out, modl + 2 * D_MODEL, NMOD * D_MODEL, Hb, AP->g_ffn + l * D_MODEL, modl + 3 * D_MODEL, modl + 4 * D_MODEL,
                                        (float*)(ws + WS_XS), ctl + CW_PANEL + ((l * 2 + 0) * 128) * 64, ctl + CW_BAR + XB_TMO, lds + LDSCTL_OFF + 2048, 0};
              pg8::gemm_phase<pg8::EpiResNorm, pg8::StaticOrder>(lds, g, S, E, tid); }
          else { pg8::EpiRes E{xl_in, xc_in, AP->out, XC, modl + 2 * D_MODEL, NMOD * D_MODEL, D_MODEL};
              pg8::gemm_phase<pg8::EpiRes, pg8::StaticOrder>(lds, g, S, E, tid); }
          if (!last) { pg8::Gemm g2{MIX + (size_t)NLAT * D_MODEL, (const bf16*)(wl + W_OUT), NCTX, D_MODEL, D_MODEL / 4, D_MODEL, 1 << 30, 0, D_MODEL, D_MODEL / 4, 0, 0}; pg8::SplitKOrder S2; S2.init(NCTX / 256, D_MODEL / 256, 4, G, bx);
              pg8::EpiPart E2{PART, modl + (size_t)BATCH * (NMOD * D_MODEL) + 2 * D_MODEL, NCTX, D_MODEL};
              pg8::gemm_phase<pg8::EpiPart, pg8::SplitKOrder>(lds, g2, S2, E2, tid); } }
        }
#endif
        GRID_BAR();

#if EN_N2
        { PHASE_IDS(); asm volatile("; PHASE_MARK EN_N2");
        _Pragma("unroll") for (int rep_ = 0; rep_ < DUP_N2; ++rep_) { if (rep_) GRID_BAR();
        norm_rows(AP->out, xc_in, Mres, Hb, AP->g_ffn + l * D_MODEL, modl, 3, 4, gw, NGW, lane, last ? nullptr : PART, XC, fused ? NLAT : 0);
        }
        }
#endif
        GRID_BAR();

#if EN_G4
        { PHASE_IDS(); asm volatile("; PHASE_MARK EN_G4");
        _Pragma("unroll") for (int rep_ = 0; rep_ < (DUP_G4 == 3 ? 1 : DUP_G4); ++rep_) {
        { pg8::Gemm g{Hb, (const bf16*)(wl + W_GU), Mres, 2 * FFN, D_MODEL, D_MODEL, 1 << 30, 0, D_MODEL, 0, 0, 0}; pg8::StaticOrder S; S.init(Mres, 2 * FFN, G, bx, WGM_G4); S.mode = HALVE_LAST;
          pg8::EpiSwiglu E{ACT, FFN, ACT_TILED ? NTOK : 0};
          STAGGER((Mres / 256) * (2 * FFN / 256), 4000);
          if (DUP_G4 == 3) { pg8::EpiSum E3{(float*)(ws + WS_MIX)};
              pg8::gemm_phase<pg8::EpiSum, pg8::StaticOrder>(lds, g, S, E3, tid); }
          pg8::gemm_phase<pg8::EpiSwiglu, pg8::StaticOrder>(lds, g, S, E, tid);
          if (HALVE_LAST) { S.mode = 2; pg8::gemm_phase<pg8::EpiSwiglu, pg8::StaticOrder, PG8_ALIGN_DEFAULT, true>(lds, g, S, E, tid); } }
        }
        }
#endif
        GRID_BAR();

#if EN_G5
        { PHASE_IDS(); asm volatile("; PHASE_MARK EN_G5");
        { pg8::Gemm g{ACT, (const bf16*)(wl + W_DOWN), NLAT, D_MODEL, FFN, ACT_TILED ? 64 : FFN, 1 << 30, 0, FFN, 0, ACT_TILED ? (long)NTOK * 128 : 0, 0}; pg8::StaticOrder S; S.init(NLAT, D_MODEL, G, bx, WGM_RES, REV_G5);
          if (fused) { const float* modn = MOD + (size_t)(l + 1) * 9 * (NMOD * D_MODEL);
              pg8::EpiResNorm E{AP->out, AP->out, modl + 5 * D_MODEL, NMOD * D_MODEL, Hb, last ? AP->g_final : AP->g_mix + (l + 1) * D_MODEL, modn, modn + D_MODEL,
                                (float*)(ws + WS_XS) + 128 * 256 * 8, ctl + CW_PANEL + ((l * 2 + 1) * 128) * 64, ctl + CW_BAR + XB_TMO, lds + LDSCTL_OFF + 2048, last ? 1 : 0};
              pg8::gemm_phase<pg8::EpiResNorm, pg8::StaticOrder>(lds, g, S, E, tid); }
          else { pg8::EpiRes E{AP->out, XC, AP->out, XC, modl + 5 * D_MODEL, NMOD * D_MODEL, D_MODEL};
              pg8::gemm_phase<pg8::EpiRes, pg8::StaticOrder>(lds, g, S, E, tid); }
          if (DUP_G5 >= 3) { pg8::StaticOrder S3; S3.init(NLAT, D_MODEL, G, bx, WGM_RES, REV_G5); if (DUP_G5 == 4) S3.pm_mod = 16;
              pg8::EpiSum E3{(float*)(ws + WS_MIX)}; pg8::gemm_phase<pg8::EpiSum, pg8::StaticOrder>(lds, g, S3, E3, tid); }
          if (!last) { pg8::Gemm g2{ACT + (size_t)NLAT * (ACT_TILED ? 64 : FFN), (const bf16*)(wl + W_DOWN), NCTX, D_MODEL, FFN / 4, ACT_TILED ? 64 : FFN, 1 << 30, 0, FFN, FFN / 4, ACT_TILED ? (long)NTOK * 128 : 0, ACT_TILED ? (long)(FFN / 4 / 64) * NTOK * 128 : 0}; pg8::SplitKOrder S2; S2.init(NCTX / 256, D_MODEL / 256, 4, G, bx);
              pg8::EpiPart E2{PART, modl + (size_t)BATCH * (NMOD * D_MODEL) + 5 * D_MODEL, NCTX, D_MODEL};
              pg8::gemm_phase<pg8::EpiPart, pg8::SplitKOrder>(lds, g2, S2, E2, tid); } }
        }
#endif
        GRID_BAR();
    }

#if BURN_MFMA
    {
        typedef short bx8 __attribute__((ext_vector_type(8))); typedef float fx4 __attribute__((ext_vector_type(4)));
        int t_ = threadIdx.x; asm volatile("" : "+v"(t_));
        bx8 a_, b_; for (int e = 0; e < 8; ++e) { a_[e] = (short)(0x3c00 + ((t_ * 7 + e) & 127)); b_[e] = (short)(0x3c00 + ((t_ * 13 + e * 5) & 127)); }
        fx4 c_[8]; for (int i = 0; i < 8; ++i) c_[i] = (fx4){0.f, 0.f, 0.f, 0.f};
#pragma unroll 1
        for (int it = 0; it < BURN_MFMA * 128; ++it) {
#pragma unroll
            for (int i = 0; i < 8; ++i) c_[i] = __builtin_amdgcn_mfma_f32_16x16x32_bf16(a_, b_, c_[i], 0, 0, 0);
        }
        float s_ = 0.f; for (int i = 0; i < 8; ++i) s_ += c_[i][0] + c_[i][1] + c_[i][2] + c_[i][3];
        ((float*)(A.ws + WS_PART))[blockIdx.x * 512 + threadIdx.x] = s_;
    }
#endif
    const int l = 0; PHASE_IDS();
    if (!(FUSE_NORM && G == 256))
    for (int row = gw; row < NLAT; row += NGW) {
        float* xr = AP->out + (size_t)row * D_MODEL;
        f32x4 v[8]; float ss = 0.f;
#pragma unroll
        for (int j = 0; j < 8; ++j) { v[j] = *(const f32x4*)(xr + 4 * lane + 256 * j); ss += (v[j].x * v[j].x + v[j].y * v[j].y) + (v[j].z * v[j].z + v[j].w * v[j].w); }
        const float rstd = 1.f / sqrtf(wave_sum(ss) * (1.f / D_MODEL) + EPS);
#pragma unroll
        for (int j = 0; j < 8; ++j) { const int col = 4 * lane + 256 * j; const f32x4 gv = *(const f32x4*)(AP->g_final + col); *(f32x4*)(xr + col) = (v[j] * rstd) * gv; }
    }
}

extern "C" void kernel_launch(void* const* d_in, const int* in_sizes, int n_in, void* d_out, int out_size, void* d_ws, size_t ws_size, hipStream_t stream) {
    static int grid = 0;
    if (grid == 0) {
        if (n_in != 23 || in_sizes[0] != NLAT * D_MODEL || out_size != NLAT * D_MODEL || ws_size < WS_END) {
            fprintf(stderr, "kernel_launch: unexpected shapes: n_in %d in0 %d out %d ws %zu (need %zu)\n", n_in, n_in > 0 ? in_sizes[0] : -1, out_size, ws_size, (size_t)WS_END); grid = -1; return; }
        int dev = 0, cus = 0, per_cu = 0;
        if (hipGetDevice(&dev) != hipSuccess || hipDeviceGetAttribute(&cus, hipDeviceAttributeMultiprocessorCount, dev) != hipSuccess) { fprintf(stderr, "kernel_launch: device query failed\n"); grid = -1; return; }
        if (hipFuncSetAttribute((const void*)fwd_kernel, hipFuncAttributeMaxDynamicSharedMemorySize, LDS_BYTES) != hipSuccess) { fprintf(stderr, "kernel_launch: hipFuncSetAttribute failed\n"); grid = -1; return; }
        if (hipOccupancyMaxActiveBlocksPerMultiprocessor(&per_cu, (const void*)fwd_kernel, NWAVES * 64, LDS_BYTES) != hipSuccess || per_cu < 1) { fprintf(stderr, "kernel_launch: occupancy query reports %d workgroups per CU\n", per_cu); (void)hipGetLastError(); grid = -1; return; }
        grid = cus;
    }
    if (grid < 0) return;
    if (hipMemsetAsync((char*)d_ws, 0, ZERO_BYTES, stream) != hipSuccess) { fprintf(stderr, "kernel_launch: memset failed\n"); return; }
    Ptrs p{};
    const float** pf = (const float**)&p;
    for (int i = 0; i < 23; ++i) pf[i] = (const float*)d_in[i];
    p.out = (float*)d_out; p.ws = (unsigned char*)d_ws;
    hipLaunchKernelGGL(fwd_kernel, dim3(grid), dim3(NWAVES * 64), LDS_BYTES, stream, p);
    const hipError_t le = hipPeekAtLastError();
    if (le != hipSuccess) fprintf(stderr, "kernel_launch: launch failed: %s\n", hipGetErrorName(le));
}
```
